# Optimizing an MI355X kernel written in HIP

```python
import jax, jax.numpy as jnp
from jax import lax
import numpy as np

D_MODEL = 2048
BATCH = 32
SEQ = 256
DEPTH = 1
DEC_BATCH = 8
DEC_SEQ = 1024
PAST_LEN = 256

GRID_W = 64
HEAD_DIM = 128
N_HEADS_TOTAL = D_MODEL // HEAD_DIM
N_HEADS_A = N_HEADS_TOTAL // 2
N_HEADS_B = N_HEADS_TOTAL - N_HEADS_A
N_KV_B = max(1, N_HEADS_B // 4)
MIX_WIDTH = N_HEADS_TOTAL * HEAD_DIM
WIN_H = 8
WIN_W = 16
D_FF = 5632
ROPE_THETA = 10000.0
EPS = 1e-6
Q_BLOCK = 128
NEG_INF = -1e30
A_WIDTH = N_HEADS_A * HEAD_DIM
B_Q_WIDTH = N_HEADS_B * HEAD_DIM
B_KV_WIDTH = N_KV_B * HEAD_DIM
IN_COLS = 3 * A_WIDTH + B_Q_WIDTH + 2 * B_KV_WIDTH

kernel_name = "hybrid_natten_gqa_dit_step"


def rms_norm(x, g):
    xf = x.astype(jnp.float32)
    y = xf * lax.rsqrt(jnp.mean(xf * xf, axis=-1, keepdims=True) + EPS)
    return (y * g.astype(jnp.float32)).astype(x.dtype)


def modulation(cond, w_mod, b_mod):
    m = jax.nn.silu(cond) @ w_mod + b_mod
    return jnp.split(m, 6, axis=-1)


def split_heads(x, n):
    b, l, _ = x.shape
    return x.reshape(b, l, n, HEAD_DIM).transpose(0, 2, 1, 3)


def merge_heads(x):
    b, n, l, d = x.shape
    return x.transpose(0, 2, 1, 3).reshape(b, l, n * d)


def project(h, w_in):
    qkv = h @ w_in
    qa, ka, va, qb, kb, vb = jnp.split(
        qkv, [A_WIDTH, 2 * A_WIDTH, 3 * A_WIDTH, 3 * A_WIDTH + B_Q_WIDTH,
              3 * A_WIDTH + B_Q_WIDTH + B_KV_WIDTH], axis=-1)
    return (split_heads(qa, N_HEADS_A), split_heads(ka, N_HEADS_A), split_heads(va, N_HEADS_A),
            split_heads(qb, N_HEADS_B), split_heads(kb, N_KV_B), split_heads(vb, N_KV_B))


def rope_2d(x):
    l = x.shape[2]
    t = jnp.arange(l)
    half = HEAD_DIM // 2
    freqs = ROPE_THETA ** (-jnp.arange(0, half, 2, dtype=jnp.float32) / half)
    xf = x.astype(jnp.float32)

    def rot(xh, pos):
        ang = pos.astype(jnp.float32)[:, None] * freqs[None, :]
        cos, sin = jnp.cos(ang), jnp.sin(ang)
        x1, x2 = xh[..., :half // 2], xh[..., half // 2:]
        return jnp.concatenate([x1 * cos - x2 * sin, x2 * cos + x1 * sin], axis=-1)

    out = jnp.concatenate([rot(xf[..., :half], t // GRID_W), rot(xf[..., half:], t % GRID_W)], axis=-1)
    return out.astype(x.dtype)


def attend(q, k, v):
    b, hq, lq, dh = q.shape
    hkv = k.shape[1]
    g = hq // hkv
    nblk = lq // Q_BLOCK
    scale = dh ** -0.5
    qb = q.reshape(b, hkv, g, nblk, Q_BLOCK, dh).transpose(3, 0, 1, 2, 4, 5)

    def block(qi):
        s = jnp.einsum('bkgqd,bkld->bkgql', qi, k).astype(jnp.float32) * scale
        p = jax.nn.softmax(s, axis=-1).astype(v.dtype)
        return jnp.einsum('bkgql,bkld->bkgqd', p, v)

    o = lax.map(block, qb)
    return o.transpose(1, 2, 3, 0, 4, 5).reshape(b, hq, lq, dh)


def neighbourhood_attention(q, k, v, k_ctx, v_ctx, rpb):
    b, h, l, dh = q.shape
    rows = l // GRID_W
    kh = min(WIN_H, rows)
    scale = dh ** -0.5
    r = jnp.arange(rows)
    rs = jnp.clip(r - kh // 2, 0, rows - kh)
    row_idx = rs[:, None] + jnp.arange(kh)[None, :]
    col = jnp.arange(GRID_W)
    cs = jnp.clip(col - WIN_W // 2, 0, GRID_W - WIN_W)
    col_valid = (col[None, :] >= cs[:, None]) & (col[None, :] < cs[:, None] + WIN_W)
    qg = q.reshape(b, h, rows, GRID_W, dh)
    kg = k.reshape(b, h, rows, GRID_W, dh)
    vg = v.reshape(b, h, rows, GRID_W, dh)
    k_rows = kg[:, :, row_idx]
    v_rows = vg[:, :, row_idx]
    roff = row_idx - r[:, None] + WIN_H - 1
    coff = jnp.clip(col[None, :] - col[:, None] + WIN_W - 1, 0, 2 * WIN_W - 2)
    bias = rpb[:, roff[:, None, :, None], coff[None, :, None, :]]
    s_nb = jnp.einsum('bhrqd,bhrikd->bhrqik', qg, k_rows).astype(jnp.float32) * scale
    s_nb = s_nb + bias.astype(jnp.float32)
    s_nb = jnp.where(col_valid[:, None, :], s_nb, NEG_INF)
    s_nb = s_nb.reshape(b, h, rows, GRID_W, kh * GRID_W)
    s_ctx = jnp.einsum('bhrqd,bhcd->bhrqc', qg, k_ctx).astype(jnp.float32) * scale
    p = jax.nn.softmax(jnp.concatenate([s_nb, s_ctx], axis=-1), axis=-1).astype(v.dtype)
    p_nb = p[..., :kh * GRID_W].reshape(b, h, rows, GRID_W, kh, GRID_W)
    p_ctx = p[..., kh * GRID_W:]
    o = (jnp.einsum('bhrqik,bhrikd->bhrqd', p_nb, v_rows)
         + jnp.einsum('bhrqc,bhcd->bhrqd', p_ctx, v_ctx))
    return o.reshape(b, h, l, dh)


def conv_ffn(h, w_up, conv_w, conv_b, w_down):
    u = h @ w_up
    up = jnp.pad(u, ((0, 0), (1, 1), (0, 0)))
    u = up[:, :-2] * conv_w[0] + up[:, 1:-1] * conv_w[1] + up[:, 2:] * conv_w[2] + conv_b
    val, gate = jnp.split(u, 2, axis=-1)
    return (jax.nn.silu(gate) * val) @ w_down


def setup_inputs(seed: int = 0) -> dict:
    key = jax.random.key(seed)
    ks = jax.random.split(key, 24)
    f32 = jnp.float32
    nrm = lambda k, s, sc: jax.random.normal(k, s, f32) * sc
    return {
        "x_prompt": nrm(ks[0], (BATCH, SEQ, D_MODEL), 1.0),
        "x_sample": nrm(ks[1], (DEC_BATCH, DEC_SEQ, D_MODEL), 1.0),
        "c": nrm(ks[2], (DEC_BATCH, D_MODEL), 1.0),
        "cache_a_k": nrm(ks[3], (DEC_BATCH, DEPTH, N_HEADS_A, PAST_LEN, HEAD_DIM), 1.0),
        "cache_a_v": nrm(ks[4], (DEC_BATCH, DEPTH, N_HEADS_A, PAST_LEN, HEAD_DIM), 1.0),
        "cache_b_k": nrm(ks[5], (DEC_BATCH, DEPTH, N_KV_B, PAST_LEN, HEAD_DIM), 1.0),
        "cache_b_v": nrm(ks[6], (DEC_BATCH, DEPTH, N_KV_B, PAST_LEN, HEAD_DIM), 1.0),
        "c_ctx": nrm(ks[7], (D_MODEL,), 1.0),
        "w_mod": nrm(ks[8], (DEPTH, D_MODEL, 6 * D_MODEL), D_MODEL ** -0.5),
        "b_mod": nrm(ks[9], (DEPTH, 6 * D_MODEL), 0.01),
        "g_attn_pre": 1.0 + nrm(ks[10], (DEPTH, D_MODEL), 0.01),
        "g_attn_post": 1.0 + nrm(ks[11], (DEPTH, D_MODEL), 0.01),
        "g_ffn_pre": 1.0 + nrm(ks[12], (DEPTH, D_MODEL), 0.01),
        "g_ffn_post": 1.0 + nrm(ks[13], (DEPTH, D_MODEL), 0.01),
        "w_in": nrm(ks[14], (DEPTH, D_MODEL, IN_COLS), D_MODEL ** -0.5),
        "rpb": nrm(ks[15], (DEPTH, N_HEADS_A, 2 * WIN_H - 1, 2 * WIN_W - 1), 0.1),
        "g_qnorm": 1.0 + nrm(ks[16], (DEPTH, HEAD_DIM), 0.01),
        "g_knorm": 1.0 + nrm(ks[17], (DEPTH, HEAD_DIM), 0.01),
        "w_out": nrm(ks[18], (DEPTH, MIX_WIDTH, D_MODEL), MIX_WIDTH ** -0.5),
        "w_up": nrm(ks[19], (DEPTH, D_MODEL, 2 * D_FF), D_MODEL ** -0.5),
        "conv_w": nrm(ks[20], (DEPTH, 3, 2 * D_FF), 3 ** -0.5),
        "conv_b": nrm(ks[21], (DEPTH, 2 * D_FF), 0.01),
        "w_down": nrm(ks[22], (DEPTH, D_FF, D_MODEL), D_FF ** -0.5),
    }


def reference(x_prompt, x_sample, c, cache_a_k, cache_a_v, cache_b_k, cache_b_v, c_ctx,
              w_mod, b_mod, g_attn_pre, g_attn_post, g_ffn_pre, g_ffn_post, w_in, rpb,
              g_qnorm, g_knorm, w_out, w_up, conv_w, conv_b, w_down):
    xp = x_prompt
    xs = x_sample
    st_ak, st_av, st_bk, st_bv = [], [], [], []
    for l in range(DEPTH):
        sh1, sc1, ga1, sh2, sc2, ga2 = modulation(c_ctx[None, :], w_mod[l], b_mod[l])
        h = rms_norm(xp, g_attn_pre[l]) * (1 + sc1) + sh1
        qa, ka, va, qb, kb, vb = project(h, w_in[l])
        qb = rms_norm(qb, g_qnorm[l])
        kb = rms_norm(kb, g_knorm[l])
        oa = attend(qa, ka, va)
        ob = attend(qb, kb, vb)
        o = jnp.concatenate([merge_heads(oa), merge_heads(ob)], axis=-1) @ w_out[l]
        xp = xp + ga1 * rms_norm(o, g_attn_post[l])
        h = rms_norm(xp, g_ffn_pre[l]) * (1 + sc2) + sh2
        f = conv_ffn(h, w_up[l], conv_w[l], conv_b[l], w_down[l])
        xp = xp + ga2 * rms_norm(f, g_ffn_post[l])
        st_ak.append(ka)
        st_av.append(va)
        st_bk.append(kb)
        st_bv.append(vb)

        sh1, sc1, ga1, sh2, sc2, ga2 = modulation(c[:, None, :], w_mod[l], b_mod[l])
        h = rms_norm(xs, g_attn_pre[l]) * (1 + sc1) + sh1
        qa, ka, va, qb, kb, vb = project(h, w_in[l])
        oa = neighbourhood_attention(qa, ka, va, cache_a_k[:, l], cache_a_v[:, l], rpb[l])
        qb = rope_2d(rms_norm(qb, g_qnorm[l]))
        kb = rope_2d(rms_norm(kb, g_knorm[l]))
        kb_all = jnp.concatenate([cache_b_k[:, l], kb], axis=2)
        vb_all = jnp.concatenate([cache_b_v[:, l], vb], axis=2)
        ob = attend(qb, kb_all, vb_all)
        o = jnp.concatenate([merge_heads(oa), merge_heads(ob)], axis=-1) @ w_out[l]
        xs = xs + ga1 * rms_norm(o, g_attn_post[l])
        h = rms_norm(xs, g_ffn_pre[l]) * (1 + sc2) + sh2
        f = conv_ffn(h, w_up[l], conv_w[l], conv_b[l], w_down[l])
        xs = xs + ga2 * rms_norm(f, g_ffn_post[l])

    state_a_k = jnp.stack(st_ak, axis=1)
    state_a_v = jnp.stack(st_av, axis=1)
    state_b_k = jnp.stack(st_bk, axis=1)
    state_b_v = jnp.stack(st_bv, axis=1)
    return (xp, xs, state_a_k, state_a_v, state_b_k, state_b_v)
```

```cpp
#include <hip/hip_runtime.h>
#include <hip/hip_cooperative_groups.h>
#include <cstdio>
#include <cstdint>
namespace cg = cooperative_groups;

#define LAS __attribute__((address_space(3)))
typedef unsigned short bf16_t;
typedef short bf16x8 __attribute__((ext_vector_type(8)));
typedef short s16x4 __attribute__((ext_vector_type(4)));
typedef float f32x4 __attribute__((ext_vector_type(4)));
typedef float f32x16 __attribute__((ext_vector_type(16)));
typedef unsigned u32x4 __attribute__((ext_vector_type(4)));
typedef unsigned u32x2 __attribute__((ext_vector_type(2)));

constexpr int DM = 2048, MTOK = 16384, NCTX = 8192, DFF = 5632, NUP = 11264, NIN = 4608, NMOD = 12288;
constexpr float EPS = 1e-6f;
constexpr int CHROWS = 4096;

constexpr size_t MiB = 1u << 20;
constexpr size_t WS_MOD = 0, WS_WDN = 1 * MiB, WS_XN = 23 * MiB, WS_WIN = 87 * MiB, WS_WOUT = 105 * MiB, WS_WUP = 113 * MiB;
constexpr size_t WS_CAK = 157 * MiB, WS_CAV = 161 * MiB, WS_CBK = 165 * MiB, WS_CBV = 166 * MiB;
constexpr size_t WS_QA = 167 * MiB, WS_KA = 199 * MiB, WS_VA = 231 * MiB, WS_QB = 263 * MiB, WS_KB = 295 * MiB, WS_VB = 303 * MiB;
constexpr size_t WS_O = 311 * MiB, WS_MODP = 311 * MiB;
constexpr size_t WS_P1 = 167 * MiB;
constexpr size_t WS_ACT = 157 * MiB, WS_U = 333 * MiB;
constexpr size_t WS_P2 = 23 * MiB;
constexpr size_t WS_END = 421 * MiB;

constexpr int LDS_BYTES = 147456, MISC_OFF = 147200;
constexpr size_t WS_CTL = 512 * 1024, CTL_BYTES = 16384;

__device__ __forceinline__ unsigned cvt_pk_bf16(float lo, float hi) { unsigned r; asm volatile("v_cvt_pk_bf16_f32 %0, %1, %2" : "=v"(r) : "v"(lo), "v"(hi)); return r; }
__device__ __forceinline__ float bf_lo(unsigned w) { return __uint_as_float(w << 16); }
__device__ __forceinline__ float bf_hi(unsigned w) { return __uint_as_float(w & 0xffff0000u); }
__device__ __forceinline__ int tid_of(int wave_s) { unsigned z = 0u; asm volatile("" : "+v"(z));
    return wave_s * 64 + (int)__builtin_amdgcn_mbcnt_hi(~0u, __builtin_amdgcn_mbcnt_lo(~0u, z)); }
__device__ __forceinline__ float wave_sum(float v) {
#pragma unroll
    for (int o = 1; o < 64; o <<= 1) v += __shfl_xor(v, o);
    return v;
}


#define XB_TMO      128
#define XB_XCNT(j)  (256  + 64 * (j))
#define XB_XSUB(j)  (1280 + 64 * (j))
#define XB_XGEN(j)  (2304 + 64 * (j))
#define XB_TOP      3328
#define XB_TOPGEN   3392
#define XCD_BAR_WORDS 3456
#define XB_SPIN_CAP (1u << 18)
__device__ __forceinline__ unsigned xb_ld(unsigned* p)              { return __hip_atomic_load(p, __ATOMIC_RELAXED, __HIP_MEMORY_SCOPE_AGENT); }
__device__ __forceinline__ unsigned xb_add(unsigned* p, unsigned v) { return __hip_atomic_fetch_add(p, v, __ATOMIC_RELAXED, __HIP_MEMORY_SCOPE_AGENT); }
__device__ __forceinline__ unsigned xb_xcc_id() { return (unsigned)__builtin_amdgcn_s_getreg((3 << 11) | 20) & 0xFu; }
#define XB_SPIN(cond, bar) do { unsigned _sp = 0; while (cond) { __builtin_amdgcn_s_sleep(1); \
    if ((++_sp & 255u) == 0u) { if (xb_ld(&(bar)[XB_TMO])) break; if (_sp > XB_SPIN_CAP) { atomicAdd(&(bar)[XB_TMO], 1u); break; } } } } while (0)
struct XcdBarrier { unsigned* bar; unsigned x; volatile LAS unsigned* st; };
__device__ __forceinline__ XcdBarrier xcd_barrier_post(unsigned* bar, volatile LAS unsigned* st, int wave_s) {
    XcdBarrier b; b.bar = bar; b.x = xb_xcc_id(); b.st = st;
    if (tid_of(wave_s) == 0) (void)xb_add(&bar[XB_XCNT(b.x)], 1u);
    return b;
}
__device__ __forceinline__ void xcd_barrier_complete(unsigned* bar, unsigned x, unsigned& nloc, unsigned& nx) {
    const unsigned G = gridDim.x * gridDim.y * gridDim.z;
    unsigned sum, cnt, mine, sp = 0u;
    for (;;) {
        sum = 0u; cnt = 0u; mine = 0u;
#pragma unroll
        for (unsigned j = 0; j < 16; ++j) { const unsigned c = xb_ld(&bar[XB_XCNT(j)]); sum += c; cnt += (c > 0u) ? 1u : 0u; mine = (j == x) ? c : mine; }
        if (sum == G) break;
        __builtin_amdgcn_s_sleep(1);
        if ((++sp & 255u) == 0u) { if (xb_ld(&bar[XB_TMO])) break; if (sp > XB_SPIN_CAP) { atomicAdd(&bar[XB_TMO], 1u); break; } }
    }
    nloc = mine > 0u ? mine : 1u; nx = cnt > 0u ? cnt : 1u;
}
__device__ __forceinline__ void xcd_barrier(const XcdBarrier& b, int wave_s) {
    asm volatile("s_waitcnt vmcnt(0)" ::: "memory");
    __syncthreads();
    if (tid_of(wave_s) == 0) {
        unsigned* bar = b.bar;
        __builtin_amdgcn_s_waitcnt(0);
        unsigned nloc = b.st[0], nx = b.st[1];
        if (nloc == 0u) { xcd_barrier_complete(bar, b.x, nloc, nx); b.st[0] = nloc; b.st[1] = nx; }
        const unsigned old = xb_add(&bar[XB_XSUB(b.x)], 1u);
        const unsigned gen = old / nloc;
        if (old + 1u == (gen + 1u) * nloc) {
            __builtin_amdgcn_fence(__ATOMIC_RELEASE, "agent");
            asm volatile("s_waitcnt vmcnt(0)" ::: "memory");
            const unsigned og = xb_add(&bar[XB_TOP], 1u);
            const unsigned tg = og / nx;
            if (og + 1u == (tg + 1u) * nx) xb_add(&bar[XB_TOPGEN], 1u);
            else XB_SPIN(xb_ld(&bar[XB_TOPGEN]) == tg, bar);
            __builtin_amdgcn_fence(__ATOMIC_ACQUIRE, "agent");
            xb_add(&bar[XB_XGEN(b.x)], 1u);
            asm volatile("s_waitcnt vmcnt(0)" ::: "memory");
        } else {
            XB_SPIN(xb_ld(&bar[XB_XGEN(b.x)]) == gen, bar);
            __builtin_amdgcn_fence(__ATOMIC_ACQUIRE, "agent");
            asm volatile("s_waitcnt vmcnt(0)" ::: "memory");
        }
    }
    __syncthreads();
}

namespace pg8 {
constexpr int BM = 256, BK = 64, HALF = 128, HTB = HALF * BK * 2, STAGE_BYTES = 8 * HTB, NXCD = 8, WGM = 8;
__host__ __device__ __forceinline__ int lds_byte(int r, int c) { const int st = (r >> 4) * 2 + (c >> 5), rr = r & 15, cc = c & 31, ob = rr * 64 + cc * 2; return st * 1024 + (ob ^ (((ob >> 9) & 1) << 5)); }
__host__ __device__ __forceinline__ void stage_rc(int b, int& R, int& C) { const int st = b / 1024, sb = b % 1024, swz = sb ^ (((sb >> 9) & 1) << 5); R = (st >> 1) * 16 + swz / 64; C = (st & 1) * 32 + (swz % 64) / 2; }
__host__ __device__ __forceinline__ int perm32(int rho) { const int n = rho >> 4, i = rho & 15; return 8 * (i >> 2) + 4 * n + (i & 3); }

struct Unit { int pm, pn; };
struct Gemm { const bf16_t* A; const bf16_t* Bt; int M, N, K; };

struct StaticOrder {
    int nM, nN, nwg, G, c;
    __host__ __device__ void init(int M, int N, int G_, int c_) { nM = M / BM; nN = N / BM; nwg = nM * nN; G = G_; c = c_; }
    __host__ __device__ bool next(int i, Unit& u) const {
        const long L = (long)i * G + c; if (L >= nwg) return false;
        int wgid = (int)L; { const int q = nwg / NXCD, r = nwg % NXCD, xcd = wgid % NXCD, off = wgid / NXCD; wgid = (xcd < r ? xcd * (q + 1) : r * (q + 1) + (xcd - r) * q) + off; }
        const int nig = WGM * nN, gid = wgid / nig, fm = gid * WGM, gsz = (nM - fm) < WGM ? (nM - fm) : WGM;
        u.pm = fm + ((wgid % nig) % gsz); u.pn = (wgid % nig) / gsz; return true;
    }
    __device__ __forceinline__ void a_ready(const Unit&) const {}
    __device__ __forceinline__ void done(const Unit&) const {}
};

__device__ __forceinline__ u32x4 quad_xpose(u32x4 w, int src4) {
    u32x4 r;
    r.x = (unsigned)__builtin_amdgcn_ds_bpermute(src4, (int)w.x); r.y = (unsigned)__builtin_amdgcn_ds_bpermute(src4, (int)w.y);
    r.z = (unsigned)__builtin_amdgcn_ds_bpermute(src4, (int)w.z); r.w = (unsigned)__builtin_amdgcn_ds_bpermute(src4, (int)w.w);
    return r;
}
struct EpiF32 {
    static constexpr bool PERM = false, AFTER_DRAIN = false;
    float* C; int ldc;
    __device__ __forceinline__ void operator()(const f32x4 (&acc)[2][2][4][2], const Unit& u, int wr, int wc, int fr, int fq) const {
        const int row0 = u.pm * BM + wr * 64 + fr, col0 = u.pn * BM + wc * 32 + 4 * fq;
#pragma unroll
        for (int ai = 0; ai < 2; ++ai)
#pragma unroll
            for (int m = 0; m < 4; ++m) { float* rowp = C + (size_t)(row0 + ai * HALF + m * 16) * ldc + col0;
#pragma unroll
                for (int bj = 0; bj < 2; ++bj)
#pragma unroll
                    for (int n = 0; n < 2; ++n) *(f32x4*)(rowp + bj * HALF + n * 16) = acc[ai][bj][m][n]; }
    }
};
struct EpiBf16 {
    static constexpr bool PERM = true, AFTER_DRAIN = false;
    bf16_t* O; int ldc;
    __device__ __forceinline__ void operator()(const f32x4 (&acc)[2][2][4][2], const Unit& u, int wr, int wc, int fr, int fq) const {
        const int ln = fr + 16 * fq, r4 = ln >> 2, c4 = ln & 3, src4 = 4 * (16 * c4 + r4);
        const int row0 = u.pm * BM + wr * 64 + r4, col0 = u.pn * BM + wc * 32 + 8 * c4;
#pragma unroll
        for (int ai = 0; ai < 2; ++ai)
#pragma unroll
            for (int m = 0; m < 4; ++m) { bf16_t* rowp = O + (size_t)(row0 + ai * HALF + m * 16) * ldc + col0;
#pragma unroll
                for (int bj = 0; bj < 2; ++bj) { const f32x4 v0 = acc[ai][bj][m][0], v1 = acc[ai][bj][m][1];
                    u32x4 w; w.x = cvt_pk_bf16(v0[0], v0[1]); w.y = cvt_pk_bf16(v0[2], v0[3]); w.z = cvt_pk_bf16(v1[0], v1[1]); w.w = cvt_pk_bf16(v1[2], v1[3]);
                    *(u32x4*)(rowp + bj * HALF) = quad_xpose(w, src4); } }
    }
};
struct EpiQKV {
    static constexpr bool PERM = true, AFTER_DRAIN = false;
    bf16_t *QA, *KA, *VA, *QB, *KB, *VB; float *sak, *sav, *sbv;
    __device__ __forceinline__ void operator()(const f32x4 (&acc)[2][2][4][2], const Unit& u, int wr, int wc, int fr, int fq) const {
        const int pn = u.pn, pm = u.pm;
        bf16_t* buf; int H, h0; float* st = nullptr;
        if (pn < 4) { buf = QA; H = 8; h0 = 2 * pn; }
        else if (pn < 8) { buf = KA; H = 8; h0 = 2 * (pn - 4); st = sak; }
        else if (pn < 12) { buf = VA; H = 8; h0 = 2 * (pn - 8); st = sav; }
        else if (pn < 16) { buf = QB; H = 8; h0 = 2 * (pn - 12); }
        else if (pn == 16) { buf = KB; H = 2; h0 = 0; }
        else { buf = VB; H = 2; h0 = 0; st = sbv; }
        const bool ctx = pm < 32;
        int b, t0, L; size_t reg;
        if (ctx) { b = pm; t0 = 0; L = 256; reg = 0; } else { b = (pm - 32) >> 2; t0 = ((pm - 32) & 3) * 256; L = 1024; reg = (size_t)NCTX * H * 128; }
#pragma unroll
        for (int bj = 0; bj < 2; ++bj) {
            const int h = h0 + bj;
            const int ln = fr + 16 * fq, r4 = ln >> 2, c4 = ln & 3, src4 = 4 * (16 * c4 + r4);
            bf16_t* base = buf + reg + ((size_t)(b * H + h) * L + t0) * 128 + wc * 32 + 8 * c4;
            float* sbase = st + ((size_t)(b * H + h) * 256) * 128 + wc * 32 + 8 * fq;
#pragma unroll
            for (int ai = 0; ai < 2; ++ai)
#pragma unroll
                for (int m = 0; m < 4; ++m) {
                    const int t = ai * HALF + wr * 64 + m * 16 + fr;
                    const f32x4 v0 = acc[ai][bj][m][0], v1 = acc[ai][bj][m][1];
                    u32x4 w; w.x = cvt_pk_bf16(v0[0], v0[1]); w.y = cvt_pk_bf16(v0[2], v0[3]); w.z = cvt_pk_bf16(v1[0], v1[1]); w.w = cvt_pk_bf16(v1[2], v1[3]);
                    *(u32x4*)(base + (size_t)(t - fr + r4) * 128) = quad_xpose(w, src4);
                    if (ctx && st) { *(f32x4*)(sbase + (size_t)t * 128) = v0; *(f32x4*)(sbase + (size_t)t * 128 + 4) = v1; }
                    asm volatile("" ::: "memory");
                }
        }
    }
};


template <int CTRL> __device__ __forceinline__ float dppf(float old, float src) {
    return __builtin_bit_cast(float, __builtin_amdgcn_update_dpp(__builtin_bit_cast(int, old), __builtin_bit_cast(int, src), CTRL, 0xF, 0xF, false));
}
struct EpiConv {
    static constexpr bool PERM = true, AFTER_DRAIN = false;
    bf16_t* ACT; float* HB; const float* cw; const float* cb; LAS float* H;
    __device__ __forceinline__ void operator()(const f32x4 (&acc)[2][2][4][2], const Unit& u, int wr, int wc, int fr, int fq) const {
        const int pm = u.pm, pn = u.pn;
        const int cl = 32 * wc + 8 * fq, j0 = 128 * pn + cl;
#pragma unroll
        for (int ai = 0; ai < 2; ++ai) { const int blk = ai * 2 + wr;
            if (fr == 0) {
#pragma unroll
                for (int bj = 0; bj < 2; ++bj)
#pragma unroll
                    for (int n = 0; n < 2; ++n) *(LAS f32x4*)(H + ((blk * 2 + 0) * 2 + bj) * 128 + cl + 4 * n) = acc[ai][bj][0][n]; }
            if (fr == 15) {
#pragma unroll
                for (int bj = 0; bj < 2; ++bj)
#pragma unroll
                    for (int n = 0; n < 2; ++n) *(LAS f32x4*)(H + ((blk * 2 + 1) * 2 + bj) * 128 + cl + 4 * n) = acc[ai][bj][3][n]; } }
        if (pm >= 32) { const int lt = pm - 32;
            if (wr == 0 && fr < 2) {
#pragma unroll
                for (int bj = 0; bj < 2; ++bj)
#pragma unroll
                    for (int n = 0; n < 2; ++n) *(f32x4*)(HB + ((size_t)((lt * 4 + fr) * 2 + bj)) * DFF + j0 + 4 * n) = acc[0][bj][0][n]; }
            if (wr == 1 && fr >= 14) {
#pragma unroll
                for (int bj = 0; bj < 2; ++bj)
#pragma unroll
                    for (int n = 0; n < 2; ++n) *(f32x4*)(HB + ((size_t)((lt * 4 + fr - 12) * 2 + bj)) * DFF + j0 + 4 * n) = acc[1][bj][3][n]; } }
        asm volatile("s_waitcnt lgkmcnt(0)" ::: "memory"); __builtin_amdgcn_s_barrier(); asm volatile("" ::: "memory");
        u32x2 keep[2][4];
        const int ln = fr + 16 * fq, r4 = ln >> 2, c4 = ln & 3, src4 = 4 * (16 * c4 + r4);
#pragma unroll
        for (int n = 0; n < 2; ++n) {
            f32x4 w[3][2], bs[2];
#pragma unroll
            for (int bj = 0; bj < 2; ++bj) { bs[bj] = *(const f32x4*)(cb + bj * DFF + j0 + 4 * n);
#pragma unroll
                for (int k = 0; k < 3; ++k) w[k][bj] = *(const f32x4*)(cw + (size_t)k * NUP + bj * DFF + j0 + 4 * n); }
#pragma unroll
            for (int ai = 0; ai < 2; ++ai) { const int blk = ai * 2 + wr;
                f32x4 hu[2], hd[2];
#pragma unroll
                for (int bj = 0; bj < 2; ++bj) {
                    hu[bj] = (blk > 0) ? *(const LAS f32x4*)(H + (((blk - 1) * 2 + 1) * 2 + bj) * 128 + cl + 4 * n) : (f32x4){0.f, 0.f, 0.f, 0.f};
                    hd[bj] = (blk < 3) ? *(const LAS f32x4*)(H + (((blk + 1) * 2 + 0) * 2 + bj) * 128 + cl + 4 * n) : (f32x4){0.f, 0.f, 0.f, 0.f}; }
#pragma unroll
                for (int m = 0; m < 4; ++m) {
                    float a[4];
#pragma unroll
                    for (int e = 0; e < 4; ++e) {
                        float r[2];
#pragma unroll
                        for (int bj = 0; bj < 2; ++bj) {
                            const float cur = acc[ai][bj][m][n][e];
                            const float upT = (m == 0) ? hu[bj][e] : dppf<0x121>(0.f, acc[ai][bj][m == 0 ? 0 : m - 1][n][e]);
                            const float up = dppf<0x111>(upT, cur);
                            const float dnT = (m == 3) ? hd[bj][e] : dppf<0x12F>(0.f, acc[ai][bj][m == 3 ? 3 : m + 1][n][e]);
                            const float dn = dppf<0x101>(dnT, cur);
                            r[bj] = w[0][bj][e] * up + w[1][bj][e] * cur + w[2][bj][e] * dn + bs[bj][e];
                        }
                        a[e] = r[1] * __builtin_amdgcn_rcpf(1.f + __expf(-r[1])) * r[0];
                    }
                    u32x2 ow; ow.x = cvt_pk_bf16(a[0], a[1]); ow.y = cvt_pk_bf16(a[2], a[3]);
                    if (n == 0) keep[ai][m] = ow;
                    else { u32x4 w16; w16.x = keep[ai][m].x; w16.y = keep[ai][m].y; w16.z = ow.x; w16.w = ow.y;
                        *(u32x4*)(ACT + (size_t)(pm * BM + ai * HALF + wr * 64 + m * 16 + r4) * DFF + 128 * pn + 32 * wc + 8 * c4) = quad_xpose(w16, src4); }
                }
            }
        }
    }
};

template <class Epi, class Sched, bool ALIGN_EPI = true>
__device__ __forceinline__ void gemm_phase(LAS unsigned char* lds, const Gemm g, const Sched& S, const Epi& E, int wave_s) {
    const int tid = tid_of(wave_s);
    const int wid = wave_s, lane = tid & 63, wr = wid >> 2, wc = wid & 3, fr = lane & 15, fq = lane >> 4;
    const int K = g.K, nt = K / BK;
    unsigned voffA[2], voffB[2];
#pragma unroll
    for (int i = 0; i < 2; ++i) { int R, C; stage_rc(tid * 16 + i * 8192, R, C); const int Rb = Epi::PERM ? ((R & ~31) + perm32(R & 31)) : R;
        voffA[i] = (unsigned)(R * K + C) * 2u; voffB[i] = (unsigned)(Rb * K + C) * 2u; }
    const size_t kstep = (size_t)(BK * 2);
    const size_t hstep = (size_t)HALF * K * 2;
    const size_t tstep = 2 * hstep;
    const unsigned ldsw = (unsigned)wid * 1024u;
    const int aoff = lds_byte(wr * 64 + fr, fq * 8), boff = lds_byte(wc * 32 + fr, fq * 8);
#define PG8_SA(b, h) (((b) * 2 + (h)) * HTB)
#define PG8_SB(b, h) ((4 + (b) * 2 + (h)) * HTB)
#define PG8_STAGE(bufoff, gbase, voff) do { _Pragma("unroll") for (int _i = 0; _i < 2; ++_i) \
        __builtin_amdgcn_global_load_lds((const unsigned*)((const char*)(gbase) + (voff)[_i]), (LAS unsigned*)(lds + (bufoff) + ldsw + _i * 8192), 16, 0, 0); } while (0)
#define PG8_LDA(dst, b, h) do { _Pragma("unroll") for (int m = 0; m < 4; ++m) _Pragma("unroll") for (int k = 0; k < 2; ++k) dst[m][k] = *(const LAS bf16x8*)(lds + PG8_SA(b, h) + aoff + m * 2048 + k * 1024); } while (0)
#define PG8_LDB(dst, b, h) do { _Pragma("unroll") for (int n = 0; n < 2; ++n) _Pragma("unroll") for (int k = 0; k < 2; ++k) dst[n][k] = *(const LAS bf16x8*)(lds + PG8_SB(b, h) + boff + n * 2048 + k * 1024); } while (0)
#define PG8_MMA(ai, bj, At, Bt) do { __builtin_amdgcn_s_setprio(1); _Pragma("unroll") for (int m = 0; m < 4; ++m) _Pragma("unroll") for (int n = 0; n < 2; ++n) _Pragma("unroll") for (int k = 0; k < 2; ++k) \
        acc[ai][bj][m][n] = __builtin_amdgcn_mfma_f32_16x16x32_bf16(Bt[n][k], At[m][k], acc[ai][bj][m][n], 0, 0, 0); __builtin_amdgcn_s_setprio(0); } while (0)
#define PG8_WAIT_V(n) asm volatile("s_waitcnt vmcnt(" #n ")" ::: "memory")
#define PG8_WAIT_L(n) asm volatile("s_waitcnt lgkmcnt(" #n ")" ::: "memory")
#define PG8_BAR __builtin_amdgcn_s_barrier()
#define PG8_SCHED __builtin_amdgcn_sched_barrier(0)
    Unit cur, nxt; int ui = 0;
    if (!S.next(0, cur)) return;
    f32x4 acc[2][2][4][2];
#pragma unroll
    for (int a = 0; a < 2; ++a)
#pragma unroll
        for (int b = 0; b < 2; ++b)
#pragma unroll
            for (int m = 0; m < 4; ++m)
#pragma unroll
                for (int n = 0; n < 2; ++n) acc[a][b][m][n] = (f32x4){0.f, 0.f, 0.f, 0.f};
    bf16x8 At[4][2], B0[2][2], B1[2][2];
    const char* cA = (const char*)g.A + (size_t)cur.pm * tstep; const char* cB = (const char*)g.Bt + (size_t)cur.pn * tstep;
    S.a_ready(cur);
    PG8_STAGE(PG8_SB(0, 0), cB, voffB); PG8_STAGE(PG8_SB(0, 1), cB + hstep, voffB); PG8_STAGE(PG8_SA(0, 0), cA, voffA); PG8_STAGE(PG8_SA(0, 1), cA + hstep, voffA);
    if (wr == 1) PG8_BAR;
    PG8_WAIT_V(2); PG8_BAR;
    PG8_STAGE(PG8_SB(1, 0), cB + kstep, voffB); PG8_STAGE(PG8_SA(1, 0), cA + kstep, voffA); PG8_STAGE(PG8_SB(1, 1), cB + hstep + kstep, voffB);
    PG8_WAIT_V(6); PG8_BAR;
    for (;;) {
        const bool has_next = S.next(ui + 1, nxt);
        const char* nA = has_next ? (const char*)g.A + (size_t)nxt.pm * tstep : cA; const char* nB = has_next ? (const char*)g.Bt + (size_t)nxt.pn * tstep : cB;
        for (int t = 0; t < nt; t += 2) {
            const bool last = (t == nt - 2);
            const char* a1 = cA + (size_t)(t + 1) * kstep;
            const char* a2 = last ? nA : cA + (size_t)(t + 2) * kstep; const char* b2 = last ? nB : cB + (size_t)(t + 2) * kstep;
            const char* a3 = a2 + kstep; const char* b3 = b2 + kstep;
            if (last && has_next) S.a_ready(nxt);
            PG8_LDB(B0, 0, 0); PG8_LDB(B1, 0, 1); PG8_SCHED; PG8_LDA(At, 0, 0); PG8_STAGE(PG8_SA(1, 1), a1 + hstep, voffA);
            PG8_WAIT_V(8); PG8_WAIT_L(0); PG8_BAR; PG8_MMA(0, 0, At, B0); PG8_MMA(0, 1, At, B1); PG8_BAR; PG8_SCHED;
            PG8_LDA(At, 0, 1); PG8_STAGE(PG8_SB(0, 0), b2, voffB); PG8_STAGE(PG8_SB(0, 1), b2 + hstep, voffB); PG8_STAGE(PG8_SA(0, 0), a2, voffA);
            PG8_WAIT_V(8); PG8_WAIT_L(0); PG8_BAR; PG8_MMA(1, 0, At, B0); PG8_MMA(1, 1, At, B1); PG8_BAR; PG8_SCHED;
            PG8_LDB(B0, 1, 0); PG8_LDB(B1, 1, 1); PG8_SCHED; PG8_LDA(At, 1, 0); PG8_STAGE(PG8_SA(0, 1), a2 + hstep, voffA);
            PG8_WAIT_V(8); PG8_WAIT_L(0); PG8_BAR; PG8_MMA(0, 0, At, B0); PG8_MMA(0, 1, At, B1); PG8_BAR; PG8_SCHED;
            PG8_LDA(At, 1, 1); PG8_STAGE(PG8_SB(1, 0), b3, voffB); PG8_STAGE(PG8_SB(1, 1), b3 + hstep, voffB); PG8_STAGE(PG8_SA(1, 0), a3, voffA);
            PG8_WAIT_V(8); PG8_WAIT_L(0); PG8_BAR; PG8_MMA(1, 0, At, B0); PG8_MMA(1, 1, At, B1); PG8_BAR; PG8_SCHED;
        }
        if constexpr (ALIGN_EPI) { if (wr == 0) PG8_BAR; }
        E(acc, cur, wr, wc, fr, fq); S.done(cur);
        if (!has_next) break;
#pragma unroll
        for (int a = 0; a < 2; ++a)
#pragma unroll
            for (int b = 0; b < 2; ++b)
#pragma unroll
                for (int m = 0; m < 4; ++m)
#pragma unroll
                    for (int n = 0; n < 2; ++n) acc[a][b][m][n] = (f32x4){0.f, 0.f, 0.f, 0.f};
        cur = nxt; cA = nA; cB = nB; ++ui;
        if constexpr (ALIGN_EPI) { if (wr == 1) PG8_BAR; }
    }
    PG8_WAIT_V(0);
    if constexpr (!ALIGN_EPI) { if (wr == 0) PG8_BAR; }
    PG8_BAR;
#undef PG8_SA
#undef PG8_SB
#undef PG8_STAGE
#undef PG8_LDA
#undef PG8_LDB
#undef PG8_MMA
#undef PG8_WAIT_V
#undef PG8_WAIT_L
#undef PG8_BAR
#undef PG8_SCHED
}
}

namespace att {
constexpr int D = 128, NW = 8, QBLK = 32, KVBLK = 64;
constexpr float SCALE = 0.088388347648318440f;
constexpr float THR = 8.f;
constexpr int SHM_V = KVBLK * D * 2, SHM_K = KVBLK * D * 2, SHM_ATTN = 2 * SHM_V + 2 * SHM_K + NW * 64 * 4;
constexpr int BIAS_OFF = SHM_ATTN, BIAS_FLOATS = 704;
constexpr int OST_OFF = 73728, OST_WAVE = 32 * 272;
#define KSWZ(row, colB) ((row) * 256 + ((colB) ^ (((row) & 7) << 4)))
#define SBAR() __builtin_amdgcn_sched_barrier(0)
__device__ __forceinline__ int crow(int r, int hi) { return (r & 3) + 8 * (r >> 2) + 4 * hi; }
__device__ __forceinline__ unsigned cvtpk(float lo, float hi) { unsigned r; asm volatile("v_cvt_pk_bf16_f32 %0, %1, %2" : "=v"(r) : "v"(lo), "v"(hi)); return r; }
__device__ __forceinline__ bf16x8 ld8(const bf16_t* p) { return *reinterpret_cast<const bf16x8*>(p); }

__device__ __forceinline__ void partialSM(f32x16& p0, f32x16& p1, float& m_reg, float& mn, float& alpha) {
  constexpr float C = SCALE * 1.4426950408889634f;
  float pmax = p0[0];
#pragma unroll
  for (int r = 1; r < 16; ++r) pmax = fmaxf(pmax, p0[r]);
#pragma unroll
  for (int r = 0; r < 16; ++r) pmax = fmaxf(pmax, p1[r]);
  { auto rr = __builtin_amdgcn_permlane32_swap(__float_as_uint(pmax), __float_as_uint(pmax), false, false);
    pmax = fmaxf(__uint_as_float(rr[0]), __uint_as_float(rr[1])); }
  if (__builtin_expect(__all(pmax - m_reg <= THR / SCALE), 1)) { mn = m_reg; alpha = 1.f; }
  else { mn = fmaxf(m_reg, pmax); alpha = __builtin_amdgcn_exp2f((m_reg - mn) * C); m_reg = mn; }
  float mnC = -mn * C;
#pragma unroll
  for (int r = 0; r < 16; ++r) p0[r] = fmaf(p0[r], C, mnC);
#pragma unroll
  for (int r = 0; r < 16; ++r) p1[r] = fmaf(p1[r], C, mnC);
#pragma unroll
  for (int r = 0; r < 16; ++r) p0[r] = __builtin_amdgcn_exp2f(p0[r]);
}
__device__ __forceinline__ void finishSM(f32x16& p0, f32x16& p1, float alpha, float& l_reg, bf16x8& pa0, bf16x8& pa1, bf16x8& pa2, bf16x8& pa3) {
#pragma unroll
  for (int r = 0; r < 16; ++r) p1[r] = __builtin_amdgcn_exp2f(p1[r]);
  float ps = 0;
#pragma unroll
  for (int r = 0; r < 16; ++r) ps += p0[r];
#pragma unroll
  for (int r = 0; r < 16; ++r) ps += p1[r];
  { auto rr = __builtin_amdgcn_permlane32_swap(__float_as_uint(ps), __float_as_uint(ps), false, false);
    ps = __uint_as_float(rr[0]) + __uint_as_float(rr[1]); }
  l_reg = l_reg * alpha + ps;
#define PK4(P, BASE, OUT) do { unsigned a0 = cvtpk(P[BASE + 0], P[BASE + 1]), a1 = cvtpk(P[BASE + 2], P[BASE + 3]);   \
    unsigned b0 = cvtpk(P[BASE + 4], P[BASE + 5]), b1 = cvtpk(P[BASE + 6], P[BASE + 7]);                              \
    auto r0 = __builtin_amdgcn_permlane32_swap(a0, b0, false, false); auto r1 = __builtin_amdgcn_permlane32_swap(a1, b1, false, false); \
    u32x4 w = {r0[0], r1[0], r0[1], r1[1]}; OUT = *reinterpret_cast<bf16x8*>(&w); } while (0)
  PK4(p0, 0, pa0); PK4(p0, 8, pa1); PK4(p1, 0, pa2); PK4(p1, 8, pa3);
#undef PK4
}
__device__ __forceinline__ void qkt(f32x16& p0, f32x16& p1, const char* Ks, const bf16x8* qr, int r32, int hi) {
  p0 = f32x16{}; p1 = f32x16{};
#pragma unroll
  for (int d0 = 0; d0 < 8; ++d0) { int cb = (d0 * 16 + hi * 8) * 2;
    bf16x8 b0 = *reinterpret_cast<const bf16x8*>(Ks + KSWZ(r32, cb));
    bf16x8 b1 = *reinterpret_cast<const bf16x8*>(Ks + KSWZ(32 + r32, cb));
    p0 = __builtin_amdgcn_mfma_f32_32x32x16_bf16(b0, qr[d0], p0, 0, 0, 0);
    p1 = __builtin_amdgcn_mfma_f32_32x32x16_bf16(b1, qr[d0], p1, 0, 0, 0); }
}
__device__ __forceinline__ int v_st(int k, int c) { const int kk = (k & ~0xC) | ((k & 4) << 1) | ((k & 8) >> 1); return ((kk >> 3) * 4 + (c >> 5)) * 512 + ((kk & 7) * 32 + (c & 31)) * 2; }
__device__ __forceinline__ int v_rd_base(int lane) { return ((lane & 3) << 3) | (((lane >> 2) & 3) << 6) | (((lane >> 4) & 1) << 5) | (((lane >> 5) & 1) << 8); }
constexpr int v_rd_off(int d0, int ks, int half) { return d0 * 512 + ks * 4096 + half * 2048; }
template <int OFF> __device__ __forceinline__ s16x4 tr_read(int vb) {
  s16x4 r; asm volatile("ds_read_b64_tr_b16 %0, %1 offset:%2" : "=&v"(r) : "v"(vb), "i"(OFF) : "memory"); return r;
}
template <int D0> __device__ __forceinline__ void pv_one(f32x16& od, int vb, bf16x8 pa0, bf16x8 pa1, bf16x8 pa2, bf16x8 pa3) {
  const s16x4 l0 = tr_read<v_rd_off(D0, 0, 0)>(vb), h0 = tr_read<v_rd_off(D0, 0, 1)>(vb), l1 = tr_read<v_rd_off(D0, 1, 0)>(vb), h1 = tr_read<v_rd_off(D0, 1, 1)>(vb);
  const s16x4 l2 = tr_read<v_rd_off(D0, 2, 0)>(vb), h2 = tr_read<v_rd_off(D0, 2, 1)>(vb), l3 = tr_read<v_rd_off(D0, 3, 0)>(vb), h3 = tr_read<v_rd_off(D0, 3, 1)>(vb);
  asm volatile("s_waitcnt lgkmcnt(0)" ::: "memory"); SBAR();
#define PK(L, H) (bf16x8){L[0], L[1], L[2], L[3], H[0], H[1], H[2], H[3]}
  od = __builtin_amdgcn_mfma_f32_32x32x16_bf16(pa0, PK(l0, h0), od, 0, 0, 0);
  od = __builtin_amdgcn_mfma_f32_32x32x16_bf16(pa1, PK(l1, h1), od, 0, 0, 0);
  od = __builtin_amdgcn_mfma_f32_32x32x16_bf16(pa2, PK(l2, h2), od, 0, 0, 0);
  od = __builtin_amdgcn_mfma_f32_32x32x16_bf16(pa3, PK(l3, h3), od, 0, 0, 0);
#undef PK
}
__device__ __forceinline__ void pv_d0(f32x16* o, int vb, bf16x8 pa0, bf16x8 pa1, bf16x8 pa2, bf16x8 pa3) {
  pv_one<0>(o[0], vb, pa0, pa1, pa2, pa3); pv_one<1>(o[1], vb, pa0, pa1, pa2, pa3); pv_one<2>(o[2], vb, pa0, pa1, pa2, pa3); pv_one<3>(o[3], vb, pa0, pa1, pa2, pa3);
}

template <bool NB>
__device__ __forceinline__ void attn_body(const bf16_t* __restrict__ Qb, const bf16_t* __restrict__ K0, const bf16_t* __restrict__ V0, int nt0,
                                          const bf16_t* __restrict__ K1, const bf16_t* __restrict__ V1, int NT,
                                          bf16_t* __restrict__ Ob, char* lds, int nb_r0, int nb_krlo, int wave_s) {
  const int tid = tid_of(wave_s);
  const int wid = wave_s, lane = tid & 63, r32 = lane & 31, hi = lane >> 5;
  char* V_lds = lds; char* K_lds = lds + 2 * SHM_V;
  float* ws = (float*)(lds + 2 * SHM_V + 2 * SHM_K) + wid * 64; float* li_l = ws; float* al_l = ws + 32;
  float m_reg = -1e30f, l_reg = 0; f32x16 o[4] = {}; bf16x8 qr[8];
  const bf16_t* Qw = Qb + (size_t)(wid * QBLK + r32) * D + hi * 8;
#pragma unroll
  for (int d0 = 0; d0 < 8; ++d0) qr[d0] = ld8(Qw + d0 * 16);
  const int sr = tid >> 4, sc = (tid & 15) * 8, vst0 = v_st(sr, sc), vst1 = v_st(32 + sr, sc);
  const int vb0 = (int)(uintptr_t)V_lds + v_rd_base(lane);
  const int nq_r = nb_r0 + (wid >> 1), nq_c = 32 * (wid & 1) + r32;
  const int nrs = min(max(nq_r - 4, 0), 8), ncs = min(max(nq_c - 8, 0), 48);
  const float* btab = (const float*)(lds + BIAS_OFF) + 64 + 15 - nq_c + 4 * hi;
  struct { bf16x8 vs0, vs1, ks0, ks1; } sr_[2];
#define KPTR(j) ((j) < nt0 ? K0 + (size_t)(j) * (KVBLK * D) : K1 + (size_t)((j) - nt0) * (KVBLK * D))
#define VPTR(j) ((j) < nt0 ? V0 + (size_t)(j) * (KVBLK * D) : V1 + (size_t)((j) - nt0) * (KVBLK * D))
#define SLOAD(i, j) do { const bf16_t* kp_ = KPTR(j); const bf16_t* vp_ = VPTR(j); \
    sr_[i].vs0 = ld8(vp_ + sr * D + sc); sr_[i].vs1 = ld8(vp_ + (32 + sr) * D + sc); \
    sr_[i].ks0 = ld8(kp_ + sr * D + sc); sr_[i].ks1 = ld8(kp_ + (32 + sr) * D + sc); } while (0)
#define SWRITE(b, i) do { *(bf16x8*)(V_lds + (b) * SHM_V + vst0) = sr_[i].vs0;          \
    *(bf16x8*)(V_lds + (b) * SHM_V + vst1) = sr_[i].vs1; int kc = sc * 2;               \
    *(bf16x8*)(K_lds + (b) * SHM_K + KSWZ(sr, kc)) = sr_[i].ks0;                       \
    *(bf16x8*)(K_lds + (b) * SHM_K + KSWZ(32 + sr, kc)) = sr_[i].ks1; } while (0)
#define SWAIT() asm volatile("s_waitcnt vmcnt(4)" ::: "memory")
#define RESC(a) do { if (__any((a) < 1.f)) { if (hi == 0) al_l[r32] = (a); asm volatile("s_waitcnt lgkmcnt(0)" ::: "memory"); \
    _Pragma("unroll") for (int d = 0; d < 4; ++d) _Pragma("unroll") for (int r = 0; r < 16; ++r) o[d][r] *= al_l[crow(r, hi)]; } } while (0)
#define NBMASK(P0, P1, j) do { if (NB && (j) >= 4) { const int kr_ = nb_krlo + (j) - 4; \
    if ((unsigned)(kr_ - nrs) >= 8u) { _Pragma("unroll") for (int r = 0; r < 16; ++r) { P0[r] = -1e30f; P1[r] = -1e30f; } } \
    else { const float* tb_ = btab + (kr_ - nq_r + 7) * 31; const int kb_ = 4 * hi - ncs; \
      _Pragma("unroll") for (int r = 0; r < 16; ++r) { const int c0_ = (r & 3) + 8 * (r >> 2); \
        P0[r] = ((unsigned)(kb_ + c0_) < 16u) ? P0[r] + tb_[c0_] : -1e30f; \
        P1[r] = ((unsigned)(kb_ + c0_ + 32) < 16u) ? P1[r] + tb_[c0_ + 32] : -1e30f; } } } } while (0)
  f32x16 pA0, pA1, pB0, pB1; float mnA, mnB, alA, alB; bf16x8 pa0, pa1, pa2, pa3;
  constexpr int SE = 0, SO = 1;
  SLOAD(SE, 0); SLOAD(SO, 1); asm volatile("s_waitcnt vmcnt(4)" ::: "memory"); SWRITE(0, SE); __syncthreads();
  qkt(pA0, pA1, K_lds, qr, r32, hi); partialSM(pA0, pA1, m_reg, mnA, alA);
  if (2 < NT) { SLOAD(SE, 2); SWAIT(); } else { asm volatile("s_waitcnt vmcnt(0)" ::: "memory"); }
  SWRITE(1, SO); __syncthreads();
  for (int j = 1; j + 1 < NT; j += 2) {
    SBAR(); qkt(pB0, pB1, K_lds + SHM_K, qr, r32, hi);
    finishSM(pA0, pA1, alA, l_reg, pa0, pa1, pa2, pa3); SBAR();
    SLOAD(SO, j + 2); SBAR();
    pv_d0(o, vb0, pa0, pa1, pa2, pa3); NBMASK(pB0, pB1, j); partialSM(pB0, pB1, m_reg, mnB, alB);
    __syncthreads(); SWAIT(); SWRITE(0, SE);
    RESC(alB); __syncthreads();
    SBAR(); qkt(pA0, pA1, K_lds, qr, r32, hi);
    finishSM(pB0, pB1, alB, l_reg, pa0, pa1, pa2, pa3); SBAR();
    if (j + 3 < NT) SLOAD(SE, j + 3); SBAR();
    pv_d0(o, vb0 + SHM_V, pa0, pa1, pa2, pa3); NBMASK(pA0, pA1, j + 1); partialSM(pA0, pA1, m_reg, mnA, alA);
    __syncthreads(); SWAIT(); SWRITE(1, SO);
    RESC(alA); __syncthreads();
  }
  SBAR(); qkt(pB0, pB1, K_lds + SHM_K, qr, r32, hi);
  finishSM(pA0, pA1, alA, l_reg, pa0, pa1, pa2, pa3); SBAR();
  pv_d0(o, vb0, pa0, pa1, pa2, pa3); NBMASK(pB0, pB1, NT - 1); partialSM(pB0, pB1, m_reg, mnB, alB);
  __syncthreads(); RESC(alB);
  finishSM(pB0, pB1, alB, l_reg, pa0, pa1, pa2, pa3); SBAR();
  pv_d0(o, vb0 + SHM_V, pa0, pa1, pa2, pa3);
  if (hi == 0) li_l[r32] = l_reg; asm volatile("s_waitcnt lgkmcnt(0)" ::: "memory");
  float rli[16];
#pragma unroll
  for (int r = 0; r < 16; ++r) rli[r] = __builtin_amdgcn_rcpf(li_l[crow(r, hi)]);
  char* ost = lds + OST_OFF + wid * OST_WAVE;
#pragma unroll
  for (int r = 0; r < 16; ++r) { const int orow = crow(r, hi);
#pragma unroll
    for (int d0 = 0; d0 < 4; ++d0) { const float v = o[d0][r] * rli[r]; *(bf16_t*)(ost + orow * 272 + (d0 * 32 + r32) * 2) = (bf16_t)(cvtpk(v, v) & 0xffffu); } }
  asm volatile("s_waitcnt lgkmcnt(0)" ::: "memory");
  bf16_t* Ow = Ob + (size_t)(wid * QBLK) * DM;
#pragma unroll
  for (int i = 0; i < 8; ++i) { const int row = (lane >> 4) + 4 * i, ch = lane & 15;
    const u32x4 w = *(const u32x4*)(ost + row * 272 + ch * 16);
    *(u32x4*)(Ow + (size_t)row * DM + ch * 8) = w; }
#undef KPTR
#undef VPTR
#undef SLOAD
#undef SWRITE
#undef SWAIT
#undef RESC
#undef NBMASK
}
}

__device__ __forceinline__ unsigned f2bf(float f) { unsigned u = __builtin_bit_cast(unsigned, f); return (u + 0x7fffu + ((u >> 16) & 1u)) >> 16; }
__device__ __forceinline__ unsigned pk2(float lo, float hi) { return f2bf(lo) | (f2bf(hi) << 16); }
#define LDS_WAIT() asm volatile("s_waitcnt lgkmcnt(0)" ::: "memory")
template <bool UPMAP> __device__ __forceinline__ void transpose_item(const float* __restrict__ W, int K, int N, bf16_t* __restrict__ WT, LAS float* scr, int item, int lane) {
    const int nblk = N / 32, kb = item / nblk, nb = item % nblk, k0 = 64 * kb, n0 = 32 * nb;
    const int d0 = UPMAP ? (n0 < DFF ? (n0 >> 7) * 256 + (n0 & 127) : ((n0 - DFF) >> 7) * 256 + 128 + ((n0 - DFF) & 127)) : n0;
    {
        const int r8 = lane >> 3, c4 = lane & 7;
        f32x4 v[8];
#pragma unroll
        for (int g = 0; g < 8; ++g) v[g] = *(const f32x4*)(W + (size_t)(k0 + 8 * g + r8) * N + n0 + 4 * c4);
#pragma unroll
        for (int g = 0; g < 8; ++g) { LAS float* d = scr + (8 * g + r8) * 33 + 4 * c4; d[0] = v[g][0]; d[1] = v[g][1]; d[2] = v[g][2]; d[3] = v[g][3]; }
    }
    LDS_WAIT(); asm volatile("" ::: "memory");
    const int c = lane & 7;
#pragma unroll
    for (int j = 0; j < 4; ++j) { const int n = (lane >> 3) + 8 * j; const LAS float* s = scr + (8 * c) * 33 + n;
        u32x4 o; o.x = pk2(s[0 * 33], s[1 * 33]); o.y = pk2(s[2 * 33], s[3 * 33]); o.z = pk2(s[4 * 33], s[5 * 33]); o.w = pk2(s[6 * 33], s[7 * 33]);
        *(u32x4*)(WT + (size_t)(d0 + n) * K + k0 + 8 * c) = o; }
    LDS_WAIT(); asm volatile("" ::: "memory");
}

struct Args { const float* in[23]; float* out; unsigned char* ws; int ph_lo, ph_hi; };

__global__ void __launch_bounds__(512, 2) mk_fwd(Args args) {
    extern __shared__ __attribute__((aligned(16))) unsigned char lds[];
    cg::grid_group grid = cg::this_grid();
    const int G = gridDim.x, bx = blockIdx.x, NGW = G * 8;
    const int wave_s = __builtin_amdgcn_readfirstlane((int)threadIdx.x >> 6);
#define PHASE_IDS const int tid = tid_of(wave_s); const int lane = tid & 63, wave = wave_s; \
    const int gw = bx * 8 + wave, gwi = wave * G + bx; (void)lane; (void)gw; (void)gwi; (void)tid;
#define ws (args.ws)
#define x_prompt (args.in[0])
#define x_sample (args.in[1])
#define cvec (args.in[2])
#define cache_a_k (args.in[3])
#define cache_a_v (args.in[4])
#define cache_b_k (args.in[5])
#define cache_b_v (args.in[6])
#define c_ctx (args.in[7])
#define w_mod (args.in[8])
#define b_mod (args.in[9])
#define g_attn_pre (args.in[10])
#define g_attn_post (args.in[11])
#define g_ffn_pre (args.in[12])
#define g_ffn_post (args.in[13])
#define w_in (args.in[14])
#define rpb (args.in[15])
#define g_qnorm (args.in[16])
#define g_knorm (args.in[17])
#define w_out (args.in[18])
#define w_up (args.in[19])
#define conv_w (args.in[20])
#define conv_b (args.in[21])
#define w_down (args.in[22])
#define Y_ (args.out)
#define st_ak (args.out + (size_t)MTOK * DM)
#define st_av (args.out + (size_t)MTOK * DM + (size_t)32 * 8 * 256 * 128)
#define st_bk (args.out + (size_t)MTOK * DM + (size_t)2 * 32 * 8 * 256 * 128)
#define st_bv (args.out + (size_t)MTOK * DM + (size_t)2 * 32 * 8 * 256 * 128 + (size_t)32 * 2 * 256 * 128)
#define MOD ((float*)(ws + WS_MOD))
#define MODP ((float*)(ws + WS_MODP))
#define WIN ((bf16_t*)(ws + WS_WIN))
#define WOUT ((bf16_t*)(ws + WS_WOUT))
#define WUP ((bf16_t*)(ws + WS_WUP))
#define WDN ((bf16_t*)(ws + WS_WDN))
#define XN ((bf16_t*)(ws + WS_XN))
#define CAK ((bf16_t*)(ws + WS_CAK))
#define CAV ((bf16_t*)(ws + WS_CAV))
#define CBK ((bf16_t*)(ws + WS_CBK))
#define CBV ((bf16_t*)(ws + WS_CBV))
#define QA ((bf16_t*)(ws + WS_QA))
#define KA ((bf16_t*)(ws + WS_KA))
#define VA ((bf16_t*)(ws + WS_VA))
#define QB ((bf16_t*)(ws + WS_QB))
#define KB ((bf16_t*)(ws + WS_KB))
#define VB ((bf16_t*)(ws + WS_VB))
#define OB ((bf16_t*)(ws + WS_O))
#define P1 ((bf16_t*)(ws + WS_P1))
#define P2 ((bf16_t*)(ws + WS_P2))
#define ACT ((bf16_t*)(ws + WS_ACT))
#define HBUF ((float*)(ws + WS_U))
    LAS unsigned char* ldsl = (LAS unsigned char*)lds;

    const int lo = args.ph_lo, hi = args.ph_hi;
#ifndef PH_MASK
#define PH_MASK 0xFFF
#endif
#define IN(k) (((PH_MASK >> (k)) & 1) && lo <= (k) && (k) < hi)
    { const int t0 = tid_of(wave_s); if (t0 < 16) ((volatile LAS unsigned*)(ldsl + MISC_OFF))[t0] = 0u; }
    __syncthreads();
    const XcdBarrier xbar = xcd_barrier_post((unsigned*)(ws + WS_CTL), (volatile LAS unsigned*)(ldsl + MISC_OFF), wave_s);
#define SEAM(k) do { if (IN(k) && IN((k) + 1)) { if ((k) == 0) grid.sync(); else xcd_barrier(xbar, wave_s); } } while (0)

    if (IN(0)) {
        PHASE_IDS
        LAS float* cs = (LAS float*)ldsl;
        for (int idx = tid; idx < 9 * 2048; idx += 512) { const int j = idx >> 11, k = idx & 2047; const float c = (j == 0) ? c_ctx[k] : cvec[(j - 1) * 2048 + k];
            cs[k * 9 + j] = c / (1.f + __expf(-c)); }
        __syncthreads();
        for (int ch = bx; ch < 256; ch += G) {
            const int vc = (ch & 7) * 32 + (ch >> 3), rsub = lane / 12, c4 = lane - 12 * rsub;
            f32x4 acc[9];
#pragma unroll
            for (int j = 0; j < 9; ++j) acc[j] = (f32x4){0.f, 0.f, 0.f, 0.f};
            if (rsub < 5) {
                const float* wp = w_mod + (size_t)(wave * 256 + rsub) * NMOD + vc * 48 + 4 * c4;
                const LAS float* sp = cs + (wave * 256 + rsub) * 9;
#pragma unroll 8
                for (int it = 0; it < 51; ++it) {
                    const f32x4 w = *(const f32x4*)(wp + (size_t)(5 * it) * NMOD);
                    const LAS float* s2 = sp + 45 * it;
#pragma unroll
                    for (int j = 0; j < 9; ++j) acc[j] += w * s2[j];
                }
                if (rsub == 0) {
                    const f32x4 w = *(const f32x4*)(wp + (size_t)255 * NMOD);
                    const LAS float* s2 = sp + 9 * 255;
#pragma unroll
                    for (int j = 0; j < 9; ++j) acc[j] += w * s2[j];
                }
            }
            __syncthreads();
            LAS float* red = (LAS float*)ldsl;
#pragma unroll
            for (int j = 0; j < 9; ++j) *(LAS f32x4*)(red + tid * 36 + 4 * j) = acc[j];
            __syncthreads();
            if (tid < 432) { const int j = tid / 48, col = tid - 48 * j, cc = col >> 2, e = col & 3;
                float sum = b_mod[vc * 48 + col];
#pragma unroll
                for (int w = 0; w < 8; ++w)
#pragma unroll
                    for (int r5 = 0; r5 < 5; ++r5) sum += red[(w * 64 + r5 * 12 + cc) * 36 + 4 * j + e];
                MOD[(size_t)j * NMOD + vc * 48 + col] = sum; }
            __syncthreads();
            if (ch + G < 256) {
                for (int idx = tid; idx < 9 * 2048; idx += 512) { const int j = idx >> 11, k = idx & 2047; const float c = (j == 0) ? c_ctx[k] : cvec[(j - 1) * 2048 + k];
                    cs[k * 9 + j] = c / (1.f + __expf(-c)); }
                __syncthreads();
            }
        }
        LAS float* scr = (LAS float*)(ldsl + wave * 8448);
        constexpr int I_IN = 32 * 144, I_OUT = 32 * 64;
        for (int it = gwi; it < I_IN + I_OUT; it += NGW) {
            if (it < I_IN) transpose_item<false>(w_in, DM, NIN, WIN, scr, it, lane);
            else transpose_item<false>(w_out, DM, DM, WOUT, scr, it - I_IN, lane);
        }
        {
            constexpr int NA8 = 8 * 8 * 256 * 128 / 8, NB8 = 8 * 2 * 256 * 128 / 8;
            for (int i = bx * 512 + tid; i < 2 * NA8 + 2 * NB8; i += G * 512) {
                const float* src; bf16_t* dst; int j = i;
                if (j < NA8) { src = cache_a_k; dst = CAK; } else if ((j -= NA8) < NA8) { src = cache_a_v; dst = CAV; }
                else if ((j -= NA8) < NB8) { src = cache_b_k; dst = CBK; } else { j -= NB8; src = cache_b_v; dst = CBV; }
                const f32x4 a = *(const f32x4*)(src + (size_t)j * 8), b = *(const f32x4*)(src + (size_t)j * 8 + 4);
                u32x4 w; w.x = cvt_pk_bf16(a[0], a[1]); w.y = cvt_pk_bf16(a[2], a[3]); w.z = cvt_pk_bf16(b[0], b[1]); w.w = cvt_pk_bf16(b[2], b[3]);
                *(u32x4*)(dst + (size_t)j * 8) = w;
            }
        }
    }
    SEAM(0);
    if (IN(2)) {
        PHASE_IDS
        for (int m = 2 * gw; m < MTOK; m += 2 * NGW) {
            const float* xr = (m < NCTX) ? x_prompt + (size_t)m * DM : x_sample + (size_t)(m - NCTX) * DM;
            const float* md = MOD + (size_t)((m < NCTX) ? 0 : 1 + ((m - NCTX) >> 10)) * NMOD;
            f32x4 v[2][8]; float ss[2] = {0.f, 0.f};
#pragma unroll
            for (int r2 = 0; r2 < 2; ++r2)
#pragma unroll
                for (int i = 0; i < 8; ++i) v[r2][i] = *(const f32x4*)(xr + (size_t)r2 * DM + 4 * lane + 256 * i);
#pragma unroll
            for (int r2 = 0; r2 < 2; ++r2)
#pragma unroll
                for (int i = 0; i < 8; ++i) ss[r2] += (v[r2][i][0] * v[r2][i][0] + v[r2][i][1] * v[r2][i][1]) + (v[r2][i][2] * v[r2][i][2] + v[r2][i][3] * v[r2][i][3]);
            const float rstd0 = rsqrtf(wave_sum(ss[0]) * (1.f / DM) + EPS), rstd1 = rsqrtf(wave_sum(ss[1]) * (1.f / DM) + EPS);
            bf16_t* orow = XN + (size_t)m * DM;
#pragma unroll
            for (int i = 0; i < 8; ++i) { const int c = 4 * lane + 256 * i;
                const f32x4 g = *(const f32x4*)(g_attn_pre + c), sh = *(const f32x4*)(md + c), sc = *(const f32x4*)(md + 2048 + c);
                const f32x4 gs = g * (sc + 1.f);
                const f32x4 r0 = v[0][i] * rstd0 * gs + sh, r1 = v[1][i] * rstd1 * gs + sh;
                u32x2 w0, w1; w0.x = cvt_pk_bf16(r0[0], r0[1]); w0.y = cvt_pk_bf16(r0[2], r0[3]); w1.x = cvt_pk_bf16(r1[0], r1[1]); w1.y = cvt_pk_bf16(r1[2], r1[3]);
                *(u32x2*)(orow + c) = w0; *(u32x2*)(orow + DM + c) = w1; }
        }
    }
    SEAM(2);
    if (IN(3)) {
        PHASE_IDS
        pg8::Gemm g{XN, WIN, MTOK, NIN, DM}; pg8::StaticOrder S; S.init(MTOK, NIN, G, bx);
        pg8::EpiQKV E{QA, KA, VA, QB, KB, VB, st_ak, st_av, st_bv};
        const int hb = G >> 1;
        if (bx >= hb) {
            LAS float* scr = (LAS float*)(ldsl + wave * 8448);
            constexpr int I_UP = 32 * 352, I_DN = 88 * 64;
            for (int it = wave * (G - hb) + (bx - hb); it < I_UP + I_DN; it += 8 * (G - hb)) {
                if (it < I_UP) transpose_item<true>(w_up, DM, NUP, WUP, scr, it, lane);
                else transpose_item<false>(w_down, DFF, DM, WDN, scr, it - I_UP, lane);
            }
            __syncthreads();
        }
        pg8::gemm_phase<pg8::EpiQKV, pg8::StaticOrder, true>(ldsl, g, S, E, wave_s);
    }
    SEAM(3);
    if (IN(4)) {
        PHASE_IDS
        const int vs = lane >> 3, part = lane & 7, hsel = part >> 2;
        const int ib = 16 * (part & 1);
        const float sgn = (part & 2) ? 1.f : -1.f;
        constexpr int NIQ = MTOK * 8 / 8, NIK = MTOK * 2 / 8;
        for (int itv = gw; itv < NIQ + NIK; itv += NGW) {
            const bool isq = itv < NIQ; const int H = isq ? 8 : 2;
            const int vv = (isq ? itv : itv - NIQ) * 8 + vs;
            bf16_t* p = (isq ? QB : KB) + (size_t)vv * 128 + 16 * part;
            const float* gp = (isq ? g_qnorm : g_knorm) + 16 * part;
            const u32x4 w0 = *(const u32x4*)p, w1 = *(const u32x4*)(p + 8);
            float e[16];
#pragma unroll
            for (int q = 0; q < 4; ++q) { e[2 * q] = bf_lo(w0[q]); e[2 * q + 1] = bf_hi(w0[q]); e[8 + 2 * q] = bf_lo(w1[q]); e[8 + 2 * q + 1] = bf_hi(w1[q]); }
            float ss = 0.f;
#pragma unroll
            for (int j = 0; j < 16; ++j) ss += e[j] * e[j];
            ss += __shfl_xor(ss, 1); ss += __shfl_xor(ss, 2); ss += __shfl_xor(ss, 4);
            const float rstd = rsqrtf(ss * (1.f / 128.f) + EPS);
#pragma unroll
            for (int q = 0; q < 4; ++q) { const f32x4 g = *(const f32x4*)(gp + 4 * q);
#pragma unroll
                for (int t = 0; t < 4; ++t) e[4 * q + t] *= rstd * g[t]; }
            const int nctxv = NCTX * H;
            if (vv >= nctxv) {
                const int t = (vv - nctxv) & 1023; const float pos = (float)(hsel ? (t & 63) : (t >> 6));
#pragma unroll
                for (int j = 0; j < 16; ++j) {
                    const float other = __shfl_xor(e[j], 2);
                    float rev = pos * (exp2f(-(float)(ib + j) * (13.287712379549449f / 32.f)) * 0.15915494309189535f); rev -= floorf(rev);
                    const float sn = __builtin_amdgcn_sinf(rev), cn = __builtin_amdgcn_cosf(rev);
                    e[j] = e[j] * cn + sgn * other * sn;
                }
            } else if (!isq) {
                float* sp = st_bk + (size_t)vv * 128 + 16 * part;
#pragma unroll
                for (int q = 0; q < 4; ++q) *(f32x4*)(sp + 4 * q) = (f32x4){e[4 * q], e[4 * q + 1], e[4 * q + 2], e[4 * q + 3]};
            }
            u32x4 o0, o1;
#pragma unroll
            for (int q = 0; q < 4; ++q) { o0[q] = cvt_pk_bf16(e[2 * q], e[2 * q + 1]); o1[q] = cvt_pk_bf16(e[8 + 2 * q], e[8 + 2 * q + 1]); }
            *(u32x4*)p = o0; *(u32x4*)(p + 8) = o1;
        }
    }
    SEAM(4);
    if (IN(5)) {
        PHASE_IDS
        char* al = (char*)lds;
#ifndef AT_MASK
#define AT_MASK 15
#endif
        if (AT_MASK & 1) for (int u0 = bx; u0 < 256; u0 += G) { const int u = (G == 256) ? ((u0 & 7) * 32 + (u0 >> 3)) : u0;
                const int b = u >> 3, h = u & 7; const size_t off = ((size_t)(b * 8 + h) * 256) * 128;
                att::attn_body<false>(QA + off, KA + off, VA + off, 4, KA + off, VA + off, 4, OB + (size_t)(b * 256) * DM + h * 128, al, 0, 0, wave_s);
                __syncthreads();
        }
        if (AT_MASK & 2) for (int u0 = bx; u0 < 256; u0 += G) { const int u = (G == 256) ? ((u0 & 7) * 32 + (u0 >> 3)) : u0;
                const int b = u >> 3, qh = u & 7, kvh = qh >> 2; const size_t qoff = ((size_t)(b * 8 + qh) * 256) * 128, koff = ((size_t)(b * 2 + kvh) * 256) * 128;
                att::attn_body<false>(QB + qoff, KB + koff, VB + koff, 4, KB + koff, VB + koff, 4, OB + (size_t)(b * 256) * DM + 1024 + qh * 128, al, 0, 0, wave_s);
                __syncthreads();
        }
        if (AT_MASK & 4) for (int u0 = bx; u0 < 256; u0 += G) { const int u = (G == 256) ? ((u0 & 7) * 32 + (u0 >> 3)) : u0;
                const int b = u >> 5, qh = (u >> 2) & 7, qb = u & 3, kvh = qh >> 2;
                const size_t qoff = (size_t)NCTX * 8 * 128 + ((size_t)(b * 8 + qh) * 1024 + qb * 256) * 128;
                const size_t coff = ((size_t)(b * 2 + kvh) * 256) * 128, koff = (size_t)NCTX * 2 * 128 + ((size_t)(b * 2 + kvh) * 1024) * 128;
                att::attn_body<false>(QB + qoff, CBK + coff, CBV + coff, 4, KB + koff, VB + koff, 20, OB + (size_t)(NCTX + b * 1024 + qb * 256) * DM + 1024 + qh * 128, al, 0, 0, wave_s);
                __syncthreads();
        }
        if (AT_MASK & 8) for (int u0 = bx; u0 < 256; u0 += G) { const int u = (G == 256) ? ((u0 & 7) * 32 + (u0 >> 3)) : u0;
                const int b = u >> 5, h = (u >> 2) & 7, qb = u & 3;
                float* bt = (float*)(al + att::BIAS_OFF);
                for (int i = tid; i < att::BIAS_FLOATS; i += 512) { const int k = i - 64; bt[i] = (k >= 0 && k < 465) ? rpb[h * 465 + k] * (1.f / att::SCALE) : 0.f; }
                const int krlo = (qb == 0 || qb == 1) ? 0 : (qb == 2 ? 4 : 8), nrows = (qb == 0 || qb == 3) ? 8 : 12;
                const size_t qoff = (size_t)NCTX * 8 * 128 + ((size_t)(b * 8 + h) * 1024 + qb * 256) * 128;
                const size_t coff = ((size_t)(b * 8 + h) * 256) * 128, koff = (size_t)NCTX * 8 * 128 + ((size_t)(b * 8 + h) * 1024 + krlo * 64) * 128;
                att::attn_body<true>(QA + qoff, CAK + coff, CAV + coff, 4, KA + koff, VA + koff, 4 + nrows, OB + (size_t)(NCTX + b * 1024 + qb * 256) * DM + h * 128, al, qb * 4, krlo, wave_s);
                __syncthreads();
        }
    }
    SEAM(5);
    if (IN(6)) {
        pg8::Gemm g{OB, WOUT, MTOK, DM, DM}; pg8::StaticOrder S; S.init(MTOK, DM, G, bx);
        pg8::EpiBf16 E{P1, DM};
        pg8::gemm_phase<pg8::EpiBf16, pg8::StaticOrder, true>(ldsl, g, S, E, wave_s);
    }
    SEAM(6);
    if (IN(7)) {
        PHASE_IDS
        for (int m = 2 * gw; m < MTOK; m += 2 * NGW) {
            const float* xr = (m < NCTX) ? x_prompt + (size_t)m * DM : x_sample + (size_t)(m - NCTX) * DM;
            const float* md = MOD + (size_t)((m < NCTX) ? 0 : 1 + ((m - NCTX) >> 10)) * NMOD;
            const bf16_t* pr = P1 + (size_t)m * DM;
            float v[2][4][8]; float ss[2] = {0.f, 0.f};
            u32x4 pw[2][4];
#pragma unroll
            for (int r2 = 0; r2 < 2; ++r2)
#pragma unroll
                for (int i = 0; i < 4; ++i) pw[r2][i] = *(const u32x4*)(pr + (size_t)r2 * DM + 8 * lane + 512 * i);
#pragma unroll
            for (int r2 = 0; r2 < 2; ++r2)
#pragma unroll
                for (int i = 0; i < 4; ++i)
#pragma unroll
                    for (int q = 0; q < 4; ++q) { const float lo_ = bf_lo(pw[r2][i][q]), hi_ = bf_hi(pw[r2][i][q]); v[r2][i][2 * q] = lo_; v[r2][i][2 * q + 1] = hi_; ss[r2] += lo_ * lo_ + hi_ * hi_; }
            float rstd[2]; rstd[0] = rsqrtf(wave_sum(ss[0]) * (1.f / DM) + EPS); rstd[1] = rsqrtf(wave_sum(ss[1]) * (1.f / DM) + EPS);
            float ss2[2] = {0.f, 0.f};
#pragma unroll
            for (int i = 0; i < 4; ++i) { const int c = 8 * lane + 512 * i;
#pragma unroll
                for (int h2 = 0; h2 < 2; ++h2) {
                    const f32x4 g = *(const f32x4*)(g_attn_post + c + 4 * h2), ga = *(const f32x4*)(md + 4096 + c + 4 * h2);
                    const f32x4 gg = g * ga;
#pragma unroll
                    for (int r2 = 0; r2 < 2; ++r2) {
                        const f32x4 xv = *(const f32x4*)(xr + (size_t)r2 * DM + c + 4 * h2);
                        f32x4 r;
#pragma unroll
                        for (int e = 0; e < 4; ++e) { r[e] = xv[e] + gg[e] * (v[r2][i][4 * h2 + e] * rstd[r2]); v[r2][i][4 * h2 + e] = r[e]; ss2[r2] += r[e] * r[e]; }
                        *(f32x4*)(Y_ + (size_t)(m + r2) * DM + c + 4 * h2) = r; } } }
            float rs2[2]; rs2[0] = rsqrtf(wave_sum(ss2[0]) * (1.f / DM) + EPS); rs2[1] = rsqrtf(wave_sum(ss2[1]) * (1.f / DM) + EPS);
            bf16_t* orow = XN + (size_t)m * DM;
#pragma unroll
            for (int i = 0; i < 4; ++i) { const int c = 8 * lane + 512 * i;
                float gsv[8], shv[8];
#pragma unroll
                for (int h2 = 0; h2 < 2; ++h2) {
                    const f32x4 g = *(const f32x4*)(g_ffn_pre + c + 4 * h2), sh = *(const f32x4*)(md + 6144 + c + 4 * h2), sc = *(const f32x4*)(md + 8192 + c + 4 * h2);
#pragma unroll
                    for (int e = 0; e < 4; ++e) { gsv[4 * h2 + e] = g[e] * (sc[e] + 1.f); shv[4 * h2 + e] = sh[e]; } }
#pragma unroll
                for (int r2 = 0; r2 < 2; ++r2) {
                    float r[8];
#pragma unroll
                    for (int e = 0; e < 8; ++e) r[e] = v[r2][i][e] * rs2[r2] * gsv[e] + shv[e];
                    u32x4 w; w.x = cvt_pk_bf16(r[0], r[1]); w.y = cvt_pk_bf16(r[2], r[3]); w.z = cvt_pk_bf16(r[4], r[5]); w.w = cvt_pk_bf16(r[6], r[7]);
                    *(u32x4*)(orow + (size_t)r2 * DM + c) = w; } }
        }
    }
    SEAM(7);
    if (IN(8)) {
        pg8::Gemm g{XN, WUP, MTOK, NUP, DM}; pg8::StaticOrder S; S.init(MTOK, NUP, G, bx);
        pg8::EpiConv E{ACT, HBUF, conv_w, conv_b, (LAS float*)(ldsl + 131072)};
        pg8::gemm_phase<pg8::EpiConv, pg8::StaticOrder, true>(ldsl, g, S, E, wave_s);
    }
    SEAM(8);
    if (IN(9)) {
        PHASE_IDS
        for (int it = gw; it < 32 * 2 * 22; it += NGW) {
            const int seg = it % 22, side = (it / 22) & 1, lt = it / 44; const int q = lt & 3;
            if ((side == 0 && q == 0) || (side == 1 && q == 3)) continue;
            const int ch = seg * 256 + lane * 4;
            f32x4 r[2];
#pragma unroll
            for (int bj = 0; bj < 2; ++bj) {
                const float* hp = HBUF + (size_t)bj * DFF + ch;
                const f32x4 up = *(const f32x4*)(hp + (size_t)((side ? lt * 4 + 2 : (lt - 1) * 4 + 3) * 2) * DFF);
                const f32x4 cu = *(const f32x4*)(hp + (size_t)((side ? lt * 4 + 3 : lt * 4 + 0) * 2) * DFF);
                const f32x4 dn = *(const f32x4*)(hp + (size_t)((side ? (lt + 1) * 4 + 0 : lt * 4 + 1) * 2) * DFF);
                const f32x4 w0 = *(const f32x4*)(conv_w + bj * DFF + ch), w1 = *(const f32x4*)(conv_w + NUP + bj * DFF + ch), w2 = *(const f32x4*)(conv_w + 2 * NUP + bj * DFF + ch);
                r[bj] = w0 * up + w1 * cu + w2 * dn + *(const f32x4*)(conv_b + bj * DFF + ch);
            }
            float a[4];
#pragma unroll
            for (int e = 0; e < 4; ++e) a[e] = r[1][e] * __builtin_amdgcn_rcpf(1.f + __expf(-r[1][e])) * r[0][e];
            u32x2 ow; ow.x = cvt_pk_bf16(a[0], a[1]); ow.y = cvt_pk_bf16(a[2], a[3]);
            *(u32x2*)(ACT + (size_t)(NCTX + lt * 256 + (side ? 255 : 0)) * DFF + ch) = ow;
        }
    }
    SEAM(9);
    if (IN(10)) {
        PHASE_IDS
        pg8::Gemm g{ACT, WDN, MTOK, DM, DFF}; pg8::StaticOrder S; S.init(MTOK, DM, G, bx);
        pg8::EpiBf16 E{P2, DM};
        pg8::gemm_phase<pg8::EpiBf16, pg8::StaticOrder, true>(ldsl, g, S, E, wave_s);
    }
    SEAM(10);
    if (IN(11)) {
        PHASE_IDS
        for (int m = 2 * gw; m < MTOK; m += 2 * NGW) {
            const float* md = MOD + (size_t)((m < NCTX) ? 0 : 1 + ((m - NCTX) >> 10)) * NMOD;
            const bf16_t* pr = P2 + (size_t)m * DM;
            float v[2][4][8]; float ss[2] = {0.f, 0.f};
            u32x4 pw[2][4];
#pragma unroll
            for (int r2 = 0; r2 < 2; ++r2)
#pragma unroll
                for (int i = 0; i < 4; ++i) pw[r2][i] = *(const u32x4*)(pr + (size_t)r2 * DM + 8 * lane + 512 * i);
#pragma unroll
            for (int r2 = 0; r2 < 2; ++r2)
#pragma unroll
                for (int i = 0; i < 4; ++i)
#pragma unroll
                    for (int q = 0; q < 4; ++q) { const float lo_ = bf_lo(pw[r2][i][q]), hi_ = bf_hi(pw[r2][i][q]); v[r2][i][2 * q] = lo_; v[r2][i][2 * q + 1] = hi_; ss[r2] += lo_ * lo_ + hi_ * hi_; }
            float rstd[2]; rstd[0] = rsqrtf(wave_sum(ss[0]) * (1.f / DM) + EPS); rstd[1] = rsqrtf(wave_sum(ss[1]) * (1.f / DM) + EPS);
#pragma unroll
            for (int i = 0; i < 4; ++i) { const int c = 8 * lane + 512 * i;
#pragma unroll
                for (int h2 = 0; h2 < 2; ++h2) {
                    const f32x4 g = *(const f32x4*)(g_ffn_post + c + 4 * h2), ga = *(const f32x4*)(md + 10240 + c + 4 * h2);
                    const f32x4 gg = g * ga;
#pragma unroll
                    for (int r2 = 0; r2 < 2; ++r2) {
                        const f32x4 xv = *(const f32x4*)(Y_ + (size_t)(m + r2) * DM + c + 4 * h2);
                        f32x4 r;
#pragma unroll
                        for (int e = 0; e < 4; ++e) r[e] = xv[e] + gg[e] * (v[r2][i][4 * h2 + e] * rstd[r2]);
                        *(f32x4*)(Y_ + (size_t)(m + r2) * DM + c + 4 * h2) = r; } } }
        }
    }
#undef IN
#undef SEAM
#undef ws
#undef x_prompt
#undef x_sample
#undef cvec
#undef cache_a_k
#undef cache_a_v
#undef cache_b_k
#undef cache_b_v
#undef c_ctx
#undef w_mod
#undef b_mod
#undef g_attn_pre
#undef g_attn_post
#undef g_ffn_pre
#undef g_ffn_post
#undef w_in
#undef rpb
#undef g_qnorm
#undef g_knorm
#undef w_out
#undef w_up
#undef conv_w
#undef conv_b
#undef w_down
#undef Y_
#undef st_ak
#undef st_av
#undef st_bk
#undef st_bv
#undef MOD
#undef MODP
#undef WIN
#undef WOUT
#undef WUP
#undef WDN
#undef XN
#undef CAK
#undef CAV
#undef CBK
#undef CBV
#undef QA
#undef KA
#undef VA
#undef QB
#undef KB
#undef VB
#undef OB
#undef P1
#undef P2
#undef ACT
#undef HBUF
}

extern "C" void kernel_launch(void* const* d_in, const int* in_sizes, int n_in, void* d_out, int out_size, void* d_ws, size_t ws_size, hipStream_t stream) {
    static int grid = 0;
    if (grid == 0) {
        if (n_in != 23 || ws_size < WS_END) { fprintf(stderr, "kernel_launch: unexpected n_in %d or ws_size %zu (need %zu)\n", n_in, ws_size, (size_t)WS_END); grid = -1; return; }
        int dev = 0, cus = 0, per_cu = 0;
        hipGetDevice(&dev);
        hipDeviceGetAttribute(&cus, hipDeviceAttributeMultiprocessorCount, dev);
        if (hipFuncSetAttribute((const void*)mk_fwd, hipFuncAttributeMaxDynamicSharedMemorySize, LDS_BYTES) != hipSuccess) { fprintf(stderr, "kernel_launch: hipFuncSetAttribute failed\n"); grid = -1; return; }
        if (hipOccupancyMaxActiveBlocksPerMultiprocessor(&per_cu, (const void*)mk_fwd, 512, LDS_BYTES) != hipSuccess || per_cu < 1) { fprintf(stderr, "kernel_launch: occupancy query failed (%d)\n", per_cu); per_cu = 1; }
        (void)hipGetLastError();
        grid = cus * (per_cu > 1 ? 1 : per_cu);
        if (grid > 256) grid = 256;
    }
    if (grid < 0) return;
    if (hipMemsetAsync((char*)d_ws + WS_CTL, 0, CTL_BYTES, stream) != hipSuccess) { fprintf(stderr, "kernel_launch: memset failed\n"); return; }
    Args a{};
    for (int i = 0; i < 23; ++i) a.in[i] = (const float*)d_in[i];
    a.out = (float*)d_out; a.ws = (unsigned char*)d_ws; a.ph_lo = 0; a.ph_hi = 12;
    void* kargs[] = {&a};
    hipError_t e = hipLaunchCooperativeKernel((const void*)mk_fwd, dim3(grid), dim3(512), kargs, LDS_BYTES, stream);
    if (e != hipSuccess) fprintf(stderr, "kernel_launch: cooperative launch failed: %s (grid %d)\n", hipGetErrorString(e), grid);
}
```

```cpp
#include <hip/hip_runtime.h>
#include <hip/hip_cooperative_groups.h>
#include <cstdio>
#include <cstdint>
namespace cg = cooperative_groups;

#define LAS __attribute__((address_space(3)))
typedef unsigned short bf16_t;
typedef short bf16x8 __attribute__((ext_vector_type(8)));
typedef short s16x4 __attribute__((ext_vector_type(4)));
typedef float f32x4 __attribute__((ext_vector_type(4)));
typedef float f32x16 __attribute__((ext_vector_type(16)));
typedef unsigned u32x4 __attribute__((ext_vector_type(4)));
typedef unsigned u32x2 __attribute__((ext_vector_type(2)));

constexpr int DM = 2048, MTOK = 16384, NCTX = 8192, DFF = 5632, NUP = 11264, NIN = 4608, NMOD = 12288;
constexpr float EPS = 1e-6f;
constexpr int CHROWS = 4096;

constexpr size_t MiB = 1u << 20;
constexpr size_t WS_MOD = 0, WS_WDN = 1 * MiB, WS_XN = 23 * MiB, WS_WIN = 87 * MiB, WS_WOUT = 105 * MiB, WS_WUP = 113 * MiB;
constexpr size_t WS_CAK = 157 * MiB, WS_CAV = 161 * MiB, WS_CBK = 165 * MiB, WS_CBV = 166 * MiB;
constexpr size_t WS_QA = 167 * MiB, WS_KA = 199 * MiB, WS_VA = 231 * MiB, WS_QB = 263 * MiB, WS_KB = 295 * MiB, WS_VB = 303 * MiB;
constexpr size_t WS_O = 311 * MiB, WS_MODP = 311 * MiB;
constexpr size_t WS_P1 = 167 * MiB;
constexpr size_t WS_ACT = 157 * MiB, WS_U = 333 * MiB, WS_X1 = 341 * MiB;
constexpr size_t WS_P2 = 23 * MiB;
constexpr size_t WS_END = 421 * MiB;

constexpr int LDS_BYTES = 147456, MISC_OFF = 147200;
constexpr size_t WS_CTL = 512 * 1024, CTL_BYTES = 16384;

__device__ __forceinline__ unsigned cvt_pk_bf16(float lo, float hi) { unsigned r; asm volatile("v_cvt_pk_bf16_f32 %0, %1, %2" : "=v"(r) : "v"(lo), "v"(hi)); return r; }
__device__ __forceinline__ float bf_lo(unsigned w) { return __uint_as_float(w << 16); }
__device__ __forceinline__ float bf_hi(unsigned w) { return __uint_as_float(w & 0xffff0000u); }
__device__ __forceinline__ int tid_of(int wave_s) { unsigned z = 0u; asm volatile("" : "+v"(z));
    return wave_s * 64 + (int)__builtin_amdgcn_mbcnt_hi(~0u, __builtin_amdgcn_mbcnt_lo(~0u, z)); }
__device__ __forceinline__ float wave_sum(float v) {
#pragma unroll
    for (int o = 1; o < 64; o <<= 1) v += __shfl_xor(v, o);
    return v;
}


#define XB_TMO      128
#define XB_XCNT(j)  (256  + 64 * (j))
#define XB_XSUB(j)  (1280 + 64 * (j))
#define XB_XGEN(j)  (2304 + 64 * (j))
#define XB_TOP      3328
#define XB_TOPGEN   3392
#define XCD_BAR_WORDS 3456
#define XB_SPIN_CAP (1u << 18)
__device__ __forceinline__ unsigned xb_ld(unsigned* p)              { return __hip_atomic_load(p, __ATOMIC_RELAXED, __HIP_MEMORY_SCOPE_AGENT); }
__device__ __forceinline__ unsigned xb_add(unsigned* p, unsigned v) { return __hip_atomic_fetch_add(p, v, __ATOMIC_RELAXED, __HIP_MEMORY_SCOPE_AGENT); }
__device__ __forceinline__ unsigned xb_xcc_id() { return (unsigned)__builtin_amdgcn_s_getreg((3 << 11) | 20) & 0xFu; }
#define XB_SPIN(cond, bar) do { unsigned _sp = 0; while (cond) { __builtin_amdgcn_s_sleep(1); \
    if ((++_sp & 255u) == 0u) { if (xb_ld(&(bar)[XB_TMO])) break; if (_sp > XB_SPIN_CAP) { atomicAdd(&(bar)[XB_TMO], 1u); break; } } } } while (0)
struct XcdBarrier { unsigned* bar; unsigned x; volatile LAS unsigned* st; };
__device__ __forceinline__ XcdBarrier xcd_barrier_post(unsigned* bar, volatile LAS unsigned* st, int wave_s) {
    XcdBarrier b; b.bar = bar; b.x = xb_xcc_id(); b.st = st;
    if (tid_of(wave_s) == 0) (void)xb_add(&bar[XB_XCNT(b.x)], 1u);
    return b;
}
__device__ __forceinline__ void xcd_barrier_complete(unsigned* bar, unsigned x, unsigned& nloc, unsigned& nx) {
    const unsigned G = gridDim.x * gridDim.y * gridDim.z;
    unsigned sum, cnt, mine, sp = 0u;
    for (;;) {
        sum = 0u; cnt = 0u; mine = 0u;
#pragma unroll
        for (unsigned j = 0; j < 16; ++j) { const unsigned c = xb_ld(&bar[XB_XCNT(j)]); sum += c; cnt += (c > 0u) ? 1u : 0u; mine = (j == x) ? c : mine; }
        if (sum == G) break;
        __builtin_amdgcn_s_sleep(1);
        if ((++sp & 255u) == 0u) { if (xb_ld(&bar[XB_TMO])) break; if (sp > XB_SPIN_CAP) { atomicAdd(&bar[XB_TMO], 1u); break; } }
    }
    nloc = mine > 0u ? mine : 1u; nx = cnt > 0u ? cnt : 1u;
}
__device__ __forceinline__ void xcd_barrier(const XcdBarrier& b, int wave_s) {
    asm volatile("s_waitcnt vmcnt(0)" ::: "memory");
    __syncthreads();
    if (tid_of(wave_s) == 0) {
        unsigned* bar = b.bar;
        __builtin_amdgcn_s_waitcnt(0);
        unsigned nloc = b.st[0], nx = b.st[1];
        if (nloc == 0u) { xcd_barrier_complete(bar, b.x, nloc, nx); b.st[0] = nloc; b.st[1] = nx; }
        const unsigned old = xb_add(&bar[XB_XSUB(b.x)], 1u);
        const unsigned gen = old / nloc;
        if (old + 1u == (gen + 1u) * nloc) {
            __builtin_amdgcn_fence(__ATOMIC_RELEASE, "agent");
            asm volatile("s_waitcnt vmcnt(0)" ::: "memory");
            const unsigned og = xb_add(&bar[XB_TOP], 1u);
            const unsigned tg = og / nx;
            if (og + 1u == (tg + 1u) * nx) xb_add(&bar[XB_TOPGEN], 1u);
            else XB_SPIN(xb_ld(&bar[XB_TOPGEN]) == tg, bar);
            __builtin_amdgcn_fence(__ATOMIC_ACQUIRE, "agent");
            xb_add(&bar[XB_XGEN(b.x)], 1u);
            asm volatile("s_waitcnt vmcnt(0)" ::: "memory");
        } else {
            XB_SPIN(xb_ld(&bar[XB_XGEN(b.x)]) == gen, bar);
            __builtin_amdgcn_fence(__ATOMIC_ACQUIRE, "agent");
            asm volatile("s_waitcnt vmcnt(0)" ::: "memory");
        }
    }
    __syncthreads();
}

namespace pg8 {
constexpr int BM = 256, BK = 64, HALF = 128, HTB = HALF * BK * 2, STAGE_BYTES = 8 * HTB, NXCD = 8, WGM = 8;
__host__ __device__ __forceinline__ int lds_byte(int r, int c) { const int st = (r >> 4) * 2 + (c >> 5), rr = r & 15, cc = c & 31, ob = rr * 64 + cc * 2; return st * 1024 + (ob ^ (((ob >> 9) & 1) << 5)); }
__host__ __device__ __forceinline__ void stage_rc(int b, int& R, int& C) { const int st = b / 1024, sb = b % 1024, swz = sb ^ (((sb >> 9) & 1) << 5); R = (st >> 1) * 16 + swz / 64; C = (st & 1) * 32 + (swz % 64) / 2; }
__host__ __device__ __forceinline__ int perm32(int rho) { const int n = rho >> 4, i = rho & 15; return 8 * (i >> 2) + 4 * n + (i & 3); }

struct Unit { int pm, pn; };
struct Gemm { const bf16_t* A; const bf16_t* Bt; int M, N, K; };

struct StaticOrder {
    int nM, nN, nwg, G, c;
    __host__ __device__ void init(int M, int N, int G_, int c_) { nM = M / BM; nN = N / BM; nwg = nM * nN; G = G_; c = c_; }
    __host__ __device__ bool next(int i, Unit& u) const {
        const long L = (long)i * G + c; if (L >= nwg) return false;
        int wgid = (int)L; { const int q = nwg / NXCD, r = nwg % NXCD, xcd = wgid % NXCD, off = wgid / NXCD; wgid = (xcd < r ? xcd * (q + 1) : r * (q + 1) + (xcd - r) * q) + off; }
        const int nig = WGM * nN, gid = wgid / nig, fm = gid * WGM, gsz = (nM - fm) < WGM ? (nM - fm) : WGM;
        u.pm = fm + ((wgid % nig) % gsz); u.pn = (wgid % nig) / gsz; return true;
    }
    __device__ __forceinline__ void a_ready(const Unit&) const {}
    __device__ __forceinline__ void done(const Unit&) const {}
};

__device__ __forceinline__ u32x4 quad_xpose(u32x4 w, int src4) {
    u32x4 r;
    r.x = (unsigned)__builtin_amdgcn_ds_bpermute(src4, (int)w.x); r.y = (unsigned)__builtin_amdgcn_ds_bpermute(src4, (int)w.y);
    r.z = (unsigned)__builtin_amdgcn_ds_bpermute(src4, (int)w.z); r.w = (unsigned)__builtin_amdgcn_ds_bpermute(src4, (int)w.w);
    return r;
}
struct EpiF32 {
    static constexpr bool PERM = false, AFTER_DRAIN = false;
    float* C; int ldc;
    __device__ __forceinline__ void operator()(const f32x4 (&acc)[2][2][4][2], const Unit& u, int wr, int wc, int fr, int fq) const {
        const int row0 = u.pm * BM + wr * 64 + fr, col0 = u.pn * BM + wc * 32 + 4 * fq;
#pragma unroll
        for (int ai = 0; ai < 2; ++ai)
#pragma unroll
            for (int m = 0; m < 4; ++m) { float* rowp = C + (size_t)(row0 + ai * HALF + m * 16) * ldc + col0;
#pragma unroll
                for (int bj = 0; bj < 2; ++bj)
#pragma unroll
                    for (int n = 0; n < 2; ++n) *(f32x4*)(rowp + bj * HALF + n * 16) = acc[ai][bj][m][n]; }
    }
};
struct EpiBf16 {
    static constexpr bool PERM = true, AFTER_DRAIN = false;
    bf16_t* O; int ldc;
    __device__ __forceinline__ void operator()(const f32x4 (&acc)[2][2][4][2], const Unit& u, int wr, int wc, int fr, int fq) const {
        const int ln = fr + 16 * fq, r4 = ln >> 2, c4 = ln & 3, src4 = 4 * (16 * c4 + r4);
        const int row0 = u.pm * BM + wr * 64 + r4, col0 = u.pn * BM + wc * 32 + 8 * c4;
#pragma unroll
        for (int ai = 0; ai < 2; ++ai)
#pragma unroll
            for (int m = 0; m < 4; ++m) { bf16_t* rowp = O + (size_t)(row0 + ai * HALF + m * 16) * ldc + col0;
#pragma unroll
                for (int bj = 0; bj < 2; ++bj) { const f32x4 v0 = acc[ai][bj][m][0], v1 = acc[ai][bj][m][1];
                    u32x4 w; w.x = cvt_pk_bf16(v0[0], v0[1]); w.y = cvt_pk_bf16(v0[2], v0[3]); w.z = cvt_pk_bf16(v1[0], v1[1]); w.w = cvt_pk_bf16(v1[2], v1[3]);
                    *(u32x4*)(rowp + bj * HALF) = quad_xpose(w, src4); } }
    }
};
struct EpiQKV {
    static constexpr bool PERM = true, AFTER_DRAIN = false;
    bf16_t *QA, *KA, *VA, *QB, *KB, *VB; float *sak, *sav, *sbv;
    __device__ __forceinline__ void operator()(const f32x4 (&acc)[2][2][4][2], const Unit& u, int wr, int wc, int fr, int fq) const {
        const int pn = u.pn, pm = u.pm;
        bf16_t* buf; int H, h0; float* st = nullptr;
        if (pn < 4) { buf = QA; H = 8; h0 = 2 * pn; }
        else if (pn < 8) { buf = KA; H = 8; h0 = 2 * (pn - 4); st = sak; }
        else if (pn < 12) { buf = VA; H = 8; h0 = 2 * (pn - 8); st = sav; }
        else if (pn < 16) { buf = QB; H = 8; h0 = 2 * (pn - 12); }
        else if (pn == 16) { buf = KB; H = 2; h0 = 0; }
        else { buf = VB; H = 2; h0 = 0; st = sbv; }
        const bool ctx = pm < 32;
        int b, t0, L; size_t reg;
        if (ctx) { b = pm; t0 = 0; L = 256; reg = 0; } else { b = (pm - 32) >> 2; t0 = ((pm - 32) & 3) * 256; L = 1024; reg = (size_t)NCTX * H * 128; }
#pragma unroll
        for (int bj = 0; bj < 2; ++bj) {
            const int h = h0 + bj;
            const int ln = fr + 16 * fq, r4 = ln >> 2, c4 = ln & 3, src4 = 4 * (16 * c4 + r4);
            bf16_t* base = buf + reg + ((size_t)(b * H + h) * L + t0) * 128 + wc * 32 + 8 * c4;
            float* sbase = st + ((size_t)(b * H + h) * 256) * 128 + wc * 32 + 8 * fq;
#pragma unroll
            for (int ai = 0; ai < 2; ++ai)
#pragma unroll
                for (int m = 0; m < 4; ++m) {
                    const int t = ai * HALF + wr * 64 + m * 16 + fr;
                    const f32x4 v0 = acc[ai][bj][m][0], v1 = acc[ai][bj][m][1];
                    u32x4 w; w.x = cvt_pk_bf16(v0[0], v0[1]); w.y = cvt_pk_bf16(v0[2], v0[3]); w.z = cvt_pk_bf16(v1[0], v1[1]); w.w = cvt_pk_bf16(v1[2], v1[3]);
                    *(u32x4*)(base + (size_t)(t - fr + r4) * 128) = quad_xpose(w, src4);
                    if (ctx && st) { *(f32x4*)(sbase + (size_t)t * 128) = v0; *(f32x4*)(sbase + (size_t)t * 128 + 4) = v1; }
                    asm volatile("" ::: "memory");
                }
        }
    }
};


template <int CTRL> __device__ __forceinline__ float dppf(float old, float src) {
    return __builtin_bit_cast(float, __builtin_amdgcn_update_dpp(__builtin_bit_cast(int, old), __builtin_bit_cast(int, src), CTRL, 0xF, 0xF, false));
}
struct EpiConv {
    static constexpr bool PERM = true, AFTER_DRAIN = false;
    bf16_t* ACT; float* HB; const float* cw; const float* cb; LAS float* H;
    __device__ __forceinline__ void operator()(const f32x4 (&acc)[2][2][4][2], const Unit& u, int wr, int wc, int fr, int fq) const {
        const int pm = u.pm, pn = u.pn;
        const int cl = 32 * wc + 8 * fq, j0 = 128 * pn + cl;
#pragma unroll
        for (int ai = 0; ai < 2; ++ai) { const int blk = ai * 2 + wr;
            if (fr == 0) {
#pragma unroll
                for (int bj = 0; bj < 2; ++bj)
#pragma unroll
                    for (int n = 0; n < 2; ++n) *(LAS f32x4*)(H + ((blk * 2 + 0) * 2 + bj) * 128 + cl + 4 * n) = acc[ai][bj][0][n]; }
            if (fr == 15) {
#pragma unroll
                for (int bj = 0; bj < 2; ++bj)
#pragma unroll
                    for (int n = 0; n < 2; ++n) *(LAS f32x4*)(H + ((blk * 2 + 1) * 2 + bj) * 128 + cl + 4 * n) = acc[ai][bj][3][n]; } }
        if (pm >= 32) { const int lt = pm - 32;
            if (wr == 0 && fr < 2) {
#pragma unroll
                for (int bj = 0; bj < 2; ++bj)
#pragma unroll
                    for (int n = 0; n < 2; ++n) *(f32x4*)(HB + ((size_t)((lt * 4 + fr) * 2 + bj)) * DFF + j0 + 4 * n) = acc[0][bj][0][n]; }
            if (wr == 1 && fr >= 14) {
#pragma unroll
                for (int bj = 0; bj < 2; ++bj)
#pragma unroll
                    for (int n = 0; n < 2; ++n) *(f32x4*)(HB + ((size_t)((lt * 4 + fr - 12) * 2 + bj)) * DFF + j0 + 4 * n) = acc[1][bj][3][n]; } }
        asm volatile("s_waitcnt lgkmcnt(0)" ::: "memory"); __builtin_amdgcn_s_barrier(); asm volatile("" ::: "memory");
        u32x2 keep[2][4];
        const int ln = fr + 16 * fq, r4 = ln >> 2, c4 = ln & 3, src4 = 4 * (16 * c4 + r4);
#pragma unroll
        for (int n = 0; n < 2; ++n) {
            f32x4 w[3][2], bs[2];
#pragma unroll
            for (int bj = 0; bj < 2; ++bj) { bs[bj] = *(const f32x4*)(cb + bj * DFF + j0 + 4 * n);
#pragma unroll
                for (int k = 0; k < 3; ++k) w[k][bj] = *(const f32x4*)(cw + (size_t)k * NUP + bj * DFF + j0 + 4 * n); }
#pragma unroll
            for (int ai = 0; ai < 2; ++ai) { const int blk = ai * 2 + wr;
                f32x4 hu[2], hd[2];
#pragma unroll
                for (int bj = 0; bj < 2; ++bj) {
                    hu[bj] = (blk > 0) ? *(const LAS f32x4*)(H + (((blk - 1) * 2 + 1) * 2 + bj) * 128 + cl + 4 * n) : (f32x4){0.f, 0.f, 0.f, 0.f};
                    hd[bj] = (blk < 3) ? *(const LAS f32x4*)(H + (((blk + 1) * 2 + 0) * 2 + bj) * 128 + cl + 4 * n) : (f32x4){0.f, 0.f, 0.f, 0.f}; }
#pragma unroll
                for (int m = 0; m < 4; ++m) {
                    float a[4];
#pragma unroll
                    for (int e = 0; e < 4; ++e) {
                        float r[2];
#pragma unroll
                        for (int bj = 0; bj < 2; ++bj) {
                            const float cur = acc[ai][bj][m][n][e];
                            const float upT = (m == 0) ? hu[bj][e] : dppf<0x121>(0.f, acc[ai][bj][m == 0 ? 0 : m - 1][n][e]);
                            const float up = dppf<0x111>(upT, cur);
                            const float dnT = (m == 3) ? hd[bj][e] : dppf<0x12F>(0.f, acc[ai][bj][m == 3 ? 3 : m + 1][n][e]);
                            const float dn = dppf<0x101>(dnT, cur);
                            r[bj] = w[0][bj][e] * up + w[1][bj][e] * cur + w[2][bj][e] * dn + bs[bj][e];
                        }
                        a[e] = r[1] * __builtin_amdgcn_rcpf(1.f + __expf(-r[1])) * r[0];
                    }
                    u32x2 ow; ow.x = cvt_pk_bf16(a[0], a[1]); ow.y = cvt_pk_bf16(a[2], a[3]);
                    if (n == 0) keep[ai][m] = ow;
                    else { u32x4 w16; w16.x = keep[ai][m].x; w16.y = keep[ai][m].y; w16.z = ow.x; w16.w = ow.y;
                        *(u32x4*)(ACT + (size_t)(pm * BM + ai * HALF + wr * 64 + m * 16 + r4) * DFF + 128 * pn + 32 * wc + 8 * c4) = quad_xpose(w16, src4); }
                }
            }
        }
    }
};

template <class Epi, class Sched, bool ALIGN_EPI = true>
__device__ __forceinline__ void gemm_phase(LAS unsigned char* lds, const Gemm g, const Sched& S, const Epi& E, int wave_s) {
    const int tid = tid_of(wave_s);
    const int wid = wave_s, lane = tid & 63, wr = wid >> 2, wc = wid & 3, fr = lane & 15, fq = lane >> 4;
    const int K = g.K, nt = K / BK;
    unsigned voffA[2], voffB[2];
#pragma unroll
    for (int i = 0; i < 2; ++i) { int R, C; stage_rc(tid * 16 + i * 8192, R, C); const int Rb = Epi::PERM ? ((R & ~31) + perm32(R & 31)) : R;
        voffA[i] = (unsigned)(R * K + C) * 2u; voffB[i] = (unsigned)(Rb * K + C) * 2u; }
    const size_t kstep = (size_t)(BK * 2);
    const size_t hstep = (size_t)HALF * K * 2;
    const size_t tstep = 2 * hstep;
    const unsigned ldsw = (unsigned)wid * 1024u;
    const int aoff = lds_byte(wr * 64 + fr, fq * 8), boff = lds_byte(wc * 32 + fr, fq * 8);
#define PG8_SA(b, h) (((b) * 2 + (h)) * HTB)
#define PG8_SB(b, h) ((4 + (b) * 2 + (h)) * HTB)
#define PG8_STAGE(bufoff, gbase, voff) do { _Pragma("unroll") for (int _i = 0; _i < 2; ++_i) \
        __builtin_amdgcn_global_load_lds((const unsigned*)((const char*)(gbase) + (voff)[_i]), (LAS unsigned*)(lds + (bufoff) + ldsw + _i * 8192), 16, 0, 0); } while (0)
#define PG8_LDA(dst, b, h) do { _Pragma("unroll") for (int m = 0; m < 4; ++m) _Pragma("unroll") for (int k = 0; k < 2; ++k) dst[m][k] = *(const LAS bf16x8*)(lds + PG8_SA(b, h) + aoff + m * 2048 + k * 1024); } while (0)
#define PG8_LDB(dst, b, h) do { _Pragma("unroll") for (int n = 0; n < 2; ++n) _Pragma("unroll") for (int k = 0; k < 2; ++k) dst[n][k] = *(const LAS bf16x8*)(lds + PG8_SB(b, h) + boff + n * 2048 + k * 1024); } while (0)
#define PG8_MMA(ai, bj, At, Bt) do { __builtin_amdgcn_s_setprio(1); _Pragma("unroll") for (int m = 0; m < 4; ++m) _Pragma("unroll") for (int n = 0; n < 2; ++n) _Pragma("unroll") for (int k = 0; k < 2; ++k) \
        acc[ai][bj][m][n] = __builtin_amdgcn_mfma_f32_16x16x32_bf16(Bt[n][k], At[m][k], acc[ai][bj][m][n], 0, 0, 0); __builtin_amdgcn_s_setprio(0); } while (0)
#define PG8_WAIT_V(n) asm volatile("s_waitcnt vmcnt(" #n ")" ::: "memory")
#define PG8_WAIT_L(n) asm volatile("s_waitcnt lgkmcnt(" #n ")" ::: "memory")
#define PG8_BAR __builtin_amdgcn_s_barrier()
#define PG8_SCHED __builtin_amdgcn_sched_barrier(0)
    Unit cur, nxt; int ui = 0;
    if (!S.next(0, cur)) return;
    f32x4 acc[2][2][4][2];
#pragma unroll
    for (int a = 0; a < 2; ++a)
#pragma unroll
        for (int b = 0; b < 2; ++b)
#pragma unroll
            for (int m = 0; m < 4; ++m)
#pragma unroll
                for (int n = 0; n < 2; ++n) acc[a][b][m][n] = (f32x4){0.f, 0.f, 0.f, 0.f};
    bf16x8 At[4][2], B0[2][2], B1[2][2];
    const char* cA = (const char*)g.A + (size_t)cur.pm * tstep; const char* cB = (const char*)g.Bt + (size_t)cur.pn * tstep;
    S.a_ready(cur);
    PG8_STAGE(PG8_SB(0, 0), cB, voffB); PG8_STAGE(PG8_SB(0, 1), cB + hstep, voffB); PG8_STAGE(PG8_SA(0, 0), cA, voffA); PG8_STAGE(PG8_SA(0, 1), cA + hstep, voffA);
    if (wr == 1) PG8_BAR;
    PG8_WAIT_V(2); PG8_BAR;
    PG8_STAGE(PG8_SB(1, 0), cB + kstep, voffB); PG8_STAGE(PG8_SA(1, 0), cA + kstep, voffA); PG8_STAGE(PG8_SB(1, 1), cB + hstep + kstep, voffB);
    PG8_WAIT_V(6); PG8_BAR;
    for (;;) {
        const bool has_next = S.next(ui + 1, nxt);
        const char* nA = has_next ? (const char*)g.A + (size_t)nxt.pm * tstep : cA; const char* nB = has_next ? (const char*)g.Bt + (size_t)nxt.pn * tstep : cB;
        for (int t = 0; t < nt; t += 2) {
            const bool last = (t == nt - 2);
            const char* a1 = cA + (size_t)(t + 1) * kstep;
            const char* a2 = last ? nA : cA + (size_t)(t + 2) * kstep; const char* b2 = last ? nB : cB + (size_t)(t + 2) * kstep;
            const char* a3 = a2 + kstep; const char* b3 = b2 + kstep;
            if (last && has_next) S.a_ready(nxt);
            PG8_LDB(B0, 0, 0); PG8_LDB(B1, 0, 1); PG8_SCHED; PG8_LDA(At, 0, 0); PG8_STAGE(PG8_SA(1, 1), a1 + hstep, voffA);
            PG8_WAIT_V(8); PG8_WAIT_L(0); PG8_BAR; PG8_MMA(0, 0, At, B0); PG8_MMA(0, 1, At, B1); PG8_BAR; PG8_SCHED;
            PG8_LDA(At, 0, 1); PG8_STAGE(PG8_SB(0, 0), b2, voffB); PG8_STAGE(PG8_SB(0, 1), b2 + hstep, voffB); PG8_STAGE(PG8_SA(0, 0), a2, voffA);
            PG8_WAIT_V(8); PG8_WAIT_L(0); PG8_BAR; PG8_MMA(1, 0, At, B0); PG8_MMA(1, 1, At, B1); PG8_BAR; PG8_SCHED;
            PG8_LDB(B0, 1, 0); PG8_LDB(B1, 1, 1); PG8_SCHED; PG8_LDA(At, 1, 0); PG8_STAGE(PG8_SA(0, 1), a2 + hstep, voffA);
            PG8_WAIT_V(8); PG8_WAIT_L(0); PG8_BAR; PG8_MMA(0, 0, At, B0); PG8_MMA(0, 1, At, B1); PG8_BAR; PG8_SCHED;
            PG8_LDA(At, 1, 1); PG8_STAGE(PG8_SB(1, 0), b3, voffB); PG8_STAGE(PG8_SB(1, 1), b3 + hstep, voffB); PG8_STAGE(PG8_SA(1, 0), a3, voffA);
            PG8_WAIT_V(8); PG8_WAIT_L(0); PG8_BAR; PG8_MMA(1, 0, At, B0); PG8_MMA(1, 1, At, B1); PG8_BAR; PG8_SCHED;
        }
        if constexpr (ALIGN_EPI) { if (wr == 0) PG8_BAR; }
        E(acc, cur, wr, wc, fr, fq); S.done(cur);
        if (!has_next) break;
#pragma unroll
        for (int a = 0; a < 2; ++a)
#pragma unroll
            for (int b = 0; b < 2; ++b)
#pragma unroll
                for (int m = 0; m < 4; ++m)
#pragma unroll
                    for (int n = 0; n < 2; ++n) acc[a][b][m][n] = (f32x4){0.f, 0.f, 0.f, 0.f};
        cur = nxt; cA = nA; cB = nB; ++ui;
        if constexpr (ALIGN_EPI) { if (wr == 1) PG8_BAR; }
    }
    PG8_WAIT_V(0);
    if constexpr (!ALIGN_EPI) { if (wr == 0) PG8_BAR; }
    PG8_BAR;
#undef PG8_SA
#undef PG8_SB
#undef PG8_STAGE
#undef PG8_LDA
#undef PG8_LDB
#undef PG8_MMA
#undef PG8_WAIT_V
#undef PG8_WAIT_L
#undef PG8_BAR
#undef PG8_SCHED
}
}

namespace att {
constexpr int D = 128, NW = 8, QBLK = 32, KVBLK = 64;
constexpr float SCALE = 0.088388347648318440f;
constexpr float THR = 8.f;
constexpr int SHM_V = KVBLK * D * 2, SHM_K = KVBLK * D * 2, SHM_ATTN = 2 * SHM_V + 2 * SHM_K + NW * 64 * 4;
constexpr int BIAS_OFF = SHM_ATTN, BIAS_FLOATS = 704;
constexpr int OST_OFF = 73728, OST_WAVE = 32 * 272;
#define KSWZ(row, colB) ((row) * 256 + ((colB) ^ (((row) & 7) << 4)))
#define SBAR() __builtin_amdgcn_sched_barrier(0)
__device__ __forceinline__ int crow(int r, int hi) { return (r & 3) + 8 * (r >> 2) + 4 * hi; }
__device__ __forceinline__ unsigned cvtpk(float lo, float hi) { unsigned r; asm volatile("v_cvt_pk_bf16_f32 %0, %1, %2" : "=v"(r) : "v"(lo), "v"(hi)); return r; }
__device__ __forceinline__ bf16x8 ld8(const bf16_t* p) { return *reinterpret_cast<const bf16x8*>(p); }

__device__ __forceinline__ void partialSM(f32x16& p0, f32x16& p1, float& m_reg, float& mn, float& alpha) {
  constexpr float C = SCALE * 1.4426950408889634f;
  float pmax = p0[0];
#pragma unroll
  for (int r = 1; r < 16; ++r) pmax = fmaxf(pmax, p0[r]);
#pragma unroll
  for (int r = 0; r < 16; ++r) pmax = fmaxf(pmax, p1[r]);
  { auto rr = __builtin_amdgcn_permlane32_swap(__float_as_uint(pmax), __float_as_uint(pmax), false, false);
    pmax = fmaxf(__uint_as_float(rr[0]), __uint_as_float(rr[1])); }
  if (__builtin_expect(__all(pmax - m_reg <= THR / SCALE), 1)) { mn = m_reg; alpha = 1.f; }
  else { mn = fmaxf(m_reg, pmax); alpha = __builtin_amdgcn_exp2f((m_reg - mn) * C); m_reg = mn; }
  float mnC = -mn * C;
#pragma unroll
  for (int r = 0; r < 16; ++r) p0[r] = fmaf(p0[r], C, mnC);
#pragma unroll
  for (int r = 0; r < 16; ++r) p1[r] = fmaf(p1[r], C, mnC);
#pragma unroll
  for (int r = 0; r < 16; ++r) p0[r] = __builtin_amdgcn_exp2f(p0[r]);
}
__device__ __forceinline__ void finishSM(f32x16& p0, f32x16& p1, float alpha, float& l_reg, bf16x8& pa0, bf16x8& pa1, bf16x8& pa2, bf16x8& pa3) {
#pragma unroll
  for (int r = 0; r < 16; ++r) p1[r] = __builtin_amdgcn_exp2f(p1[r]);
  float ps = 0;
#pragma unroll
  for (int r = 0; r < 16; ++r) ps += p0[r];
#pragma unroll
  for (int r = 0; r < 16; ++r) ps += p1[r];
  { auto rr = __builtin_amdgcn_permlane32_swap(__float_as_uint(ps), __float_as_uint(ps), false, false);
    ps = __uint_as_float(rr[0]) + __uint_as_float(rr[1]); }
  l_reg = l_reg * alpha + ps;
#define PK4(P, BASE, OUT) do { unsigned a0 = cvtpk(P[BASE + 0], P[BASE + 1]), a1 = cvtpk(P[BASE + 2], P[BASE + 3]);   \
    unsigned b0 = cvtpk(P[BASE + 4], P[BASE + 5]), b1 = cvtpk(P[BASE + 6], P[BASE + 7]);                              \
    auto r0 = __builtin_amdgcn_permlane32_swap(a0, b0, false, false); auto r1 = __builtin_amdgcn_permlane32_swap(a1, b1, false, false); \
    u32x4 w = {r0[0], r1[0], r0[1], r1[1]}; OUT = *reinterpret_cast<bf16x8*>(&w); } while (0)
  PK4(p0, 0, pa0); PK4(p0, 8, pa1); PK4(p1, 0, pa2); PK4(p1, 8, pa3);
#undef PK4
}
__device__ __forceinline__ void qkt(f32x16& p0, f32x16& p1, const char* Ks, const bf16x8* qr, int r32, int hi) {
  p0 = f32x16{}; p1 = f32x16{};
#pragma unroll
  for (int d0 = 0; d0 < 8; ++d0) { int cb = (d0 * 16 + hi * 8) * 2;
    bf16x8 b0 = *reinterpret_cast<const bf16x8*>(Ks + KSWZ(r32, cb));
    bf16x8 b1 = *reinterpret_cast<const bf16x8*>(Ks + KSWZ(32 + r32, cb));
    p0 = __builtin_amdgcn_mfma_f32_32x32x16_bf16(b0, qr[d0], p0, 0, 0, 0);
    p1 = __builtin_amdgcn_mfma_f32_32x32x16_bf16(b1, qr[d0], p1, 0, 0, 0); }
}
__device__ __forceinline__ int v_st(int k, int c) { const int kk = (k & ~0xC) | ((k & 4) << 1) | ((k & 8) >> 1); return ((kk >> 3) * 4 + (c >> 5)) * 512 + ((kk & 7) * 32 + (c & 31)) * 2; }
__device__ __forceinline__ int v_rd_base(int lane) { return ((lane & 3) << 3) | (((lane >> 2) & 3) << 6) | (((lane >> 4) & 1) << 5) | (((lane >> 5) & 1) << 8); }
constexpr int v_rd_off(int d0, int ks, int half) { return d0 * 512 + ks * 4096 + half * 2048; }
template <int OFF> __device__ __forceinline__ s16x4 tr_read(int vb) {
  s16x4 r; asm volatile("ds_read_b64_tr_b16 %0, %1 offset:%2" : "=&v"(r) : "v"(vb), "i"(OFF) : "memory"); return r;
}
template <int D0> __device__ __forceinline__ void pv_one(f32x16& od, int vb, bf16x8 pa0, bf16x8 pa1, bf16x8 pa2, bf16x8 pa3) {
  const s16x4 l0 = tr_read<v_rd_off(D0, 0, 0)>(vb), h0 = tr_read<v_rd_off(D0, 0, 1)>(vb), l1 = tr_read<v_rd_off(D0, 1, 0)>(vb), h1 = tr_read<v_rd_off(D0, 1, 1)>(vb);
  const s16x4 l2 = tr_read<v_rd_off(D0, 2, 0)>(vb), h2 = tr_read<v_rd_off(D0, 2, 1)>(vb), l3 = tr_read<v_rd_off(D0, 3, 0)>(vb), h3 = tr_read<v_rd_off(D0, 3, 1)>(vb);
  asm volatile("s_waitcnt lgkmcnt(0)" ::: "memory"); SBAR();
#define PK(L, H) (bf16x8){L[0], L[1], L[2], L[3], H[0], H[1], H[2], H[3]}
  od = __builtin_amdgcn_mfma_f32_32x32x16_bf16(pa0, PK(l0, h0), od, 0, 0, 0);
  od = __builtin_amdgcn_mfma_f32_32x32x16_bf16(pa1, PK(l1, h1), od, 0, 0, 0);
  od = __builtin_amdgcn_mfma_f32_32x32x16_bf16(pa2, PK(l2, h2), od, 0, 0, 0);
  od = __builtin_amdgcn_mfma_f32_32x32x16_bf16(pa3, PK(l3, h3), od, 0, 0, 0);
#undef PK
}
__device__ __forceinline__ void pv_d0(f32x16* o, int vb, bf16x8 pa0, bf16x8 pa1, bf16x8 pa2, bf16x8 pa3) {
  pv_one<0>(o[0], vb, pa0, pa1, pa2, pa3); pv_one<1>(o[1], vb, pa0, pa1, pa2, pa3); pv_one<2>(o[2], vb, pa0, pa1, pa2, pa3); pv_one<3>(o[3], vb, pa0, pa1, pa2, pa3);
}

template <bool NB>
__device__ __forceinline__ void attn_body(const bf16_t* __restrict__ Qb, const bf16_t* __restrict__ K0, const bf16_t* __restrict__ V0, int nt0,
                                          const bf16_t* __restrict__ K1, const bf16_t* __restrict__ V1, int NT,
                                          bf16_t* __restrict__ Ob, char* lds, int nb_r0, int nb_krlo, int wave_s) {
  const int tid = tid_of(wave_s);
  const int wid = wave_s, lane = tid & 63, r32 = lane & 31, hi = lane >> 5;
  char* V_lds = lds; char* K_lds = lds + 2 * SHM_V;
  float* ws = (float*)(lds + 2 * SHM_V + 2 * SHM_K) + wid * 64; float* li_l = ws; float* al_l = ws + 32;
  float m_reg = -1e30f, l_reg = 0; f32x16 o[4] = {}; bf16x8 qr[8];
  const bf16_t* Qw = Qb + (size_t)(wid * QBLK + r32) * D + hi * 8;
#pragma unroll
  for (int d0 = 0; d0 < 8; ++d0) qr[d0] = ld8(Qw + d0 * 16);
  const int sr = tid >> 4, sc = (tid & 15) * 8, vst0 = v_st(sr, sc), vst1 = v_st(32 + sr, sc);
  const int vb0 = (int)(uintptr_t)V_lds + v_rd_base(lane);
  const int nq_r = nb_r0 + (wid >> 1), nq_c = 32 * (wid & 1) + r32;
  const int nrs = min(max(nq_r - 4, 0), 8), ncs = min(max(nq_c - 8, 0), 48);
  const float* btab = (const float*)(lds + BIAS_OFF) + 64 + 15 - nq_c + 4 * hi;
  struct { bf16x8 vs0, vs1, ks0, ks1; } sr_[2];
#define KPTR(j) ((j) < nt0 ? K0 + (size_t)(j) * (KVBLK * D) : K1 + (size_t)((j) - nt0) * (KVBLK * D))
#define VPTR(j) ((j) < nt0 ? V0 + (size_t)(j) * (KVBLK * D) : V1 + (size_t)((j) - nt0) * (KVBLK * D))
#define SLOAD(i, j) do { const bf16_t* kp_ = KPTR(j); const bf16_t* vp_ = VPTR(j); \
    sr_[i].vs0 = ld8(vp_ + sr * D + sc); sr_[i].vs1 = ld8(vp_ + (32 + sr) * D + sc); \
    sr_[i].ks0 = ld8(kp_ + sr * D + sc); sr_[i].ks1 = ld8(kp_ + (32 + sr) * D + sc); } while (0)
#define SWRITE(b, i) do { *(bf16x8*)(V_lds + (b) * SHM_V + vst0) = sr_[i].vs0;          \
    *(bf16x8*)(V_lds + (b) * SHM_V + vst1) = sr_[i].vs1; int kc = sc * 2;               \
    *(bf16x8*)(K_lds + (b) * SHM_K + KSWZ(sr, kc)) = sr_[i].ks0;                       \
    *(bf16x8*)(K_lds + (b) * SHM_K + KSWZ(32 + sr, kc)) = sr_[i].ks1; } while (0)
#define SWAIT() asm volatile("s_waitcnt vmcnt(4)" ::: "memory")
#define RESC(a) do { if (__any((a) < 1.f)) { if (hi == 0) al_l[r32] = (a); asm volatile("s_waitcnt lgkmcnt(0)" ::: "memory"); \
    _Pragma("unroll") for (int d = 0; d < 4; ++d) _Pragma("unroll") for (int r = 0; r < 16; ++r) o[d][r] *= al_l[crow(r, hi)]; } } while (0)
#define NBMASK(P0, P1, j) do { if (NB && (j) >= 4) { const int kr_ = nb_krlo + (j) - 4; \
    if ((unsigned)(kr_ - nrs) >= 8u) { _Pragma("unroll") for (int r = 0; r < 16; ++r) { P0[r] = -1e30f; P1[r] = -1e30f; } } \
    else { const float* tb_ = btab + (kr_ - nq_r + 7) * 31; const int kb_ = 4 * hi - ncs; \
      _Pragma("unroll") for (int r = 0; r < 16; ++r) { const int c0_ = (r & 3) + 8 * (r >> 2); \
        P0[r] = ((unsigned)(kb_ + c0_) < 16u) ? P0[r] + tb_[c0_] : -1e30f; \
        P1[r] = ((unsigned)(kb_ + c0_ + 32) < 16u) ? P1[r] + tb_[c0_ + 32] : -1e30f; } } } } while (0)
  f32x16 pA0, pA1, pB0, pB1; float mnA, mnB, alA, alB; bf16x8 pa0, pa1, pa2, pa3;
  constexpr int SE = 0, SO = 1;
  SLOAD(SE, 0); asm volatile("s_waitcnt vmcnt(0)" ::: "memory"); SWRITE(0, SE); __syncthreads();
  qkt(pA0, pA1, K_lds, qr, r32, hi); partialSM(pA0, pA1, m_reg, mnA, alA);
  SLOAD(SO, 1); if (2 < NT) SLOAD(SE, 2);
  SWAIT(); SWRITE(1, SO); __syncthreads();
  for (int j = 1; j + 1 < NT; j += 2) {
    SBAR(); qkt(pB0, pB1, K_lds + SHM_K, qr, r32, hi);
    finishSM(pA0, pA1, alA, l_reg, pa0, pa1, pa2, pa3); SBAR();
    SLOAD(SO, j + 2); SBAR();
    pv_d0(o, vb0, pa0, pa1, pa2, pa3); NBMASK(pB0, pB1, j); partialSM(pB0, pB1, m_reg, mnB, alB);
    __syncthreads(); SWAIT(); SWRITE(0, SE);
    RESC(alB); __syncthreads();
    SBAR(); qkt(pA0, pA1, K_lds, qr, r32, hi);
    finishSM(pB0, pB1, alB, l_reg, pa0, pa1, pa2, pa3); SBAR();
    if (j + 3 < NT) SLOAD(SE, j + 3); SBAR();
    pv_d0(o, vb0 + SHM_V, pa0, pa1, pa2, pa3); NBMASK(pA0, pA1, j + 1); partialSM(pA0, pA1, m_reg, mnA, alA);
    __syncthreads(); SWAIT(); SWRITE(1, SO);
    RESC(alA); __syncthreads();
  }
  SBAR(); qkt(pB0, pB1, K_lds + SHM_K, qr, r32, hi);
  finishSM(pA0, pA1, alA, l_reg, pa0, pa1, pa2, pa3); SBAR();
  pv_d0(o, vb0, pa0, pa1, pa2, pa3); NBMASK(pB0, pB1, NT - 1); partialSM(pB0, pB1, m_reg, mnB, alB);
  __syncthreads(); RESC(alB);
  finishSM(pB0, pB1, alB, l_reg, pa0, pa1, pa2, pa3); SBAR();
  pv_d0(o, vb0 + SHM_V, pa0, pa1, pa2, pa3);
  if (hi == 0) li_l[r32] = l_reg; asm volatile("s_waitcnt lgkmcnt(0)" ::: "memory");
  float rli[16];
#pragma unroll
  for (int r = 0; r < 16; ++r) rli[r] = __builtin_amdgcn_rcpf(li_l[crow(r, hi)]);
  char* ost = lds + OST_OFF + wid * OST_WAVE;
#pragma unroll
  for (int r = 0; r < 16; ++r) { const int orow = crow(r, hi);
#pragma unroll
    for (int d0 = 0; d0 < 4; ++d0) { const float v = o[d0][r] * rli[r]; *(bf16_t*)(ost + orow * 272 + (d0 * 32 + r32) * 2) = (bf16_t)(cvtpk(v, v) & 0xffffu); } }
  asm volatile("s_waitcnt lgkmcnt(0)" ::: "memory");
  bf16_t* Ow = Ob + (size_t)(wid * QBLK) * DM;
#pragma unroll
  for (int i = 0; i < 8; ++i) { const int row = (lane >> 4) + 4 * i, ch = lane & 15;
    const u32x4 w = *(const u32x4*)(ost + row * 272 + ch * 16);
    *(u32x4*)(Ow + (size_t)row * DM + ch * 8) = w; }
#undef KPTR
#undef VPTR
#undef SLOAD
#undef SWRITE
#undef SWAIT
#undef RESC
#undef NBMASK
}
}

__device__ __forceinline__ unsigned f2bf(float f) { unsigned u = __builtin_bit_cast(unsigned, f); return (u + 0x7fffu + ((u >> 16) & 1u)) >> 16; }
__device__ __forceinline__ unsigned pk2(float lo, float hi) { return f2bf(lo) | (f2bf(hi) << 16); }
#define LDS_WAIT() asm volatile("s_waitcnt lgkmcnt(0)" ::: "memory")
template <bool UPMAP> __device__ __forceinline__ void transpose_item(const float* __restrict__ W, int K, int N, bf16_t* __restrict__ WT, LAS float* scr, int item, int lane) {
    const int nblk = N / 32, kb = item / nblk, nb = item % nblk, k0 = 64 * kb, n0 = 32 * nb;
    const int d0 = UPMAP ? (n0 < DFF ? (n0 >> 7) * 256 + (n0 & 127) : ((n0 - DFF) >> 7) * 256 + 128 + ((n0 - DFF) & 127)) : n0;
    {
        const int r8 = lane >> 3, c4 = lane & 7;
        f32x4 v[8];
#pragma unroll
        for (int g = 0; g < 8; ++g) v[g] = *(const f32x4*)(W + (size_t)(k0 + 8 * g + r8) * N + n0 + 4 * c4);
#pragma unroll
        for (int g = 0; g < 8; ++g) { LAS float* d = scr + (8 * g + r8) * 33 + 4 * c4; d[0] = v[g][0]; d[1] = v[g][1]; d[2] = v[g][2]; d[3] = v[g][3]; }
    }
    LDS_WAIT(); asm volatile("" ::: "memory");
    const int c = lane & 7;
#pragma unroll
    for (int j = 0; j < 4; ++j) { const int n = (lane >> 3) + 8 * j; const LAS float* s = scr + (8 * c) * 33 + n;
        u32x4 o; o.x = pk2(s[0 * 33], s[1 * 33]); o.y = pk2(s[2 * 33], s[3 * 33]); o.z = pk2(s[4 * 33], s[5 * 33]); o.w = pk2(s[6 * 33], s[7 * 33]);
        *(u32x4*)(WT + (size_t)(d0 + n) * K + k0 + 8 * c) = o; }
    LDS_WAIT(); asm volatile("" ::: "memory");
}

struct Args { const float* in[23]; float* out; unsigned char* ws; int ph_lo, ph_hi; };

__global__ void __launch_bounds__(512, 2) mk_fwd(Args args) {
    extern __shared__ __attribute__((aligned(16))) unsigned char lds[];
    cg::grid_group grid = cg::this_grid();
    const int G = gridDim.x, bx = blockIdx.x, NGW = G * 8;
    const int wave_s = __builtin_amdgcn_readfirstlane((int)threadIdx.x >> 6);
#define PHASE_IDS const int tid = tid_of(wave_s); const int lane = tid & 63, wave = wave_s; \
    const int gw = bx * 8 + wave, gwi = wave * G + bx; (void)lane; (void)gw; (void)gwi; (void)tid;
#define ws (args.ws)
#define x_prompt (args.in[0])
#define x_sample (args.in[1])
#define cvec (args.in[2])
#define cache_a_k (args.in[3])
#define cache_a_v (args.in[4])
#define cache_b_k (args.in[5])
#define cache_b_v (args.in[6])
#define c_ctx (args.in[7])
#define w_mod (args.in[8])
#define b_mod (args.in[9])
#define g_attn_pre (args.in[10])
#define g_attn_post (args.in[11])
#define g_ffn_pre (args.in[12])
#define g_ffn_post (args.in[13])
#define w_in (args.in[14])
#define rpb (args.in[15])
#define g_qnorm (args.in[16])
#define g_knorm (args.in[17])
#define w_out (args.in[18])
#define w_up (args.in[19])
#define conv_w (args.in[20])
#define conv_b (args.in[21])
#define w_down (args.in[22])
#define Y_ (args.out)
#define st_ak (args.out + (size_t)MTOK * DM)
#define st_av (args.out + (size_t)MTOK * DM + (size_t)32 * 8 * 256 * 128)
#define st_bk (args.out + (size_t)MTOK * DM + (size_t)2 * 32 * 8 * 256 * 128)
#define st_bv (args.out + (size_t)MTOK * DM + (size_t)2 * 32 * 8 * 256 * 128 + (size_t)32 * 2 * 256 * 128)
#define MOD ((float*)(ws + WS_MOD))
#define MODP ((float*)(ws + WS_MODP))
#define WIN ((bf16_t*)(ws + WS_WIN))
#define WOUT ((bf16_t*)(ws + WS_WOUT))
#define WUP ((bf16_t*)(ws + WS_WUP))
#define WDN ((bf16_t*)(ws + WS_WDN))
#define XN ((bf16_t*)(ws + WS_XN))
#define CAK ((bf16_t*)(ws + WS_CAK))
#define CAV ((bf16_t*)(ws + WS_CAV))
#define CBK ((bf16_t*)(ws + WS_CBK))
#define CBV ((bf16_t*)(ws + WS_CBV))
#define QA ((bf16_t*)(ws + WS_QA))
#define KA ((bf16_t*)(ws + WS_KA))
#define VA ((bf16_t*)(ws + WS_VA))
#define QB ((bf16_t*)(ws + WS_QB))
#define KB ((bf16_t*)(ws + WS_KB))
#define VB ((bf16_t*)(ws + WS_VB))
#define OB ((bf16_t*)(ws + WS_O))
#define P1 ((bf16_t*)(ws + WS_P1))
#define P2 ((bf16_t*)(ws + WS_P2))
#define ACT ((bf16_t*)(ws + WS_ACT))
#define HBUF ((float*)(ws + WS_U))
#define X1B ((bf16_t*)(ws + WS_X1))
    LAS unsigned char* ldsl = (LAS unsigned char*)lds;

    const int lo = args.ph_lo, hi = args.ph_hi;
#ifndef PH_MASK
#define PH_MASK 0xFFF
#endif
#define IN(k) (((PH_MASK >> (k)) & 1) && lo <= (k) && (k) < hi)
    { const int t0 = tid_of(wave_s); if (t0 < 16) ((volatile LAS unsigned*)(ldsl + MISC_OFF))[t0] = 0u; }
    __syncthreads();
    const XcdBarrier xbar = xcd_barrier_post((unsigned*)(ws + WS_CTL), (volatile LAS unsigned*)(ldsl + MISC_OFF), wave_s);
#define SEAM(k) do { if (IN(k) && IN((k) + 1)) { if ((k) == 0) grid.sync(); else xcd_barrier(xbar, wave_s); } } while (0)

    if (IN(0)) {
        PHASE_IDS
        LAS float* cs = (LAS float*)ldsl;
        for (int idx = tid; idx < 9 * 2048; idx += 512) { const int j = idx >> 11, k = idx & 2047; const float c = (j == 0) ? c_ctx[k] : cvec[(j - 1) * 2048 + k];
            cs[k * 9 + j] = c / (1.f + __expf(-c)); }
        __syncthreads();
        for (int ch = bx; ch < 256; ch += G) {
            const int vc = (ch & 7) * 32 + (ch >> 3), rsub = lane / 12, c4 = lane - 12 * rsub;
            f32x4 acc[9];
#pragma unroll
            for (int j = 0; j < 9; ++j) acc[j] = (f32x4){0.f, 0.f, 0.f, 0.f};
            if (rsub < 5) {
                const float* wp = w_mod + (size_t)(wave * 256 + rsub) * NMOD + vc * 48 + 4 * c4;
                const LAS float* sp = cs + (wave * 256 + rsub) * 9;
#pragma unroll 8
                for (int it = 0; it < 51; ++it) {
                    const f32x4 w = *(const f32x4*)(wp + (size_t)(5 * it) * NMOD);
                    const LAS float* s2 = sp + 45 * it;
#pragma unroll
                    for (int j = 0; j < 9; ++j) acc[j] += w * s2[j];
                }
                if (rsub == 0) {
                    const f32x4 w = *(const f32x4*)(wp + (size_t)255 * NMOD);
                    const LAS float* s2 = sp + 9 * 255;
#pragma unroll
                    for (int j = 0; j < 9; ++j) acc[j] += w * s2[j];
                }
            }
            __syncthreads();
            LAS float* red = (LAS float*)ldsl;
#pragma unroll
            for (int j = 0; j < 9; ++j) *(LAS f32x4*)(red + tid * 36 + 4 * j) = acc[j];
            __syncthreads();
            if (tid < 432) { const int j = tid / 48, col = tid - 48 * j, cc = col >> 2, e = col & 3;
                float sum = b_mod[vc * 48 + col];
#pragma unroll
                for (int w = 0; w < 8; ++w)
#pragma unroll
                    for (int r5 = 0; r5 < 5; ++r5) sum += red[(w * 64 + r5 * 12 + cc) * 36 + 4 * j + e];
                MOD[(size_t)j * NMOD + vc * 48 + col] = sum; }
            __syncthreads();
            if (ch + G < 256) {
                for (int idx = tid; idx < 9 * 2048; idx += 512) { const int j = idx >> 11, k = idx & 2047; const float c = (j == 0) ? c_ctx[k] : cvec[(j - 1) * 2048 + k];
                    cs[k * 9 + j] = c / (1.f + __expf(-c)); }
                __syncthreads();
            }
        }
        LAS float* scr = (LAS float*)(ldsl + wave * 8448);
        constexpr int I_IN = 32 * 144, I_OUT = 32 * 64;
        for (int it = gwi; it < I_IN + I_OUT; it += NGW) {
            if (it < I_IN) transpose_item<false>(w_in, DM, NIN, WIN, scr, it, lane);
            else transpose_item<false>(w_out, DM, DM, WOUT, scr, it - I_IN, lane);
        }
        {
            constexpr int NA8 = 8 * 8 * 256 * 128 / 8, NB8 = 8 * 2 * 256 * 128 / 8;
            for (int i = bx * 512 + tid; i < 2 * NA8 + 2 * NB8; i += G * 512) {
                const float* src; bf16_t* dst; int j = i;
                if (j < NA8) { src = cache_a_k; dst = CAK; } else if ((j -= NA8) < NA8) { src = cache_a_v; dst = CAV; }
                else if ((j -= NA8) < NB8) { src = cache_b_k; dst = CBK; } else { j -= NB8; src = cache_b_v; dst = CBV; }
                const f32x4 a = *(const f32x4*)(src + (size_t)j * 8), b = *(const f32x4*)(src + (size_t)j * 8 + 4);
                u32x4 w; w.x = cvt_pk_bf16(a[0], a[1]); w.y = cvt_pk_bf16(a[2], a[3]); w.z = cvt_pk_bf16(b[0], b[1]); w.w = cvt_pk_bf16(b[2], b[3]);
                *(u32x4*)(dst + (size_t)j * 8) = w;
            }
        }
    }
    SEAM(0);
    if (IN(2)) {
        PHASE_IDS
        for (int m = 2 * gw; m < MTOK; m += 2 * NGW) {
            const float* xr = (m < NCTX) ? x_prompt + (size_t)m * DM : x_sample + (size_t)(m - NCTX) * DM;
            const float* md = MOD + (size_t)((m < NCTX) ? 0 : 1 + ((m - NCTX) >> 10)) * NMOD;
            f32x4 v[2][8]; float ss[2] = {0.f, 0.f};
#pragma unroll
            for (int r2 = 0; r2 < 2; ++r2)
#pragma unroll
                for (int i = 0; i < 8; ++i) v[r2][i] = *(const f32x4*)(xr + (size_t)r2 * DM + 4 * lane + 256 * i);
#pragma unroll
            for (int r2 = 0; r2 < 2; ++r2)
#pragma unroll
                for (int i = 0; i < 8; ++i) ss[r2] += (v[r2][i][0] * v[r2][i][0] + v[r2][i][1] * v[r2][i][1]) + (v[r2][i][2] * v[r2][i][2] + v[r2][i][3] * v[r2][i][3]);
            const float rstd0 = rsqrtf(wave_sum(ss[0]) * (1.f / DM) + EPS), rstd1 = rsqrtf(wave_sum(ss[1]) * (1.f / DM) + EPS);
            bf16_t* orow = XN + (size_t)m * DM;
#pragma unroll
            for (int i = 0; i < 8; ++i) { const int c = 4 * lane + 256 * i;
                const f32x4 g = *(const f32x4*)(g_attn_pre + c), sh = *(const f32x4*)(md + c), sc = *(const f32x4*)(md + 2048 + c);
                const f32x4 gs = g * (sc + 1.f);
                const f32x4 r0 = v[0][i] * rstd0 * gs + sh, r1 = v[1][i] * rstd1 * gs + sh;
                u32x2 w0, w1; w0.x = cvt_pk_bf16(r0[0], r0[1]); w0.y = cvt_pk_bf16(r0[2], r0[3]); w1.x = cvt_pk_bf16(r1[0], r1[1]); w1.y = cvt_pk_bf16(r1[2], r1[3]);
                *(u32x2*)(orow + c) = w0; *(u32x2*)(orow + DM + c) = w1; }
        }
    }
    SEAM(2);
    if (IN(3)) {
        PHASE_IDS
        pg8::Gemm g{XN, WIN, MTOK, NIN, DM}; pg8::StaticOrder S; S.init(MTOK, NIN, G, bx);
        pg8::EpiQKV E{QA, KA, VA, QB, KB, VB, st_ak, st_av, st_bv};
        const int hb = G >> 1;
        if (bx >= hb) {
            LAS float* scr = (LAS float*)(ldsl + wave * 8448);
            constexpr int I_UP = 32 * 352, I_DN = 88 * 64;
            for (int it = wave * (G - hb) + (bx - hb); it < I_UP + I_DN; it += 8 * (G - hb)) {
                if (it < I_UP) transpose_item<true>(w_up, DM, NUP, WUP, scr, it, lane);
                else transpose_item<false>(w_down, DFF, DM, WDN, scr, it - I_UP, lane);
            }
            __syncthreads();
        }
        pg8::gemm_phase<pg8::EpiQKV, pg8::StaticOrder, true>(ldsl, g, S, E, wave_s);
    }
    SEAM(3);
    if (IN(4)) {
        PHASE_IDS
        const int vs = lane >> 3, part = lane & 7, hsel = part >> 2;
        const int ib = 16 * (part & 1);
        const float sgn = (part & 2) ? 1.f : -1.f;
        constexpr int NIQ = MTOK * 8 / 8, NIK = MTOK * 2 / 8;
        for (int itv = gw; itv < NIQ + NIK; itv += NGW) {
            const bool isq = itv < NIQ; const int H = isq ? 8 : 2;
            const int vv = (isq ? itv : itv - NIQ) * 8 + vs;
            bf16_t* p = (isq ? QB : KB) + (size_t)vv * 128 + 16 * part;
            const float* gp = (isq ? g_qnorm : g_knorm) + 16 * part;
            const u32x4 w0 = *(const u32x4*)p, w1 = *(const u32x4*)(p + 8);
            float e[16];
#pragma unroll
            for (int q = 0; q < 4; ++q) { e[2 * q] = bf_lo(w0[q]); e[2 * q + 1] = bf_hi(w0[q]); e[8 + 2 * q] = bf_lo(w1[q]); e[8 + 2 * q + 1] = bf_hi(w1[q]); }
            float ss = 0.f;
#pragma unroll
            for (int j = 0; j < 16; ++j) ss += e[j] * e[j];
            ss += __shfl_xor(ss, 1); ss += __shfl_xor(ss, 2); ss += __shfl_xor(ss, 4);
            const float rstd = rsqrtf(ss * (1.f / 128.f) + EPS);
#pragma unroll
            for (int q = 0; q < 4; ++q) { const f32x4 g = *(const f32x4*)(gp + 4 * q);
#pragma unroll
                for (int t = 0; t < 4; ++t) e[4 * q + t] *= rstd * g[t]; }
            const int nctxv = NCTX * H;
            if (vv >= nctxv) {
                const int t = (vv - nctxv) & 1023; const float pos = (float)(hsel ? (t & 63) : (t >> 6));
#pragma unroll
                for (int j = 0; j < 16; ++j) {
                    const float other = __shfl_xor(e[j], 2);
                    float rev = pos * (exp2f(-(float)(ib + j) * (13.287712379549449f / 32.f)) * 0.15915494309189535f); rev -= floorf(rev);
                    const float sn = __builtin_amdgcn_sinf(rev), cn = __builtin_amdgcn_cosf(rev);
                    e[j] = e[j] * cn + sgn * other * sn;
                }
            } else if (!isq) {
                float* sp = st_bk + (size_t)vv * 128 + 16 * part;
#pragma unroll
                for (int q = 0; q < 4; ++q) *(f32x4*)(sp + 4 * q) = (f32x4){e[4 * q], e[4 * q + 1], e[4 * q + 2], e[4 * q + 3]};
            }
            u32x4 o0, o1;
#pragma unroll
            for (int q = 0; q < 4; ++q) { o0[q] = cvt_pk_bf16(e[2 * q], e[2 * q + 1]); o1[q] = cvt_pk_bf16(e[8 + 2 * q], e[8 + 2 * q + 1]); }
            *(u32x4*)p = o0; *(u32x4*)(p + 8) = o1;
        }
    }
    SEAM(4);
    if (IN(5)) {
        PHASE_IDS
        char* al = (char*)lds;
#ifndef AT_MASK
#define AT_MASK 15
#endif
        if (AT_MASK & 1) for (int u0 = bx; u0 < 256; u0 += G) { const int u = (G == 256) ? ((u0 & 7) * 32 + (u0 >> 3)) : u0;
                const int b = u >> 3, h = u & 7; const size_t off = ((size_t)(b * 8 + h) * 256) * 128;
                att::attn_body<false>(QA + off, KA + off, VA + off, 4, KA + off, VA + off, 4, OB + (size_t)(b * 256) * DM + h * 128, al, 0, 0, wave_s);
                __syncthreads();
        }
        if (AT_MASK & 2) for (int u0 = bx; u0 < 256; u0 += G) { const int u = (G == 256) ? ((u0 & 7) * 32 + (u0 >> 3)) : u0;
                const int b = u >> 3, qh = u & 7, kvh = qh >> 2; const size_t qoff = ((size_t)(b * 8 + qh) * 256) * 128, koff = ((size_t)(b * 2 + kvh) * 256) * 128;
                att::attn_body<false>(QB + qoff, KB + koff, VB + koff, 4, KB + koff, VB + koff, 4, OB + (size_t)(b * 256) * DM + 1024 + qh * 128, al, 0, 0, wave_s);
                __syncthreads();
        }
        if (AT_MASK & 4) for (int u0 = bx; u0 < 256; u0 += G) { const int u = (G == 256) ? ((u0 & 7) * 32 + (u0 >> 3)) : u0;
                const int b = u >> 5, qh = (u >> 2) & 7, qb = u & 3, kvh = qh >> 2;
                const size_t qoff = (size_t)NCTX * 8 * 128 + ((size_t)(b * 8 + qh) * 1024 + qb * 256) * 128;
                const size_t coff = ((size_t)(b * 2 + kvh) * 256) * 128, koff = (size_t)NCTX * 2 * 128 + ((size_t)(b * 2 + kvh) * 1024) * 128;
                att::attn_body<false>(QB + qoff, CBK + coff, CBV + coff, 4, KB + koff, VB + koff, 20, OB + (size_t)(NCTX + b * 1024 + qb * 256) * DM + 1024 + qh * 128, al, 0, 0, wave_s);
                __syncthreads();
        }
        if (AT_MASK & 8) for (int u0 = bx; u0 < 256; u0 += G) { const int u = (G == 256) ? ((u0 & 7) * 32 + (u0 >> 3)) : u0;
                const int b = u >> 5, h = (u >> 2) & 7, qb = u & 3;
                float* bt = (float*)(al + att::BIAS_OFF);
                for (int i = tid; i < att::BIAS_FLOATS; i += 512) { const int k = i - 64; bt[i] = (k >= 0 && k < 465) ? rpb[h * 465 + k] * (1.f / att::SCALE) : 0.f; }
                const int krlo = (qb == 0 || qb == 1) ? 0 : (qb == 2 ? 4 : 8), nrows = (qb == 0 || qb == 3) ? 8 : 12;
                const size_t qoff = (size_t)NCTX * 8 * 128 + ((size_t)(b * 8 + h) * 1024 + qb * 256) * 128;
                const size_t coff = ((size_t)(b * 8 + h) * 256) * 128, koff = (size_t)NCTX * 8 * 128 + ((size_t)(b * 8 + h) * 1024 + krlo * 64) * 128;
                att::attn_body<true>(QA + qoff, CAK + coff, CAV + coff, 4, KA + koff, VA + koff, 4 + nrows, OB + (size_t)(NCTX + b * 1024 + qb * 256) * DM + h * 128, al, qb * 4, krlo, wave_s);
                __syncthreads();
        }
    }
    SEAM(5);
    if (IN(6)) {
        pg8::Gemm g{OB, WOUT, MTOK, DM, DM}; pg8::StaticOrder S; S.init(MTOK, DM, G, bx);
        pg8::EpiBf16 E{P1, DM};
        pg8::gemm_phase<pg8::EpiBf16, pg8::StaticOrder, true>(ldsl, g, S, E, wave_s);
    }
    SEAM(6);
    if (IN(7)) {
        PHASE_IDS
        for (int m = 2 * gw; m < MTOK; m += 2 * NGW) {
            const float* xr = (m < NCTX) ? x_prompt + (size_t)m * DM : x_sample + (size_t)(m - NCTX) * DM;
            const float* md = MOD + (size_t)((m < NCTX) ? 0 : 1 + ((m - NCTX) >> 10)) * NMOD;
            const bf16_t* pr = P1 + (size_t)m * DM;
            float v[2][4][8]; float ss[2] = {0.f, 0.f};
            u32x4 pw[2][4];
#pragma unroll
            for (int r2 = 0; r2 < 2; ++r2)
#pragma unroll
                for (int i = 0; i < 4; ++i) pw[r2][i] = *(const u32x4*)(pr + (size_t)r2 * DM + 8 * lane + 512 * i);
#pragma unroll
            for (int r2 = 0; r2 < 2; ++r2)
#pragma unroll
                for (int i = 0; i < 4; ++i)
#pragma unroll
                    for (int q = 0; q < 4; ++q) { const float lo_ = bf_lo(pw[r2][i][q]), hi_ = bf_hi(pw[r2][i][q]); v[r2][i][2 * q] = lo_; v[r2][i][2 * q + 1] = hi_; ss[r2] += lo_ * lo_ + hi_ * hi_; }
            float rstd[2]; rstd[0] = rsqrtf(wave_sum(ss[0]) * (1.f / DM) + EPS); rstd[1] = rsqrtf(wave_sum(ss[1]) * (1.f / DM) + EPS);
            float ss2[2] = {0.f, 0.f};
#pragma unroll
            for (int i = 0; i < 4; ++i) { const int c = 8 * lane + 512 * i;
                float gg[8];
#pragma unroll
                for (int h2 = 0; h2 < 2; ++h2) {
                    const f32x4 g = *(const f32x4*)(g_attn_post + c + 4 * h2), ga = *(const f32x4*)(md + 4096 + c + 4 * h2);
#pragma unroll
                    for (int e = 0; e < 4; ++e) gg[4 * h2 + e] = g[e] * ga[e]; }
#pragma unroll
                for (int r2 = 0; r2 < 2; ++r2) {
                    const f32x4 xa = *(const f32x4*)(xr + (size_t)r2 * DM + c), xb = *(const f32x4*)(xr + (size_t)r2 * DM + c + 4);
                    float r[8];
#pragma unroll
                    for (int e = 0; e < 8; ++e) { r[e] = (e < 4 ? xa[e & 3] : xb[e & 3]) + gg[e] * (v[r2][i][e] * rstd[r2]); v[r2][i][e] = r[e]; ss2[r2] += r[e] * r[e]; }
                    u32x4 w; w.x = cvt_pk_bf16(r[0], r[1]); w.y = cvt_pk_bf16(r[2], r[3]); w.z = cvt_pk_bf16(r[4], r[5]); w.w = cvt_pk_bf16(r[6], r[7]);
                    *(u32x4*)(X1B + (size_t)(m + r2) * DM + c) = w; } }
            float rs2[2]; rs2[0] = rsqrtf(wave_sum(ss2[0]) * (1.f / DM) + EPS); rs2[1] = rsqrtf(wave_sum(ss2[1]) * (1.f / DM) + EPS);
            bf16_t* orow = XN + (size_t)m * DM;
#pragma unroll
            for (int i = 0; i < 4; ++i) { const int c = 8 * lane + 512 * i;
                float gsv[8], shv[8];
#pragma unroll
                for (int h2 = 0; h2 < 2; ++h2) {
                    const f32x4 g = *(const f32x4*)(g_ffn_pre + c + 4 * h2), sh = *(const f32x4*)(md + 6144 + c + 4 * h2), sc = *(const f32x4*)(md + 8192 + c + 4 * h2);
#pragma unroll
                    for (int e = 0; e < 4; ++e) { gsv[4 * h2 + e] = g[e] * (sc[e] + 1.f); shv[4 * h2 + e] = sh[e]; } }
#pragma unroll
                for (int r2 = 0; r2 < 2; ++r2) {
                    float r[8];
#pragma unroll
                    for (int e = 0; e < 8; ++e) r[e] = v[r2][i][e] * rs2[r2] * gsv[e] + shv[e];
                    u32x4 w; w.x = cvt_pk_bf16(r[0], r[1]); w.y = cvt_pk_bf16(r[2], r[3]); w.z = cvt_pk_bf16(r[4], r[5]); w.w = cvt_pk_bf16(r[6], r[7]);
                    *(u32x4*)(orow + (size_t)r2 * DM + c) = w; } }
        }
    }
    SEAM(7);
    if (IN(8)) {
        pg8::Gemm g{XN, WUP, MTOK, NUP, DM}; pg8::StaticOrder S; S.init(MTOK, NUP, G, bx);
        pg8::EpiConv E{ACT, HBUF, conv_w, conv_b, (LAS float*)(ldsl + 131072)};
        pg8::gemm_phase<pg8::EpiConv, pg8::StaticOrder, true>(ldsl, g, S, E, wave_s);
    }
    SEAM(8);
    if (IN(9)) {
        PHASE_IDS
        for (int it = gw; it < 32 * 2 * 22; it += NGW) {
            const int seg = it % 22, side = (it / 22) & 1, lt = it / 44; const int q = lt & 3;
            if ((side == 0 && q == 0) || (side == 1 && q == 3)) continue;
            const int ch = seg * 256 + lane * 4;
            f32x4 r[2];
#pragma unroll
            for (int bj = 0; bj < 2; ++bj) {
                const float* hp = HBUF + (size_t)bj * DFF + ch;
                const f32x4 up = *(const f32x4*)(hp + (size_t)((side ? lt * 4 + 2 : (lt - 1) * 4 + 3) * 2) * DFF);
                const f32x4 cu = *(const f32x4*)(hp + (size_t)((side ? lt * 4 + 3 : lt * 4 + 0) * 2) * DFF);
                const f32x4 dn = *(const f32x4*)(hp + (size_t)((side ? (lt + 1) * 4 + 0 : lt * 4 + 1) * 2) * DFF);
                const f32x4 w0 = *(const f32x4*)(conv_w + bj * DFF + ch), w1 = *(const f32x4*)(conv_w + NUP + bj * DFF + ch), w2 = *(const f32x4*)(conv_w + 2 * NUP + bj * DFF + ch);
                r[bj] = w0 * up + w1 * cu + w2 * dn + *(const f32x4*)(conv_b + bj * DFF + ch);
            }
            float a[4];
#pragma unroll
            for (int e = 0; e < 4; ++e) a[e] = r[1][e] * __builtin_amdgcn_rcpf(1.f + __expf(-r[1][e])) * r[0][e];
            u32x2 ow; ow.x = cvt_pk_bf16(a[0], a[1]); ow.y = cvt_pk_bf16(a[2], a[3]);
            *(u32x2*)(ACT + (size_t)(NCTX + lt * 256 + (side ? 255 : 0)) * DFF + ch) = ow;
        }
    }
    SEAM(9);
    if (IN(10)) {
        PHASE_IDS
        pg8::Gemm g{ACT, WDN, MTOK, DM, DFF}; pg8::StaticOrder S; S.init(MTOK, DM, G, bx);
        pg8::EpiBf16 E{P2, DM};
        pg8::gemm_phase<pg8::EpiBf16, pg8::StaticOrder, true>(ldsl, g, S, E, wave_s);
    }
    SEAM(10);
    if (IN(11)) {
        PHASE_IDS
        for (int m = 2 * gw; m < MTOK; m += 2 * NGW) {
            const float* md = MOD + (size_t)((m < NCTX) ? 0 : 1 + ((m - NCTX) >> 10)) * NMOD;
            const bf16_t* pr = P2 + (size_t)m * DM;
            float v[2][4][8]; float ss[2] = {0.f, 0.f};
            u32x4 pw[2][4];
#pragma unroll
            for (int r2 = 0; r2 < 2; ++r2)
#pragma unroll
                for (int i = 0; i < 4; ++i) pw[r2][i] = *(const u32x4*)(pr + (size_t)r2 * DM + 8 * lane + 512 * i);
#pragma unroll
            for (int r2 = 0; r2 < 2; ++r2)
#pragma unroll
                for (int i = 0; i < 4; ++i)
#pragma unroll
                    for (int q = 0; q < 4; ++q) { const float lo_ = bf_lo(pw[r2][i][q]), hi_ = bf_hi(pw[r2][i][q]); v[r2][i][2 * q] = lo_; v[r2][i][2 * q + 1] = hi_; ss[r2] += lo_ * lo_ + hi_ * hi_; }
            float rstd[2]; rstd[0] = rsqrtf(wave_sum(ss[0]) * (1.f / DM) + EPS); rstd[1] = rsqrtf(wave_sum(ss[1]) * (1.f / DM) + EPS);
#pragma unroll
            for (int i = 0; i < 4; ++i) { const int c = 8 * lane + 512 * i;
#pragma unroll
                for (int h2 = 0; h2 < 2; ++h2) {
                    const f32x4 g = *(const f32x4*)(g_ffn_post + c + 4 * h2), ga = *(const f32x4*)(md + 10240 + c + 4 * h2);
                    const f32x4 gg = g * ga;
#pragma unroll
                    for (int r2 = 0; r2 < 2; ++r2) {
                        const u32x2 xw = *(const u32x2*)(X1B + (size_t)(m + r2) * DM + c + 4 * h2);
                        const float xv[4] = {bf_lo(xw.x), bf_hi(xw.x), bf_lo(xw.y), bf_hi(xw.y)};
                        f32x4 r;
#pragma unroll
                        for (int e = 0; e < 4; ++e) r[e] = xv[e] + gg[e] * (v[r2][i][4 * h2 + e] * rstd[r2]);
                        *(f32x4*)(Y_ + (size_t)(m + r2) * DM + c + 4 * h2) = r; } } }
        }
    }
#undef IN
#undef SEAM
#undef ws
#undef x_prompt
#undef x_sample
#undef cvec
#undef cache_a_k
#undef cache_a_v
#undef cache_b_k
#undef cache_b_v
#undef c_ctx
#undef w_mod
#undef b_mod
#undef g_attn_pre
#undef g_attn_post
#undef g_ffn_pre
#undef g_ffn_post
#undef w_in
#undef rpb
#undef g_qnorm
#undef g_knorm
#undef w_out
#undef w_up
#undef conv_w
#undef conv_b
#undef w_down
#undef Y_
#undef st_ak
#undef st_av
#undef st_bk
#undef st_bv
#undef MOD
#undef MODP
#undef WIN
#undef WOUT
#undef WUP
#undef WDN
#undef XN
#undef CAK
#undef CAV
#undef CBK
#undef CBV
#undef QA
#undef KA
#undef VA
#undef QB
#undef KB
#undef VB
#undef OB
#undef P1
#undef P2
#undef ACT
#undef HBUF
#undef X1B
}

extern "C" void kernel_launch(void* const* d_in, const int* in_sizes, int n_in, void* d_out, int out_size, void* d_ws, size_t ws_size, hipStream_t stream) {
    static int grid = 0;
    if (grid == 0) {
        if (n_in != 23 || ws_size < WS_END) { fprintf(stderr, "kernel_launch: unexpected n_in %d or ws_size %zu (need %zu)\n", n_in, ws_size, (size_t)WS_END); grid = -1; return; }
        int dev = 0, cus = 0, per_cu = 0;
        hipGetDevice(&dev);
        hipDeviceGetAttribute(&cus, hipDeviceAttributeMultiprocessorCount, dev);
        if (hipFuncSetAttribute((const void*)mk_fwd, hipFuncAttributeMaxDynamicSharedMemorySize, LDS_BYTES) != hipSuccess) { fprintf(stderr, "kernel_launch: hipFuncSetAttribute failed\n"); grid = -1; return; }
        if (hipOccupancyMaxActiveBlocksPerMultiprocessor(&per_cu, (const void*)mk_fwd, 512, LDS_BYTES) != hipSuccess || per_cu < 1) { fprintf(stderr, "kernel_launch: occupancy query failed (%d)\n", per_cu); per_cu = 1; }
        (void)hipGetLastError();
        grid = cus * (per_cu > 1 ? 1 : per_cu);
        if (grid > 256) grid = 256;
    }
    if (grid < 0) return;
    if (hipMemsetAsync((char*)d_ws + WS_CTL, 0, CTL_BYTES, stream) != hipSuccess) { fprintf(stderr, "kernel_launch: memset failed\n"); return; }
    Args a{};
    for (int i = 0; i < 23; ++i) a.in[i] = (const float*)d_in[i];
    a.out = (float*)d_out; a.ws = (unsigned char*)d_ws; a.ph_lo = 0; a.ph_hi = 12;
    void* kargs[] = {&a};
    hipError_t e = hipLaunchCooperativeKernel((const void*)mk_fwd, dim3(grid), dim3(512), kargs, LDS_BYTES, stream);
    if (e != hipSuccess) fprintf(stderr, "kernel_launch: cooperative launch failed: %s (grid %d)\n", hipGetErrorString(e), grid);
}
```

```cpp
#include <hip/hip_runtime.h>
#include <hip/hip_cooperative_groups.h>
#include <cstdio>
#include <cstdint>
namespace cg = cooperative_groups;

#define LAS __attribute__((address_space(3)))
typedef unsigned short bf16_t;
typedef short bf16x8 __attribute__((ext_vector_type(8)));
typedef short s16x4 __attribute__((ext_vector_type(4)));
typedef float f32x4 __attribute__((ext_vector_type(4)));
typedef float f32x16 __attribute__((ext_vector_type(16)));
typedef unsigned u32x4 __attribute__((ext_vector_type(4)));
typedef unsigned u32x2 __attribute__((ext_vector_type(2)));

constexpr int DM = 2048, MTOK = 16384, NCTX = 8192, DFF = 5632, NUP = 11264, NIN = 4608, NMOD = 12288;
constexpr float EPS = 1e-6f;
constexpr int CHROWS = 4096;

constexpr size_t MiB = 1u << 20;
constexpr size_t WS_MOD = 0, WS_WDN = 1 * MiB, WS_XN = 23 * MiB, WS_WIN = 87 * MiB, WS_WOUT = 105 * MiB, WS_WUP = 113 * MiB;
constexpr size_t WS_CAK = 157 * MiB, WS_CAV = 161 * MiB, WS_CBK = 165 * MiB, WS_CBV = 166 * MiB;
constexpr size_t WS_QA = 167 * MiB, WS_KA = 199 * MiB, WS_VA = 231 * MiB, WS_QB = 263 * MiB, WS_KB = 295 * MiB, WS_VB = 303 * MiB;
constexpr size_t WS_O = 311 * MiB, WS_MODP = 311 * MiB;
constexpr size_t WS_P1 = 167 * MiB;
constexpr size_t WS_ACT = 157 * MiB, WS_U = 333 * MiB, WS_X1 = 341 * MiB;
constexpr size_t WS_P2 = 23 * MiB;
constexpr size_t WS_END = 421 * MiB;

constexpr int LDS_BYTES = 147456, MISC_OFF = 147200;
constexpr size_t WS_CTL = 512 * 1024, CTL_BYTES = 16384;

__device__ __forceinline__ unsigned cvt_pk_bf16(float lo, float hi) { unsigned r; asm volatile("v_cvt_pk_bf16_f32 %0, %1, %2" : "=v"(r) : "v"(lo), "v"(hi)); return r; }
__device__ __forceinline__ float bf_lo(unsigned w) { return __uint_as_float(w << 16); }
__device__ __forceinline__ float bf_hi(unsigned w) { return __uint_as_float(w & 0xffff0000u); }
__device__ __forceinline__ int tid_of(int wave_s) { unsigned z; asm volatile("v_mov_b32 %0, 0" : "=v"(z) :: "memory");
    return wave_s * 64 + (int)__builtin_amdgcn_mbcnt_hi(~0u, __builtin_amdgcn_mbcnt_lo(~0u, z)); }
__device__ __forceinline__ float wave_sum(float v) {
#pragma unroll
    for (int o = 1; o < 64; o <<= 1) v += __shfl_xor(v, o);
    return v;
}


#define XB_TMO      128
#define XB_XCNT(j)  (256  + 64 * (j))
#define XB_XSUB(j)  (1280 + 64 * (j))
#define XB_XGEN(j)  (2304 + 64 * (j))
#define XB_TOP      3328
#define XB_TOPGEN   3392
#define XCD_BAR_WORDS 3456
#define XB_SPIN_CAP (1u << 18)
__device__ __forceinline__ unsigned xb_ld(unsigned* p)              { return __hip_atomic_load(p, __ATOMIC_RELAXED, __HIP_MEMORY_SCOPE_AGENT); }
__device__ __forceinline__ unsigned xb_add(unsigned* p, unsigned v) { return __hip_atomic_fetch_add(p, v, __ATOMIC_RELAXED, __HIP_MEMORY_SCOPE_AGENT); }
__device__ __forceinline__ unsigned xb_xcc_id() { return (unsigned)__builtin_amdgcn_s_getreg((3 << 11) | 20) & 0xFu; }
#define XB_SPIN(cond, bar) do { unsigned _sp = 0; while (cond) { __builtin_amdgcn_s_sleep(1); \
    if ((++_sp & 255u) == 0u) { if (xb_ld(&(bar)[XB_TMO])) break; if (_sp > XB_SPIN_CAP) { atomicAdd(&(bar)[XB_TMO], 1u); break; } } } } while (0)
struct XcdBarrier { unsigned* bar; unsigned x; volatile LAS unsigned* st; };
__device__ __forceinline__ XcdBarrier xcd_barrier_post(unsigned* bar, volatile LAS unsigned* st, int wave_s) {
    XcdBarrier b; b.bar = bar; b.x = xb_xcc_id(); b.st = st;
    if (tid_of(wave_s) == 0) (void)xb_add(&bar[XB_XCNT(b.x)], 1u);
    return b;
}
__device__ __forceinline__ void xcd_barrier_complete(unsigned* bar, unsigned x, unsigned& nloc, unsigned& nx) {
    const unsigned G = gridDim.x * gridDim.y * gridDim.z;
    unsigned sum, cnt, mine, sp = 0u;
    for (;;) {
        sum = 0u; cnt = 0u; mine = 0u;
#pragma unroll
        for (unsigned j = 0; j < 16; ++j) { const unsigned c = xb_ld(&bar[XB_XCNT(j)]); sum += c; cnt += (c > 0u) ? 1u : 0u; mine = (j == x) ? c : mine; }
        if (sum == G) break;
        __builtin_amdgcn_s_sleep(1);
        if ((++sp & 255u) == 0u) { if (xb_ld(&bar[XB_TMO])) break; if (sp > XB_SPIN_CAP) { atomicAdd(&bar[XB_TMO], 1u); break; } }
    }
    nloc = mine > 0u ? mine : 1u; nx = cnt > 0u ? cnt : 1u;
}
__device__ __forceinline__ void xcd_barrier(const XcdBarrier& b, int wave_s) {
    asm volatile("s_waitcnt vmcnt(0)" ::: "memory");
    __syncthreads();
    if (tid_of(wave_s) == 0) {
        unsigned* bar = b.bar;
        __builtin_amdgcn_s_waitcnt(0);
        unsigned nloc = b.st[0], nx = b.st[1];
        if (nloc == 0u) { xcd_barrier_complete(bar, b.x, nloc, nx); b.st[0] = nloc; b.st[1] = nx; }
        const unsigned old = xb_add(&bar[XB_XSUB(b.x)], 1u);
        const unsigned gen = old / nloc;
        if (old + 1u == (gen + 1u) * nloc) {
            __builtin_amdgcn_fence(__ATOMIC_RELEASE, "agent");
            asm volatile("s_waitcnt vmcnt(0)" ::: "memory");
            const unsigned og = xb_add(&bar[XB_TOP], 1u);
            const unsigned tg = og / nx;
            if (og + 1u == (tg + 1u) * nx) xb_add(&bar[XB_TOPGEN], 1u);
            else XB_SPIN(xb_ld(&bar[XB_TOPGEN]) == tg, bar);
            __builtin_amdgcn_fence(__ATOMIC_ACQUIRE, "agent");
            xb_add(&bar[XB_XGEN(b.x)], 1u);
            asm volatile("s_waitcnt vmcnt(0)" ::: "memory");
        } else {
            XB_SPIN(xb_ld(&bar[XB_XGEN(b.x)]) == gen, bar);
            __builtin_amdgcn_fence(__ATOMIC_ACQUIRE, "agent");
            asm volatile("s_waitcnt vmcnt(0)" ::: "memory");
        }
    }
    __syncthreads();
}

namespace pg8 {
constexpr int BM = 256, BK = 64, HALF = 128, HTB = HALF * BK * 2, STAGE_BYTES = 8 * HTB, NXCD = 8, WGM = 8;
__host__ __device__ __forceinline__ int lds_byte(int r, int c) { const int st = (r >> 4) * 2 + (c >> 5), rr = r & 15, cc = c & 31, ob = rr * 64 + cc * 2; return st * 1024 + (ob ^ (((ob >> 9) & 1) << 5)); }
__host__ __device__ __forceinline__ void stage_rc(int b, int& R, int& C) { const int st = b / 1024, sb = b % 1024, swz = sb ^ (((sb >> 9) & 1) << 5); R = (st >> 1) * 16 + swz / 64; C = (st & 1) * 32 + (swz % 64) / 2; }
__host__ __device__ __forceinline__ int perm32(int rho) { const int n = rho >> 4, i = rho & 15; return 8 * (i >> 2) + 4 * n + (i & 3); }

struct Unit { int pm, pn; };
struct Gemm { const bf16_t* A; const bf16_t* Bt; int M, N, K; };

struct StaticOrder {
    int nM, nN, nwg, G, c;
    __host__ __device__ void init(int M, int N, int G_, int c_) { nM = M / BM; nN = N / BM; nwg = nM * nN; G = G_; c = c_; }
    __host__ __device__ bool next(int i, Unit& u) const {
        const long L = (long)i * G + c; if (L >= nwg) return false;
        int wgid = (int)L; { const int q = nwg / NXCD, r = nwg % NXCD, xcd = wgid % NXCD, off = wgid / NXCD; wgid = (xcd < r ? xcd * (q + 1) : r * (q + 1) + (xcd - r) * q) + off; }
        const int nig = WGM * nN, gid = wgid / nig, fm = gid * WGM, gsz = (nM - fm) < WGM ? (nM - fm) : WGM;
        u.pm = fm + ((wgid % nig) % gsz); u.pn = (wgid % nig) / gsz; return true;
    }
    __device__ __forceinline__ void a_ready(const Unit&) const {}
    __device__ __forceinline__ void done(const Unit&) const {}
};

__device__ __forceinline__ u32x4 quad_xpose(u32x4 w, int src4) {
    u32x4 r;
    r.x = (unsigned)__builtin_amdgcn_ds_bpermute(src4, (int)w.x); r.y = (unsigned)__builtin_amdgcn_ds_bpermute(src4, (int)w.y);
    r.z = (unsigned)__builtin_amdgcn_ds_bpermute(src4, (int)w.z); r.w = (unsigned)__builtin_amdgcn_ds_bpermute(src4, (int)w.w);
    return r;
}
struct EpiF32 {
    static constexpr bool PERM = false, AFTER_DRAIN = false;
    float* C; int ldc;
    __device__ __forceinline__ void operator()(const f32x4 (&acc)[2][2][4][2], const Unit& u, int wr, int wc, int fr, int fq) const {
        const int row0 = u.pm * BM + wr * 64 + fr, col0 = u.pn * BM + wc * 32 + 4 * fq;
#pragma unroll
        for (int ai = 0; ai < 2; ++ai)
#pragma unroll
            for (int m = 0; m < 4; ++m) { float* rowp = C + (size_t)(row0 + ai * HALF + m * 16) * ldc + col0;
#pragma unroll
                for (int bj = 0; bj < 2; ++bj)
#pragma unroll
                    for (int n = 0; n < 2; ++n) *(f32x4*)(rowp + bj * HALF + n * 16) = acc[ai][bj][m][n]; }
    }
};
struct EpiBf16 {
    static constexpr bool PERM = true, AFTER_DRAIN = false;
    bf16_t* O; int ldc;
    __device__ __forceinline__ void operator()(const f32x4 (&acc)[2][2][4][2], const Unit& u, int wr, int wc, int fr, int fq) const {
        const int ln = fr + 16 * fq, r4 = ln >> 2, c4 = ln & 3, src4 = 4 * (16 * c4 + r4);
        const int row0 = u.pm * BM + wr * 64 + r4, col0 = u.pn * BM + wc * 32 + 8 * c4;
#pragma unroll
        for (int ai = 0; ai < 2; ++ai)
#pragma unroll
            for (int m = 0; m < 4; ++m) { bf16_t* rowp = O + (size_t)(row0 + ai * HALF + m * 16) * ldc + col0;
#pragma unroll
                for (int bj = 0; bj < 2; ++bj) { const f32x4 v0 = acc[ai][bj][m][0], v1 = acc[ai][bj][m][1];
                    u32x4 w; w.x = cvt_pk_bf16(v0[0], v0[1]); w.y = cvt_pk_bf16(v0[2], v0[3]); w.z = cvt_pk_bf16(v1[0], v1[1]); w.w = cvt_pk_bf16(v1[2], v1[3]);
                    *(u32x4*)(rowp + bj * HALF) = quad_xpose(w, src4); } }
    }
};
struct EpiQKV {
    static constexpr bool PERM = true, AFTER_DRAIN = false;
    bf16_t *QA, *KA, *VA, *QB, *KB, *VB; float *sak, *sav, *sbv;
    __device__ __forceinline__ void operator()(const f32x4 (&acc)[2][2][4][2], const Unit& u, int wr, int wc, int fr, int fq) const {
        const int pn = u.pn, pm = u.pm;
        bf16_t* buf; int H, h0; float* st = nullptr;
        if (pn < 4) { buf = QA; H = 8; h0 = 2 * pn; }
        else if (pn < 8) { buf = KA; H = 8; h0 = 2 * (pn - 4); st = sak; }
        else if (pn < 12) { buf = VA; H = 8; h0 = 2 * (pn - 8); st = sav; }
        else if (pn < 16) { buf = QB; H = 8; h0 = 2 * (pn - 12); }
        else if (pn == 16) { buf = KB; H = 2; h0 = 0; }
        else { buf = VB; H = 2; h0 = 0; st = sbv; }
        const bool ctx = pm < 32;
        int b, t0, L; size_t reg;
        if (ctx) { b = pm; t0 = 0; L = 256; reg = 0; } else { b = (pm - 32) >> 2; t0 = ((pm - 32) & 3) * 256; L = 1024; reg = (size_t)NCTX * H * 128; }
#pragma unroll
        for (int bj = 0; bj < 2; ++bj) {
            const int h = h0 + bj;
            bf16_t* base = buf + reg + ((size_t)(b * H + h) * L + t0) * 128 + wc * 32 + 8 * fq;
            float* sbase = st + ((size_t)(b * H + h) * 256) * 128 + wc * 32 + 8 * fq;
#pragma unroll
            for (int ai = 0; ai < 2; ++ai)
#pragma unroll
                for (int m = 0; m < 4; ++m) {
                    const int t = ai * HALF + wr * 64 + m * 16 + fr;
                    const f32x4 v0 = acc[ai][bj][m][0], v1 = acc[ai][bj][m][1];
                    u32x4 w; w.x = cvt_pk_bf16(v0[0], v0[1]); w.y = cvt_pk_bf16(v0[2], v0[3]); w.z = cvt_pk_bf16(v1[0], v1[1]); w.w = cvt_pk_bf16(v1[2], v1[3]);
                    *(u32x4*)(base + (size_t)t * 128) = w;
                    if (ctx && st) { *(f32x4*)(sbase + (size_t)t * 128) = v0; *(f32x4*)(sbase + (size_t)t * 128 + 4) = v1; }
                    asm volatile("" ::: "memory");
                }
        }
    }
};


template <int CTRL> __device__ __forceinline__ float dppf(float old, float src) {
    return __builtin_bit_cast(float, __builtin_amdgcn_update_dpp(__builtin_bit_cast(int, old), __builtin_bit_cast(int, src), CTRL, 0xF, 0xF, false));
}
struct EpiConv {
    static constexpr bool PERM = true, AFTER_DRAIN = false;
    bf16_t* ACT; float* HB; const float* cw; const float* cb; LAS float* H;
    __device__ __forceinline__ void operator()(const f32x4 (&acc)[2][2][4][2], const Unit& u, int wr, int wc, int fr, int fq) const {
        const int pm = u.pm, pn = u.pn;
        const int cl = 32 * wc + 8 * fq, j0 = 128 * pn + cl;
#pragma unroll
        for (int ai = 0; ai < 2; ++ai) { const int blk = ai * 2 + wr;
            if (fr == 0) {
#pragma unroll
                for (int bj = 0; bj < 2; ++bj)
#pragma unroll
                    for (int n = 0; n < 2; ++n) *(LAS f32x4*)(H + ((blk * 2 + 0) * 2 + bj) * 128 + cl + 4 * n) = acc[ai][bj][0][n]; }
            if (fr == 15) {
#pragma unroll
                for (int bj = 0; bj < 2; ++bj)
#pragma unroll
                    for (int n = 0; n < 2; ++n) *(LAS f32x4*)(H + ((blk * 2 + 1) * 2 + bj) * 128 + cl + 4 * n) = acc[ai][bj][3][n]; } }
        if (pm >= 32) { const int lt = pm - 32;
            if (wr == 0 && fr < 2) {
#pragma unroll
                for (int bj = 0; bj < 2; ++bj)
#pragma unroll
                    for (int n = 0; n < 2; ++n) *(f32x4*)(HB + ((size_t)((lt * 4 + fr) * 2 + bj)) * DFF + j0 + 4 * n) = acc[0][bj][0][n]; }
            if (wr == 1 && fr >= 14) {
#pragma unroll
                for (int bj = 0; bj < 2; ++bj)
#pragma unroll
                    for (int n = 0; n < 2; ++n) *(f32x4*)(HB + ((size_t)((lt * 4 + fr - 12) * 2 + bj)) * DFF + j0 + 4 * n) = acc[1][bj][3][n]; } }
        asm volatile("s_waitcnt lgkmcnt(0)" ::: "memory"); __builtin_amdgcn_s_barrier(); asm volatile("" ::: "memory");
        u32x2 keep[2][4];
        const int ln = fr + 16 * fq, r4 = ln >> 2, c4 = ln & 3, src4 = 4 * (16 * c4 + r4);
#pragma unroll
        for (int n = 0; n < 2; ++n) {
            f32x4 w[3][2], bs[2];
#pragma unroll
            for (int bj = 0; bj < 2; ++bj) { bs[bj] = *(const f32x4*)(cb + bj * DFF + j0 + 4 * n);
#pragma unroll
                for (int k = 0; k < 3; ++k) w[k][bj] = *(const f32x4*)(cw + (size_t)k * NUP + bj * DFF + j0 + 4 * n); }
#pragma unroll
            for (int ai = 0; ai < 2; ++ai) { const int blk = ai * 2 + wr;
                f32x4 hu[2], hd[2];
#pragma unroll
                for (int bj = 0; bj < 2; ++bj) {
                    hu[bj] = (blk > 0) ? *(const LAS f32x4*)(H + (((blk - 1) * 2 + 1) * 2 + bj) * 128 + cl + 4 * n) : (f32x4){0.f, 0.f, 0.f, 0.f};
                    hd[bj] = (blk < 3) ? *(const LAS f32x4*)(H + (((blk + 1) * 2 + 0) * 2 + bj) * 128 + cl + 4 * n) : (f32x4){0.f, 0.f, 0.f, 0.f}; }
#pragma unroll
                for (int m = 0; m < 4; ++m) {
                    float a[4];
#pragma unroll
                    for (int e = 0; e < 4; ++e) {
                        float r[2];
#pragma unroll
                        for (int bj = 0; bj < 2; ++bj) {
                            const float cur = acc[ai][bj][m][n][e];
                            const float upT = (m == 0) ? hu[bj][e] : dppf<0x121>(0.f, acc[ai][bj][m == 0 ? 0 : m - 1][n][e]);
                            const float up = dppf<0x111>(upT, cur);
                            const float dnT = (m == 3) ? hd[bj][e] : dppf<0x12F>(0.f, acc[ai][bj][m == 3 ? 3 : m + 1][n][e]);
                            const float dn = dppf<0x101>(dnT, cur);
                            r[bj] = w[0][bj][e] * up + w[1][bj][e] * cur + w[2][bj][e] * dn + bs[bj][e];
                        }
                        a[e] = r[1] * __builtin_amdgcn_rcpf(1.f + __expf(-r[1])) * r[0];
                    }
                    u32x2 ow; ow.x = cvt_pk_bf16(a[0], a[1]); ow.y = cvt_pk_bf16(a[2], a[3]);
                    if (n == 0) keep[ai][m] = ow;
                    else { u32x4 w16; w16.x = keep[ai][m].x; w16.y = keep[ai][m].y; w16.z = ow.x; w16.w = ow.y;
                        *(u32x4*)(ACT + (size_t)(pm * BM + ai * HALF + wr * 64 + m * 16 + r4) * DFF + 128 * pn + 32 * wc + 8 * c4) = quad_xpose(w16, src4); }
                }
            }
        }
    }
};

template <class Epi, class Sched, bool ALIGN_EPI = true>
__device__ __forceinline__ void gemm_phase(LAS unsigned char* lds, const Gemm g, const Sched& S, const Epi& E, int wave_s) {
    const int tid = tid_of(wave_s);
    const int wid = wave_s, lane = tid & 63, wr = wid >> 2, wc = wid & 3, fr = lane & 15, fq = lane >> 4;
    const int K = g.K, nt = K / BK;
    unsigned voffA[2], voffB[2];
#pragma unroll
    for (int i = 0; i < 2; ++i) { int R, C; stage_rc(tid * 16 + i * 8192, R, C); const int Rb = Epi::PERM ? ((R & ~31) + perm32(R & 31)) : R;
        voffA[i] = (unsigned)(R * K + C) * 2u; voffB[i] = (unsigned)(Rb * K + C) * 2u; }
    const size_t kstep = (size_t)(BK * 2);
    const size_t hstep = (size_t)HALF * K * 2;
    const size_t tstep = 2 * hstep;
    const unsigned ldsw = (unsigned)wid * 1024u;
    const int aoff = lds_byte(wr * 64 + fr, fq * 8), boff = lds_byte(wc * 32 + fr, fq * 8);
#define PG8_SA(b, h) (((b) * 2 + (h)) * HTB)
#define PG8_SB(b, h) ((4 + (b) * 2 + (h)) * HTB)
#define PG8_STAGE(bufoff, gbase, voff) do { _Pragma("unroll") for (int _i = 0; _i < 2; ++_i) \
        __builtin_amdgcn_global_load_lds((const unsigned*)((const char*)(gbase) + (voff)[_i]), (LAS unsigned*)(lds + (bufoff) + ldsw + _i * 8192), 16, 0, 0); } while (0)
#define PG8_LDA(dst, b, h) do { _Pragma("unroll") for (int m = 0; m < 4; ++m) _Pragma("unroll") for (int k = 0; k < 2; ++k) dst[m][k] = *(const LAS bf16x8*)(lds + PG8_SA(b, h) + aoff + m * 2048 + k * 1024); } while (0)
#define PG8_LDB(dst, b, h) do { _Pragma("unroll") for (int n = 0; n < 2; ++n) _Pragma("unroll") for (int k = 0; k < 2; ++k) dst[n][k] = *(const LAS bf16x8*)(lds + PG8_SB(b, h) + boff + n * 2048 + k * 1024); } while (0)
#define PG8_MMA(ai, bj, At, Bt) do { __builtin_amdgcn_s_setprio(1); _Pragma("unroll") for (int m = 0; m < 4; ++m) _Pragma("unroll") for (int n = 0; n < 2; ++n) _Pragma("unroll") for (int k = 0; k < 2; ++k) \
        acc[ai][bj][m][n] = __builtin_amdgcn_mfma_f32_16x16x32_bf16(Bt[n][k], At[m][k], acc[ai][bj][m][n], 0, 0, 0); __builtin_amdgcn_s_setprio(0); } while (0)
#define PG8_WAIT_V(n) asm volatile("s_waitcnt vmcnt(" #n ")" ::: "memory")
#define PG8_WAIT_L(n) asm volatile("s_waitcnt lgkmcnt(" #n ")" ::: "memory")
#define PG8_BAR __builtin_amdgcn_s_barrier()
#define PG8_SCHED __builtin_amdgcn_sched_barrier(0)
    Unit cur, nxt; int ui = 0;
    if (!S.next(0, cur)) return;
    f32x4 acc[2][2][4][2];
#pragma unroll
    for (int a = 0; a < 2; ++a)
#pragma unroll
        for (int b = 0; b < 2; ++b)
#pragma unroll
            for (int m = 0; m < 4; ++m)
#pragma unroll
                for (int n = 0; n < 2; ++n) acc[a][b][m][n] = (f32x4){0.f, 0.f, 0.f, 0.f};
    bf16x8 At[4][2], B0[2][2], B1[2][2];
    const char* cA = (const char*)g.A + (size_t)cur.pm * tstep; const char* cB = (const char*)g.Bt + (size_t)cur.pn * tstep;
    S.a_ready(cur);
    PG8_STAGE(PG8_SB(0, 0), cB, voffB); PG8_STAGE(PG8_SB(0, 1), cB + hstep, voffB); PG8_STAGE(PG8_SA(0, 0), cA, voffA); PG8_STAGE(PG8_SA(0, 1), cA + hstep, voffA);
    if (wr == 1) PG8_BAR;
    PG8_WAIT_V(2); PG8_BAR;
    PG8_STAGE(PG8_SB(1, 0), cB + kstep, voffB); PG8_STAGE(PG8_SA(1, 0), cA + kstep, voffA); PG8_STAGE(PG8_SB(1, 1), cB + hstep + kstep, voffB);
    PG8_WAIT_V(6); PG8_BAR;
    for (;;) {
        const bool has_next = S.next(ui + 1, nxt);
        const char* nA = has_next ? (const char*)g.A + (size_t)nxt.pm * tstep : cA; const char* nB = has_next ? (const char*)g.Bt + (size_t)nxt.pn * tstep : cB;
        for (int t = 0; t < nt; t += 2) {
            const bool last = (t == nt - 2);
            const char* a1 = cA + (size_t)(t + 1) * kstep;
            const char* a2 = last ? nA : cA + (size_t)(t + 2) * kstep; const char* b2 = last ? nB : cB + (size_t)(t + 2) * kstep;
            const char* a3 = a2 + kstep; const char* b3 = b2 + kstep;
            if (last && has_next) S.a_ready(nxt);
            PG8_LDB(B0, 0, 0); PG8_LDB(B1, 0, 1); PG8_SCHED; PG8_LDA(At, 0, 0); PG8_STAGE(PG8_SA(1, 1), a1 + hstep, voffA);
            PG8_WAIT_V(8); PG8_WAIT_L(0); PG8_BAR; PG8_MMA(0, 0, At, B0); PG8_MMA(0, 1, At, B1); PG8_BAR; PG8_SCHED;
            PG8_LDA(At, 0, 1); PG8_STAGE(PG8_SB(0, 0), b2, voffB); PG8_STAGE(PG8_SB(0, 1), b2 + hstep, voffB); PG8_STAGE(PG8_SA(0, 0), a2, voffA);
            PG8_WAIT_V(8); PG8_WAIT_L(0); PG8_BAR; PG8_MMA(1, 0, At, B0); PG8_MMA(1, 1, At, B1); PG8_BAR; PG8_SCHED;
            PG8_LDB(B0, 1, 0); PG8_LDB(B1, 1, 1); PG8_SCHED; PG8_LDA(At, 1, 0); PG8_STAGE(PG8_SA(0, 1), a2 + hstep, voffA);
            PG8_WAIT_V(8); PG8_WAIT_L(0); PG8_BAR; PG8_MMA(0, 0, At, B0); PG8_MMA(0, 1, At, B1); PG8_BAR; PG8_SCHED;
            PG8_LDA(At, 1, 1); PG8_STAGE(PG8_SB(1, 0), b3, voffB); PG8_STAGE(PG8_SB(1, 1), b3 + hstep, voffB); PG8_STAGE(PG8_SA(1, 0), a3, voffA);
            PG8_WAIT_V(8); PG8_WAIT_L(0); PG8_BAR; PG8_MMA(1, 0, At, B0); PG8_MMA(1, 1, At, B1); PG8_BAR; PG8_SCHED;
        }
        if constexpr (ALIGN_EPI) { if (wr == 0) PG8_BAR; }
        E(acc, cur, wr, wc, fr, fq); S.done(cur);
        if (!has_next) break;
#pragma unroll
        for (int a = 0; a < 2; ++a)
#pragma unroll
            for (int b = 0; b < 2; ++b)
#pragma unroll
                for (int m = 0; m < 4; ++m)
#pragma unroll
                    for (int n = 0; n < 2; ++n) acc[a][b][m][n] = (f32x4){0.f, 0.f, 0.f, 0.f};
        cur = nxt; cA = nA; cB = nB; ++ui;
        if constexpr (ALIGN_EPI) { if (wr == 1) PG8_BAR; }
    }
    PG8_WAIT_V(0);
    if constexpr (!ALIGN_EPI) { if (wr == 0) PG8_BAR; }
    PG8_BAR;
#undef PG8_SA
#undef PG8_SB
#undef PG8_STAGE
#undef PG8_LDA
#undef PG8_LDB
#undef PG8_MMA
#undef PG8_WAIT_V
#undef PG8_WAIT_L
#undef PG8_BAR
#undef PG8_SCHED
}
}

namespace att {
constexpr int D = 128, NW = 8, QBLK = 32, KVBLK = 64;
constexpr float SCALE = 0.088388347648318440f;
constexpr float THR = 8.f;
constexpr int SHM_V = KVBLK * D * 2, SHM_K = KVBLK * D * 2, SHM_ATTN = 2 * SHM_V + 2 * SHM_K + NW * 64 * 4;
constexpr int BIAS_OFF = SHM_ATTN, BIAS_FLOATS = 704;
constexpr int OST_OFF = 73728, OST_WAVE = 32 * 272;
#define KSWZ(row, colB) ((row) * 256 + ((colB) ^ (((row) & 7) << 4)))
#define SBAR() __builtin_amdgcn_sched_barrier(0)
__device__ __forceinline__ int crow(int r, int hi) { return (r & 3) + 8 * (r >> 2) + 4 * hi; }
__device__ __forceinline__ unsigned cvtpk(float lo, float hi) { unsigned r; asm volatile("v_cvt_pk_bf16_f32 %0, %1, %2" : "=v"(r) : "v"(lo), "v"(hi)); return r; }
__device__ __forceinline__ bf16x8 ld8(const bf16_t* p) { return *reinterpret_cast<const bf16x8*>(p); }

__device__ __forceinline__ void partialSM(f32x16& p0, f32x16& p1, float& m_reg, float& mn, float& alpha) {
  constexpr float C = SCALE * 1.4426950408889634f;
  float pmax = p0[0];
#pragma unroll
  for (int r = 1; r < 16; ++r) pmax = fmaxf(pmax, p0[r]);
#pragma unroll
  for (int r = 0; r < 16; ++r) pmax = fmaxf(pmax, p1[r]);
  { auto rr = __builtin_amdgcn_permlane32_swap(__float_as_uint(pmax), __float_as_uint(pmax), false, false);
    pmax = fmaxf(__uint_as_float(rr[0]), __uint_as_float(rr[1])); }
  if (__builtin_expect(__all(pmax - m_reg <= THR / SCALE), 1)) { mn = m_reg; alpha = 1.f; }
  else { mn = fmaxf(m_reg, pmax); alpha = __builtin_amdgcn_exp2f((m_reg - mn) * C); m_reg = mn; }
  float mnC = -mn * C;
#pragma unroll
  for (int r = 0; r < 16; ++r) p0[r] = fmaf(p0[r], C, mnC);
#pragma unroll
  for (int r = 0; r < 16; ++r) p1[r] = fmaf(p1[r], C, mnC);
#pragma unroll
  for (int r = 0; r < 16; ++r) p0[r] = __builtin_amdgcn_exp2f(p0[r]);
}
__device__ __forceinline__ void finishSM(f32x16& p0, f32x16& p1, float alpha, float& l_reg, bf16x8& pa0, bf16x8& pa1, bf16x8& pa2, bf16x8& pa3) {
#pragma unroll
  for (int r = 0; r < 16; ++r) p1[r] = __builtin_amdgcn_exp2f(p1[r]);
  float ps = 0;
#pragma unroll
  for (int r = 0; r < 16; ++r) ps += p0[r];
#pragma unroll
  for (int r = 0; r < 16; ++r) ps += p1[r];
  { auto rr = __builtin_amdgcn_permlane32_swap(__float_as_uint(ps), __float_as_uint(ps), false, false);
    ps = __uint_as_float(rr[0]) + __uint_as_float(rr[1]); }
  l_reg = l_reg * alpha + ps;
#define PK4(P, BASE, OUT) do { unsigned a0 = cvtpk(P[BASE + 0], P[BASE + 1]), a1 = cvtpk(P[BASE + 2], P[BASE + 3]);   \
    unsigned b0 = cvtpk(P[BASE + 4], P[BASE + 5]), b1 = cvtpk(P[BASE + 6], P[BASE + 7]);                              \
    auto r0 = __builtin_amdgcn_permlane32_swap(a0, b0, false, false); auto r1 = __builtin_amdgcn_permlane32_swap(a1, b1, false, false); \
    u32x4 w = {r0[0], r1[0], r0[1], r1[1]}; OUT = *reinterpret_cast<bf16x8*>(&w); } while (0)
  PK4(p0, 0, pa0); PK4(p0, 8, pa1); PK4(p1, 0, pa2); PK4(p1, 8, pa3);
#undef PK4
}
__device__ __forceinline__ void qkt(f32x16& p0, f32x16& p1, const char* Ks, const bf16x8* qr, int r32, int hi) {
  p0 = f32x16{}; p1 = f32x16{};
#pragma unroll
  for (int d0 = 0; d0 < 8; ++d0) { int cb = (d0 * 16 + hi * 8) * 2;
    bf16x8 b0 = *reinterpret_cast<const bf16x8*>(Ks + KSWZ(r32, cb));
    bf16x8 b1 = *reinterpret_cast<const bf16x8*>(Ks + KSWZ(32 + r32, cb));
    p0 = __builtin_amdgcn_mfma_f32_32x32x16_bf16(b0, qr[d0], p0, 0, 0, 0);
    p1 = __builtin_amdgcn_mfma_f32_32x32x16_bf16(b1, qr[d0], p1, 0, 0, 0); }
}
__device__ __forceinline__ int v_st(int k, int c) { const int kk = (k & ~0xC) | ((k & 4) << 1) | ((k & 8) >> 1); return ((kk >> 3) * 4 + (c >> 5)) * 512 + ((kk & 7) * 32 + (c & 31)) * 2; }
__device__ __forceinline__ int v_rd_base(int lane) { return ((lane & 3) << 3) | (((lane >> 2) & 3) << 6) | (((lane >> 4) & 1) << 5) | (((lane >> 5) & 1) << 8); }
constexpr int v_rd_off(int d0, int ks, int half) { return d0 * 512 + ks * 4096 + half * 2048; }
template <int OFF> __device__ __forceinline__ s16x4 tr_read(int vb) {
  s16x4 r; asm volatile("ds_read_b64_tr_b16 %0, %1 offset:%2" : "=&v"(r) : "v"(vb), "i"(OFF) : "memory"); return r;
}
template <int D0> __device__ __forceinline__ void pv_one(f32x16& od, int vb, bf16x8 pa0, bf16x8 pa1, bf16x8 pa2, bf16x8 pa3) {
  const s16x4 l0 = tr_read<v_rd_off(D0, 0, 0)>(vb), h0 = tr_read<v_rd_off(D0, 0, 1)>(vb), l1 = tr_read<v_rd_off(D0, 1, 0)>(vb), h1 = tr_read<v_rd_off(D0, 1, 1)>(vb);
  const s16x4 l2 = tr_read<v_rd_off(D0, 2, 0)>(vb), h2 = tr_read<v_rd_off(D0, 2, 1)>(vb), l3 = tr_read<v_rd_off(D0, 3, 0)>(vb), h3 = tr_read<v_rd_off(D0, 3, 1)>(vb);
  asm volatile("s_waitcnt lgkmcnt(0)" ::: "memory"); SBAR();
#define PK(L, H) (bf16x8){L[0], L[1], L[2], L[3], H[0], H[1], H[2], H[3]}
  od = __builtin_amdgcn_mfma_f32_32x32x16_bf16(pa0, PK(l0, h0), od, 0, 0, 0);
  od = __builtin_amdgcn_mfma_f32_32x32x16_bf16(pa1, PK(l1, h1), od, 0, 0, 0);
  od = __builtin_amdgcn_mfma_f32_32x32x16_bf16(pa2, PK(l2, h2), od, 0, 0, 0);
  od = __builtin_amdgcn_mfma_f32_32x32x16_bf16(pa3, PK(l3, h3), od, 0, 0, 0);
#undef PK
}
__device__ __forceinline__ void pv_d0(f32x16* o, int vb, bf16x8 pa0, bf16x8 pa1, bf16x8 pa2, bf16x8 pa3) {
  pv_one<0>(o[0], vb, pa0, pa1, pa2, pa3); pv_one<1>(o[1], vb, pa0, pa1, pa2, pa3); pv_one<2>(o[2], vb, pa0, pa1, pa2, pa3); pv_one<3>(o[3], vb, pa0, pa1, pa2, pa3);
}

template <bool NB, int QN = 0>
__device__ __forceinline__ void attn_body(const bf16_t* __restrict__ Qb, const bf16_t* __restrict__ K0, const bf16_t* __restrict__ V0, int nt0,
                                          const bf16_t* __restrict__ K1, const bf16_t* __restrict__ V1, int NT,
                                          bf16_t* __restrict__ Ob, char* lds, int nb_r0, int nb_krlo, int wave_s,
                                          const float* __restrict__ gq = nullptr, int tpos0 = 0) {
  const int tid = tid_of(wave_s);
  const int wid = wave_s, lane = tid & 63, r32 = lane & 31, hi = lane >> 5;
  char* V_lds = lds; char* K_lds = lds + 2 * SHM_V;
  float* ws = (float*)(lds + 2 * SHM_V + 2 * SHM_K) + wid * 64; float* li_l = ws; float* al_l = ws + 32;
  float m_reg = -1e30f, l_reg = 0; f32x16 o[4] = {}; bf16x8 qr[8];
  const bf16_t* Qw = Qb + (size_t)(wid * QBLK + r32) * D + hi * 8;
#pragma unroll
  for (int d0 = 0; d0 < 8; ++d0) qr[d0] = ld8(Qw + d0 * 16);
  if constexpr (QN != 0) {
    float qf[8][8]; float ss = 0.f;
#pragma unroll
    for (int d0 = 0; d0 < 8; ++d0) { const u32x4 w = __builtin_bit_cast(u32x4, qr[d0]);
      qf[d0][0] = bf_lo(w.x); qf[d0][1] = bf_hi(w.x); qf[d0][2] = bf_lo(w.y); qf[d0][3] = bf_hi(w.y); qf[d0][4] = bf_lo(w.z); qf[d0][5] = bf_hi(w.z); qf[d0][6] = bf_lo(w.w); qf[d0][7] = bf_hi(w.w);
#pragma unroll
      for (int e = 0; e < 8; ++e) ss += qf[d0][e] * qf[d0][e]; }
    ss += __shfl_xor(ss, 32);
    const float rstd = rsqrtf(ss * (1.f / 128.f) + EPS);
#pragma unroll
    for (int d0 = 0; d0 < 8; ++d0) { const f32x4 g0 = *(const f32x4*)(gq + d0 * 16 + hi * 8), g1 = *(const f32x4*)(gq + d0 * 16 + hi * 8 + 4);
#pragma unroll
      for (int e = 0; e < 4; ++e) { qf[d0][e] *= rstd * g0[e]; qf[d0][4 + e] *= rstd * g1[e]; } }
    if constexpr (QN == 2) {
      const int tq = tpos0 + wid * QBLK + r32;
#pragma unroll
      for (int dh = 0; dh < 2; ++dh)
#pragma unroll
        for (int e = 0; e < 8; ++e) {
          const float fr_ = __builtin_amdgcn_exp2f(-(float)(dh * 16 + hi * 8 + e) * (13.287712379549449f / 32.f)) * 0.15915494309189535f;
#pragma unroll
          for (int H = 0; H < 2; ++H) {
            float rev = (float)(H ? (tq & 63) : (tq >> 6)) * fr_; rev -= floorf(rev);
            const float sn = __builtin_amdgcn_sinf(rev), cn = __builtin_amdgcn_cosf(rev);
            const float x1 = qf[4 * H + dh][e], x2 = qf[4 * H + dh + 2][e];
            qf[4 * H + dh][e] = x1 * cn - x2 * sn; qf[4 * H + dh + 2][e] = x2 * cn + x1 * sn; } }
    }
#pragma unroll
    for (int d0 = 0; d0 < 8; ++d0) { u32x4 w; w.x = cvtpk(qf[d0][0], qf[d0][1]); w.y = cvtpk(qf[d0][2], qf[d0][3]); w.z = cvtpk(qf[d0][4], qf[d0][5]); w.w = cvtpk(qf[d0][6], qf[d0][7]);
      qr[d0] = __builtin_bit_cast(bf16x8, w); }
  }
  const int sr = tid >> 4, sc = (tid & 15) * 8, vst0 = v_st(sr, sc), vst1 = v_st(32 + sr, sc);
  const int vb0 = (int)(uintptr_t)V_lds + v_rd_base(lane);
  const int nq_r = nb_r0 + (wid >> 1), nq_c = 32 * (wid & 1) + r32;
  const int nrs = min(max(nq_r - 4, 0), 8), ncs = min(max(nq_c - 8, 0), 48);
  const float* btab = (const float*)(lds + BIAS_OFF) + 64 + 15 - nq_c + 4 * hi;
  struct { bf16x8 vs0, vs1, ks0, ks1; } sr_[2];
#define KPTR(j) ((j) < nt0 ? K0 + (size_t)(j) * (KVBLK * D) : K1 + (size_t)((j) - nt0) * (KVBLK * D))
#define VPTR(j) ((j) < nt0 ? V0 + (size_t)(j) * (KVBLK * D) : V1 + (size_t)((j) - nt0) * (KVBLK * D))
#define SLOAD(i, j) do { const bf16_t* kp_ = KPTR(j); const bf16_t* vp_ = VPTR(j); \
    sr_[i].vs0 = ld8(vp_ + sr * D + sc); sr_[i].vs1 = ld8(vp_ + (32 + sr) * D + sc); \
    sr_[i].ks0 = ld8(kp_ + sr * D + sc); sr_[i].ks1 = ld8(kp_ + (32 + sr) * D + sc); } while (0)
#define SWRITE(b, i) do { *(bf16x8*)(V_lds + (b) * SHM_V + vst0) = sr_[i].vs0;          \
    *(bf16x8*)(V_lds + (b) * SHM_V + vst1) = sr_[i].vs1; int kc = sc * 2;               \
    *(bf16x8*)(K_lds + (b) * SHM_K + KSWZ(sr, kc)) = sr_[i].ks0;                       \
    *(bf16x8*)(K_lds + (b) * SHM_K + KSWZ(32 + sr, kc)) = sr_[i].ks1; } while (0)
#define SWAIT() asm volatile("s_waitcnt vmcnt(4)" ::: "memory")
#define RESC(a) do { if (__any((a) < 1.f)) { if (hi == 0) al_l[r32] = (a); asm volatile("s_waitcnt lgkmcnt(0)" ::: "memory"); \
    _Pragma("unroll") for (int d = 0; d < 4; ++d) _Pragma("unroll") for (int r = 0; r < 16; ++r) o[d][r] *= al_l[crow(r, hi)]; } } while (0)
#define NBMASK(P0, P1, j) do { if (NB && (j) >= 4) { const int kr_ = nb_krlo + (j) - 4; \
    if ((unsigned)(kr_ - nrs) >= 8u) { _Pragma("unroll") for (int r = 0; r < 16; ++r) { P0[r] = -1e30f; P1[r] = -1e30f; } } \
    else { const float* tb_ = btab + (kr_ - nq_r + 7) * 31; const int kb_ = 4 * hi - ncs; \
      _Pragma("unroll") for (int r = 0; r < 16; ++r) { const int c0_ = (r & 3) + 8 * (r >> 2); \
        P0[r] = ((unsigned)(kb_ + c0_) < 16u) ? P0[r] + tb_[c0_] : -1e30f; \
        P1[r] = ((unsigned)(kb_ + c0_ + 32) < 16u) ? P1[r] + tb_[c0_ + 32] : -1e30f; } } } } while (0)
  f32x16 pA0, pA1, pB0, pB1; float mnA, mnB, alA, alB; bf16x8 pa0, pa1, pa2, pa3;
  constexpr int SE = 0, SO = 1;
  SLOAD(SE, 0); asm volatile("s_waitcnt vmcnt(0)" ::: "memory"); SWRITE(0, SE); __syncthreads();
  qkt(pA0, pA1, K_lds, qr, r32, hi); partialSM(pA0, pA1, m_reg, mnA, alA);
  SLOAD(SO, 1); if (2 < NT) SLOAD(SE, 2);
  SWAIT(); SWRITE(1, SO); __syncthreads();
  for (int j = 1; j + 1 < NT; j += 2) {
    SBAR(); qkt(pB0, pB1, K_lds + SHM_K, qr, r32, hi);
    finishSM(pA0, pA1, alA, l_reg, pa0, pa1, pa2, pa3); SBAR();
    SLOAD(SO, j + 2); SBAR();
    pv_d0(o, vb0, pa0, pa1, pa2, pa3); NBMASK(pB0, pB1, j); partialSM(pB0, pB1, m_reg, mnB, alB);
    __syncthreads(); SWAIT(); SWRITE(0, SE);
    RESC(alB); __syncthreads();
    SBAR(); qkt(pA0, pA1, K_lds, qr, r32, hi);
    finishSM(pB0, pB1, alB, l_reg, pa0, pa1, pa2, pa3); SBAR();
    if (j + 3 < NT) SLOAD(SE, j + 3); SBAR();
    pv_d0(o, vb0 + SHM_V, pa0, pa1, pa2, pa3); NBMASK(pA0, pA1, j + 1); partialSM(pA0, pA1, m_reg, mnA, alA);
    __syncthreads(); SWAIT(); SWRITE(1, SO);
    RESC(alA); __syncthreads();
  }
  SBAR(); qkt(pB0, pB1, K_lds + SHM_K, qr, r32, hi);
  finishSM(pA0, pA1, alA, l_reg, pa0, pa1, pa2, pa3); SBAR();
  pv_d0(o, vb0, pa0, pa1, pa2, pa3); NBMASK(pB0, pB1, NT - 1); partialSM(pB0, pB1, m_reg, mnB, alB);
  __syncthreads(); RESC(alB);
  finishSM(pB0, pB1, alB, l_reg, pa0, pa1, pa2, pa3); SBAR();
  pv_d0(o, vb0 + SHM_V, pa0, pa1, pa2, pa3);
  if (hi == 0) li_l[r32] = l_reg; asm volatile("s_waitcnt lgkmcnt(0)" ::: "memory");
  float rli[16];
#pragma unroll
  for (int r = 0; r < 16; ++r) rli[r] = __builtin_amdgcn_rcpf(li_l[crow(r, hi)]);
  char* ost = lds + OST_OFF + wid * OST_WAVE;
#pragma unroll
  for (int r = 0; r < 16; ++r) { const int orow = crow(r, hi);
#pragma unroll
    for (int d0 = 0; d0 < 4; ++d0) { const float v = o[d0][r] * rli[r]; *(bf16_t*)(ost + orow * 272 + (d0 * 32 + r32) * 2) = (bf16_t)(cvtpk(v, v) & 0xffffu); } }
  asm volatile("s_waitcnt lgkmcnt(0)" ::: "memory");
  bf16_t* Ow = Ob + (size_t)(wid * QBLK) * DM;
#pragma unroll
  for (int i = 0; i < 8; ++i) { const int row = (lane >> 4) + 4 * i, ch = lane & 15;
    const u32x4 w = *(const u32x4*)(ost + row * 272 + ch * 16);
    *(u32x4*)(Ow + (size_t)row * DM + ch * 8) = w; }
#undef KPTR
#undef VPTR
#undef SLOAD
#undef SWRITE
#undef SWAIT
#undef RESC
#undef NBMASK
}
}

__device__ __forceinline__ unsigned f2bf(float f) { unsigned u = __builtin_bit_cast(unsigned, f); return (u + 0x7fffu + ((u >> 16) & 1u)) >> 16; }
__device__ __forceinline__ unsigned pk2(float lo, float hi) { return f2bf(lo) | (f2bf(hi) << 16); }
#define LDS_WAIT() asm volatile("s_waitcnt lgkmcnt(0)" ::: "memory")
template <bool UPMAP> __device__ __forceinline__ void transpose_item(const float* __restrict__ W, int K, int N, bf16_t* __restrict__ WT, LAS float* scr, int item, int lane) {
    const int nblk = N / 32, kb = item / nblk, nb = item % nblk, k0 = 64 * kb, n0 = 32 * nb;
    const int d0 = UPMAP ? (n0 < DFF ? (n0 >> 7) * 256 + (n0 & 127) : ((n0 - DFF) >> 7) * 256 + 128 + ((n0 - DFF) & 127)) : n0;
    {
        const int r8 = lane >> 3, c4 = lane & 7;
        f32x4 v[8];
#pragma unroll
        for (int g = 0; g < 8; ++g) v[g] = *(const f32x4*)(W + (size_t)(k0 + 8 * g + r8) * N + n0 + 4 * c4);
#pragma unroll
        for (int g = 0; g < 8; ++g) { LAS float* d = scr + (8 * g + r8) * 33 + 4 * c4; d[0] = v[g][0]; d[1] = v[g][1]; d[2] = v[g][2]; d[3] = v[g][3]; }
    }
    LDS_WAIT(); asm volatile("" ::: "memory");
    const int c = lane & 7;
#pragma unroll
    for (int j = 0; j < 4; ++j) { const int n = (lane >> 3) + 8 * j; const LAS float* s = scr + (8 * c) * 33 + n;
        u32x4 o; o.x = pk2(s[0 * 33], s[1 * 33]); o.y = pk2(s[2 * 33], s[3 * 33]); o.z = pk2(s[4 * 33], s[5 * 33]); o.w = pk2(s[6 * 33], s[7 * 33]);
        *(u32x4*)(WT + (size_t)(d0 + n) * K + k0 + 8 * c) = o; }
    LDS_WAIT(); asm volatile("" ::: "memory");
}

struct Args { const float* in[23]; float* out; unsigned char* ws; int ph_lo, ph_hi; };

__global__ void __launch_bounds__(512, 2) mk_fwd(Args args) {
    extern __shared__ __attribute__((aligned(16))) unsigned char lds[];
    cg::grid_group grid = cg::this_grid();
    const int G = gridDim.x, bx = blockIdx.x, NGW = G * 8;
    const int wave_s = __builtin_amdgcn_readfirstlane((int)threadIdx.x >> 6);
#define PHASE_IDS const int tid = tid_of(wave_s); const int lane = tid & 63, wave = wave_s; \
    const int gw = bx * 8 + wave, gwi = wave * G + bx; (void)lane; (void)gw; (void)gwi; (void)tid;
#define ws (args.ws)
#define x_prompt (args.in[0])
#define x_sample (args.in[1])
#define cvec (args.in[2])
#define cache_a_k (args.in[3])
#define cache_a_v (args.in[4])
#define cache_b_k (args.in[5])
#define cache_b_v (args.in[6])
#define c_ctx (args.in[7])
#define w_mod (args.in[8])
#define b_mod (args.in[9])
#define g_attn_pre (args.in[10])
#define g_attn_post (args.in[11])
#define g_ffn_pre (args.in[12])
#define g_ffn_post (args.in[13])
#define w_in (args.in[14])
#define rpb (args.in[15])
#define g_qnorm (args.in[16])
#define g_knorm (args.in[17])
#define w_out (args.in[18])
#define w_up (args.in[19])
#define conv_w (args.in[20])
#define conv_b (args.in[21])
#define w_down (args.in[22])
#define Y_ (args.out)
#define st_ak (args.out + (size_t)MTOK * DM)
#define st_av (args.out + (size_t)MTOK * DM + (size_t)32 * 8 * 256 * 128)
#define st_bk (args.out + (size_t)MTOK * DM + (size_t)2 * 32 * 8 * 256 * 128)
#define st_bv (args.out + (size_t)MTOK * DM + (size_t)2 * 32 * 8 * 256 * 128 + (size_t)32 * 2 * 256 * 128)
#define MOD ((float*)(ws + WS_MOD))
#define MODP ((float*)(ws + WS_MODP))
#define WIN ((bf16_t*)(ws + WS_WIN))
#define WOUT ((bf16_t*)(ws + WS_WOUT))
#define WUP ((bf16_t*)(ws + WS_WUP))
#define WDN ((bf16_t*)(ws + WS_WDN))
#define XN ((bf16_t*)(ws + WS_XN))
#define CAK ((bf16_t*)(ws + WS_CAK))
#define CAV ((bf16_t*)(ws + WS_CAV))
#define CBK ((bf16_t*)(ws + WS_CBK))
#define CBV ((bf16_t*)(ws + WS_CBV))
#define QA ((bf16_t*)(ws + WS_QA))
#define KA ((bf16_t*)(ws + WS_KA))
#define VA ((bf16_t*)(ws + WS_VA))
#define QB ((bf16_t*)(ws + WS_QB))
#define KB ((bf16_t*)(ws + WS_KB))
#define VB ((bf16_t*)(ws + WS_VB))
#define OB ((bf16_t*)(ws + WS_O))
#define P1 ((bf16_t*)(ws + WS_P1))
#define P2 ((bf16_t*)(ws + WS_P2))
#define ACT ((bf16_t*)(ws + WS_ACT))
#define HBUF ((float*)(ws + WS_U))
#define X1B ((bf16_t*)(ws + WS_X1))
    LAS unsigned char* ldsl = (LAS unsigned char*)lds;

    const int lo = args.ph_lo, hi = args.ph_hi;
#ifndef PH_MASK
#define PH_MASK 0xFFF
#endif
#define IN(k) (((PH_MASK >> (k)) & 1) && lo <= (k) && (k) < hi)
    { const int t0 = tid_of(wave_s); if (t0 < 16) ((volatile LAS unsigned*)(ldsl + MISC_OFF))[t0] = 0u; }
    __syncthreads();
    const XcdBarrier xbar = xcd_barrier_post((unsigned*)(ws + WS_CTL), (volatile LAS unsigned*)(ldsl + MISC_OFF), wave_s);
#define SEAM(k) do { if (IN(k) && IN((k) + 1)) { if ((k) == 0) grid.sync(); else xcd_barrier(xbar, wave_s); } } while (0)

    if (IN(0)) {
        PHASE_IDS
        LAS float* cs = (LAS float*)ldsl;
        for (int idx = tid; idx < 9 * 2048; idx += 512) { const int j = idx >> 11, k = idx & 2047; const float c = (j == 0) ? c_ctx[k] : cvec[(j - 1) * 2048 + k];
            cs[k * 9 + j] = c / (1.f + __expf(-c)); }
        __syncthreads();
        for (int ch = bx; ch < 256; ch += G) {
            const int vc = (ch & 7) * 32 + (ch >> 3), rsub = lane / 12, c4 = lane - 12 * rsub;
            f32x4 acc[9];
#pragma unroll
            for (int j = 0; j < 9; ++j) acc[j] = (f32x4){0.f, 0.f, 0.f, 0.f};
            if (rsub < 5) {
                const float* wp = w_mod + (size_t)(wave * 256 + rsub) * NMOD + vc * 48 + 4 * c4;
                const LAS float* sp = cs + (wave * 256 + rsub) * 9;
#pragma unroll 8
                for (int it = 0; it < 51; ++it) {
                    const f32x4 w = *(const f32x4*)(wp + (size_t)(5 * it) * NMOD);
                    const LAS float* s2 = sp + 45 * it;
#pragma unroll
                    for (int j = 0; j < 9; ++j) acc[j] += w * s2[j];
                }
                if (rsub == 0) {
                    const f32x4 w = *(const f32x4*)(wp + (size_t)255 * NMOD);
                    const LAS float* s2 = sp + 9 * 255;
#pragma unroll
                    for (int j = 0; j < 9; ++j) acc[j] += w * s2[j];
                }
            }
            __syncthreads();
            LAS float* red = (LAS float*)ldsl;
#pragma unroll
            for (int j = 0; j < 9; ++j) *(LAS f32x4*)(red + tid * 36 + 4 * j) = acc[j];
            __syncthreads();
            if (tid < 432) { const int j = tid / 48, col = tid - 48 * j, cc = col >> 2, e = col & 3;
                float sum = b_mod[vc * 48 + col];
#pragma unroll
                for (int w = 0; w < 8; ++w)
#pragma unroll
                    for (int r5 = 0; r5 < 5; ++r5) sum += red[(w * 64 + r5 * 12 + cc) * 36 + 4 * j + e];
                MOD[(size_t)j * NMOD + vc * 48 + col] = sum; }
            __syncthreads();
            if (ch + G < 256) {
                for (int idx = tid; idx < 9 * 2048; idx += 512) { const int j = idx >> 11, k = idx & 2047; const float c = (j == 0) ? c_ctx[k] : cvec[(j - 1) * 2048 + k];
                    cs[k * 9 + j] = c / (1.f + __expf(-c)); }
                __syncthreads();
            }
        }
        LAS float* scr = (LAS float*)(ldsl + wave * 8448);
        constexpr int I_IN = 32 * 144, I_OUT = 32 * 64;
        for (int it = gwi; it < I_IN + I_OUT; it += NGW) {
            if (it < I_IN) transpose_item<false>(w_in, DM, NIN, WIN, scr, it, lane);
            else transpose_item<false>(w_out, DM, DM, WOUT, scr, it - I_IN, lane);
        }
        {
            constexpr int NA8 = 8 * 8 * 256 * 128 / 8, NB8 = 8 * 2 * 256 * 128 / 8;
            for (int i = bx * 512 + tid; i < 2 * NA8 + 2 * NB8; i += G * 512) {
                const float* src; bf16_t* dst; int j = i;
                if (j < NA8) { src = cache_a_k; dst = CAK; } else if ((j -= NA8) < NA8) { src = cache_a_v; dst = CAV; }
                else if ((j -= NA8) < NB8) { src = cache_b_k; dst = CBK; } else { j -= NB8; src = cache_b_v; dst = CBV; }
                const f32x4 a = *(const f32x4*)(src + (size_t)j * 8), b = *(const f32x4*)(src + (size_t)j * 8 + 4);
                u32x4 w; w.x = cvt_pk_bf16(a[0], a[1]); w.y = cvt_pk_bf16(a[2], a[3]); w.z = cvt_pk_bf16(b[0], b[1]); w.w = cvt_pk_bf16(b[2], b[3]);
                *(u32x4*)(dst + (size_t)j * 8) = w;
            }
        }
    }
    SEAM(0);
    if (IN(2)) {
        PHASE_IDS
        for (int m = 2 * gw; m < MTOK; m += 2 * NGW) {
            const float* xr = (m < NCTX) ? x_prompt + (size_t)m * DM : x_sample + (size_t)(m - NCTX) * DM;
            const float* md = MOD + (size_t)((m < NCTX) ? 0 : 1 + ((m - NCTX) >> 10)) * NMOD;
            f32x4 v[2][8]; float ss[2] = {0.f, 0.f};
#pragma unroll
            for (int r2 = 0; r2 < 2; ++r2)
#pragma unroll
                for (int i = 0; i < 8; ++i) v[r2][i] = *(const f32x4*)(xr + (size_t)r2 * DM + 4 * lane + 256 * i);
#pragma unroll
            for (int r2 = 0; r2 < 2; ++r2)
#pragma unroll
                for (int i = 0; i < 8; ++i) ss[r2] += (v[r2][i][0] * v[r2][i][0] + v[r2][i][1] * v[r2][i][1]) + (v[r2][i][2] * v[r2][i][2] + v[r2][i][3] * v[r2][i][3]);
            const float rstd0 = rsqrtf(wave_sum(ss[0]) * (1.f / DM) + EPS), rstd1 = rsqrtf(wave_sum(ss[1]) * (1.f / DM) + EPS);
            bf16_t* orow = XN + (size_t)m * DM;
#pragma unroll
            for (int i = 0; i < 8; ++i) { const int c = 4 * lane + 256 * i;
                const f32x4 g = *(const f32x4*)(g_attn_pre + c), sh = *(const f32x4*)(md + c), sc = *(const f32x4*)(md + 2048 + c);
                const f32x4 gs = g * (sc + 1.f);
                const f32x4 r0 = v[0][i] * rstd0 * gs + sh, r1 = v[1][i] * rstd1 * gs + sh;
                u32x2 w0, w1; w0.x = cvt_pk_bf16(r0[0], r0[1]); w0.y = cvt_pk_bf16(r0[2], r0[3]); w1.x = cvt_pk_bf16(r1[0], r1[1]); w1.y = cvt_pk_bf16(r1[2], r1[3]);
                *(u32x2*)(orow + c) = w0; *(u32x2*)(orow + DM + c) = w1; }
        }
    }
    SEAM(2);
    if (IN(3)) {
        pg8::Gemm g{XN, WIN, MTOK, NIN, DM}; pg8::StaticOrder S; S.init(MTOK, NIN, G, bx);
        pg8::EpiQKV E{QA, KA, VA, QB, KB, VB, st_ak, st_av, st_bv};
        const int hb = G >> 1;
        if (bx >= hb) {
            PHASE_IDS
            LAS float* scr = (LAS float*)(ldsl + wave * 8448);
            constexpr int I_UP = 32 * 352, I_DN = 88 * 64;
            for (int it = wave * (G - hb) + (bx - hb); it < I_UP + I_DN; it += 8 * (G - hb)) {
                if (it < I_UP) transpose_item<true>(w_up, DM, NUP, WUP, scr, it, lane);
                else transpose_item<false>(w_down, DFF, DM, WDN, scr, it - I_UP, lane);
            }
            __syncthreads();
        }
        pg8::gemm_phase<pg8::EpiQKV, pg8::StaticOrder, true>(ldsl, g, S, E, wave_s);
    }
    SEAM(3);
    if (IN(4)) {
        PHASE_IDS
        const int vs = lane >> 3, part = lane & 7, hsel = part >> 2;
        const int ib = 16 * (part & 1);
        const float sgn = (part & 2) ? 1.f : -1.f;
        constexpr int NIQ = MTOK * 8 / 8, NIK = MTOK * 2 / 8;
        for (int itv = NIQ + gw; itv < NIQ + NIK; itv += NGW) {
            const bool isq = itv < NIQ; const int H = isq ? 8 : 2;
            const int vv = (isq ? itv : itv - NIQ) * 8 + vs;
            bf16_t* p = (isq ? QB : KB) + (size_t)vv * 128 + 16 * part;
            const float* gp = (isq ? g_qnorm : g_knorm) + 16 * part;
            const u32x4 w0 = *(const u32x4*)p, w1 = *(const u32x4*)(p + 8);
            float e[16];
#pragma unroll
            for (int q = 0; q < 4; ++q) { e[2 * q] = bf_lo(w0[q]); e[2 * q + 1] = bf_hi(w0[q]); e[8 + 2 * q] = bf_lo(w1[q]); e[8 + 2 * q + 1] = bf_hi(w1[q]); }
            float ss = 0.f;
#pragma unroll
            for (int j = 0; j < 16; ++j) ss += e[j] * e[j];
            ss += __shfl_xor(ss, 1); ss += __shfl_xor(ss, 2); ss += __shfl_xor(ss, 4);
            const float rstd = rsqrtf(ss * (1.f / 128.f) + EPS);
#pragma unroll
            for (int q = 0; q < 4; ++q) { const f32x4 g = *(const f32x4*)(gp + 4 * q);
#pragma unroll
                for (int t = 0; t < 4; ++t) e[4 * q + t] *= rstd * g[t]; }
            const int nctxv = NCTX * H;
            if (vv >= nctxv) {
                const int t = (vv - nctxv) & 1023; const float pos = (float)(hsel ? (t & 63) : (t >> 6));
#pragma unroll
                for (int j = 0; j < 16; ++j) {
                    const float other = __shfl_xor(e[j], 2);
                    float rev = pos * (exp2f(-(float)(ib + j) * (13.287712379549449f / 32.f)) * 0.15915494309189535f); rev -= floorf(rev);
                    const float sn = __builtin_amdgcn_sinf(rev), cn = __builtin_amdgcn_cosf(rev);
                    e[j] = e[j] * cn + sgn * other * sn;
                }
            } else if (!isq) {
                float* sp = st_bk + (size_t)vv * 128 + 16 * part;
#pragma unroll
                for (int q = 0; q < 4; ++q) *(f32x4*)(sp + 4 * q) = (f32x4){e[4 * q], e[4 * q + 1], e[4 * q + 2], e[4 * q + 3]};
            }
            u32x4 o0, o1;
#pragma unroll
            for (int q = 0; q < 4; ++q) { o0[q] = cvt_pk_bf16(e[2 * q], e[2 * q + 1]); o1[q] = cvt_pk_bf16(e[8 + 2 * q], e[8 + 2 * q + 1]); }
            *(u32x4*)p = o0; *(u32x4*)(p + 8) = o1;
        }
    }
    SEAM(4);
    if (IN(5)) {
        char* al = (char*)lds;
#ifndef AT_MASK
#define AT_MASK 15
#endif
        if (AT_MASK & 1) for (int u0 = bx; u0 < 256; u0 += G) { const int u = (G == 256) ? ((u0 & 7) * 32 + (u0 >> 3)) : u0;
                const int b = u >> 3, h = u & 7; const size_t off = ((size_t)(b * 8 + h) * 256) * 128;
                att::attn_body<false>(QA + off, KA + off, VA + off, 4, KA + off, VA + off, 4, OB + (size_t)(b * 256) * DM + h * 128, al, 0, 0, wave_s);
                __syncthreads();
        }
        if (AT_MASK & 2) for (int u0 = bx; u0 < 256; u0 += G) { const int u = (G == 256) ? ((u0 & 7) * 32 + (u0 >> 3)) : u0;
                const int b = u >> 3, qh = u & 7, kvh = qh >> 2; const size_t qoff = ((size_t)(b * 8 + qh) * 256) * 128, koff = ((size_t)(b * 2 + kvh) * 256) * 128;
                att::attn_body<false, 1>(QB + qoff, KB + koff, VB + koff, 4, KB + koff, VB + koff, 4, OB + (size_t)(b * 256) * DM + 1024 + qh * 128, al, 0, 0, wave_s, g_qnorm, 0);
                __syncthreads();
        }
        if (AT_MASK & 4) for (int u0 = bx; u0 < 256; u0 += G) { const int u = (G == 256) ? ((u0 & 7) * 32 + (u0 >> 3)) : u0;
                const int b = u >> 5, qh = (u >> 2) & 7, qb = u & 3, kvh = qh >> 2;
                const size_t qoff = (size_t)NCTX * 8 * 128 + ((size_t)(b * 8 + qh) * 1024 + qb * 256) * 128;
                const size_t coff = ((size_t)(b * 2 + kvh) * 256) * 128, koff = (size_t)NCTX * 2 * 128 + ((size_t)(b * 2 + kvh) * 1024) * 128;
                att::attn_body<false, 2>(QB + qoff, CBK + coff, CBV + coff, 4, KB + koff, VB + koff, 20, OB + (size_t)(NCTX + b * 1024 + qb * 256) * DM + 1024 + qh * 128, al, 0, 0, wave_s, g_qnorm, qb * 256);
                __syncthreads();
        }
        if (AT_MASK & 8) for (int u0 = bx; u0 < 256; u0 += G) { const int u = (G == 256) ? ((u0 & 7) * 32 + (u0 >> 3)) : u0;
                const int b = u >> 5, h = (u >> 2) & 7, qb = u & 3;
                PHASE_IDS
                float* bt = (float*)(al + att::BIAS_OFF);
                for (int i = tid; i < att::BIAS_FLOATS; i += 512) { const int k = i - 64; bt[i] = (k >= 0 && k < 465) ? rpb[h * 465 + k] * (1.f / att::SCALE) : 0.f; }
                const int krlo = (qb == 0 || qb == 1) ? 0 : (qb == 2 ? 4 : 8), nrows = (qb == 0 || qb == 3) ? 8 : 12;
                const size_t qoff = (size_t)NCTX * 8 * 128 + ((size_t)(b * 8 + h) * 1024 + qb * 256) * 128;
                const size_t coff = ((size_t)(b * 8 + h) * 256) * 128, koff = (size_t)NCTX * 8 * 128 + ((size_t)(b * 8 + h) * 1024 + krlo * 64) * 128;
                att::attn_body<true>(QA + qoff, CAK + coff, CAV + coff, 4, KA + koff, VA + koff, 4 + nrows, OB + (size_t)(NCTX + b * 1024 + qb * 256) * DM + h * 128, al, qb * 4, krlo, wave_s);
                __syncthreads();
        }
    }
    SEAM(5);
    if (IN(6)) {
        pg8::Gemm g{OB, WOUT, MTOK, DM, DM}; pg8::StaticOrder S; S.init(MTOK, DM, G, bx);
        pg8::EpiBf16 E{P1, DM};
        pg8::gemm_phase<pg8::EpiBf16, pg8::StaticOrder, true>(ldsl, g, S, E, wave_s);
    }
    SEAM(6);
    if (IN(7)) {
        PHASE_IDS
        for (int m = 2 * gw; m < MTOK; m += 2 * NGW) {
            const float* xr = (m < NCTX) ? x_prompt + (size_t)m * DM : x_sample + (size_t)(m - NCTX) * DM;
            const float* md = MOD + (size_t)((m < NCTX) ? 0 : 1 + ((m - NCTX) >> 10)) * NMOD;
            const bf16_t* pr = P1 + (size_t)m * DM;
            float v[2][4][8]; float ss[2] = {0.f, 0.f};
            u32x4 pw[2][4];
#pragma unroll
            for (int r2 = 0; r2 < 2; ++r2)
#pragma unroll
                for (int i = 0; i < 4; ++i) pw[r2][i] = *(const u32x4*)(pr + (size_t)r2 * DM + 8 * lane + 512 * i);
#pragma unroll
            for (int r2 = 0; r2 < 2; ++r2)
#pragma unroll
                for (int i = 0; i < 4; ++i)
#pragma unroll
                    for (int q = 0; q < 4; ++q) { const float lo_ = bf_lo(pw[r2][i][q]), hi_ = bf_hi(pw[r2][i][q]); v[r2][i][2 * q] = lo_; v[r2][i][2 * q + 1] = hi_; ss[r2] += lo_ * lo_ + hi_ * hi_; }
            float rstd[2]; rstd[0] = rsqrtf(wave_sum(ss[0]) * (1.f / DM) + EPS); rstd[1] = rsqrtf(wave_sum(ss[1]) * (1.f / DM) + EPS);
            float ss2[2] = {0.f, 0.f};
#pragma unroll
            for (int i = 0; i < 4; ++i) { const int c = 8 * lane + 512 * i;
                float gg[8];
#pragma unroll
                for (int h2 = 0; h2 < 2; ++h2) {
                    const f32x4 g = *(const f32x4*)(g_attn_post + c + 4 * h2), ga = *(const f32x4*)(md + 4096 + c + 4 * h2);
#pragma unroll
                    for (int e = 0; e < 4; ++e) gg[4 * h2 + e] = g[e] * ga[e]; }
#pragma unroll
                for (int r2 = 0; r2 < 2; ++r2) {
                    const f32x4 xa = *(const f32x4*)(xr + (size_t)r2 * DM + c), xb = *(const f32x4*)(xr + (size_t)r2 * DM + c + 4);
                    float r[8];
#pragma unroll
                    for (int e = 0; e < 8; ++e) { r[e] = (e < 4 ? xa[e & 3] : xb[e & 3]) + gg[e] * (v[r2][i][e] * rstd[r2]); v[r2][i][e] = r[e]; ss2[r2] += r[e] * r[e]; }
                    u32x4 w; w.x = cvt_pk_bf16(r[0], r[1]); w.y = cvt_pk_bf16(r[2], r[3]); w.z = cvt_pk_bf16(r[4], r[5]); w.w = cvt_pk_bf16(r[6], r[7]);
                    *(u32x4*)(X1B + (size_t)(m + r2) * DM + c) = w; } }
            float rs2[2]; rs2[0] = rsqrtf(wave_sum(ss2[0]) * (1.f / DM) + EPS); rs2[1] = rsqrtf(wave_sum(ss2[1]) * (1.f / DM) + EPS);
            bf16_t* orow = XN + (size_t)m * DM;
#pragma unroll
            for (int i = 0; i < 4; ++i) { const int c = 8 * lane + 512 * i;
                float gsv[8], shv[8];
#pragma unroll
                for (int h2 = 0; h2 < 2; ++h2) {
                    const f32x4 g = *(const f32x4*)(g_ffn_pre + c + 4 * h2), sh = *(const f32x4*)(md + 6144 + c + 4 * h2), sc = *(const f32x4*)(md + 8192 + c + 4 * h2);
#pragma unroll
                    for (int e = 0; e < 4; ++e) { gsv[4 * h2 + e] = g[e] * (sc[e] + 1.f); shv[4 * h2 + e] = sh[e]; } }
#pragma unroll
                for (int r2 = 0; r2 < 2; ++r2) {
                    float r[8];
#pragma unroll
                    for (int e = 0; e < 8; ++e) r[e] = v[r2][i][e] * rs2[r2] * gsv[e] + shv[e];
                    u32x4 w; w.x = cvt_pk_bf16(r[0], r[1]); w.y = cvt_pk_bf16(r[2], r[3]); w.z = cvt_pk_bf16(r[4], r[5]); w.w = cvt_pk_bf16(r[6], r[7]);
                    *(u32x4*)(orow + (size_t)r2 * DM + c) = w; } }
        }
    }
    SEAM(7);
    if (IN(8)) {
        pg8::Gemm g{XN, WUP, MTOK, NUP, DM}; pg8::StaticOrder S; S.init(MTOK, NUP, G, bx);
        pg8::EpiConv E{ACT, HBUF, conv_w, conv_b, (LAS float*)(ldsl + 131072)};
        pg8::gemm_phase<pg8::EpiConv, pg8::StaticOrder, true>(ldsl, g, S, E, wave_s);
    }
    SEAM(8);
    if (IN(9)) {
        PHASE_IDS
        for (int it = gw; it < 32 * 2 * 22; it += NGW) {
            const int seg = it % 22, side = (it / 22) & 1, lt = it / 44; const int q = lt & 3;
            if ((side == 0 && q == 0) || (side == 1 && q == 3)) continue;
            const int ch = seg * 256 + lane * 4;
            f32x4 r[2];
#pragma unroll
            for (int bj = 0; bj < 2; ++bj) {
                const float* hp = HBUF + (size_t)bj * DFF + ch;
                const f32x4 up = *(const f32x4*)(hp + (size_t)((side ? lt * 4 + 2 : (lt - 1) * 4 + 3) * 2) * DFF);
                const f32x4 cu = *(const f32x4*)(hp + (size_t)((side ? lt * 4 + 3 : lt * 4 + 0) * 2) * DFF);
                const f32x4 dn = *(const f32x4*)(hp + (size_t)((side ? (lt + 1) * 4 + 0 : lt * 4 + 1) * 2) * DFF);
                const f32x4 w0 = *(const f32x4*)(conv_w + bj * DFF + ch), w1 = *(const f32x4*)(conv_w + NUP + bj * DFF + ch), w2 = *(const f32x4*)(conv_w + 2 * NUP + bj * DFF + ch);
                r[bj] = w0 * up + w1 * cu + w2 * dn + *(const f32x4*)(conv_b + bj * DFF + ch);
            }
            float a[4];
#pragma unroll
            for (int e = 0; e < 4; ++e) a[e] = r[1][e] * __builtin_amdgcn_rcpf(1.f + __expf(-r[1][e])) * r[0][e];
            u32x2 ow; ow.x = cvt_pk_bf16(a[0], a[1]); ow.y = cvt_pk_bf16(a[2], a[3]);
            *(u32x2*)(ACT + (size_t)(NCTX + lt * 256 + (side ? 255 : 0)) * DFF + ch) = ow;
        }
    }
    SEAM(9);
    if (IN(10)) {
        PHASE_IDS
        pg8::Gemm g{ACT, WDN, MTOK, DM, DFF}; pg8::StaticOrder S; S.init(MTOK, DM, G, bx);
        pg8::EpiBf16 E{P2, DM};
        pg8::gemm_phase<pg8::EpiBf16, pg8::StaticOrder, true>(ldsl, g, S, E, wave_s);
    }
    SEAM(10);
    if (IN(11)) {
        PHASE_IDS
        for (int m = 2 * gw; m < MTOK; m += 2 * NGW) {
            const float* md = MOD + (size_t)((m < NCTX) ? 0 : 1 + ((m - NCTX) >> 10)) * NMOD;
            const bf16_t* pr = P2 + (size_t)m * DM;
            float v[2][4][8]; float ss[2] = {0.f, 0.f};
            u32x4 pw[2][4];
#pragma unroll
            for (int r2 = 0; r2 < 2; ++r2)
#pragma unroll
                for (int i = 0; i < 4; ++i) pw[r2][i] = *(const u32x4*)(pr + (size_t)r2 * DM + 8 * lane + 512 * i);
#pragma unroll
            for (int r2 = 0; r2 < 2; ++r2)
#pragma unroll
                for (int i = 0; i < 4; ++i)
#pragma unroll
                    for (int q = 0; q < 4; ++q) { const float lo_ = bf_lo(pw[r2][i][q]), hi_ = bf_hi(pw[r2][i][q]); v[r2][i][2 * q] = lo_; v[r2][i][2 * q + 1] = hi_; ss[r2] += lo_ * lo_ + hi_ * hi_; }
            float rstd[2]; rstd[0] = rsqrtf(wave_sum(ss[0]) * (1.f / DM) + EPS); rstd[1] = rsqrtf(wave_sum(ss[1]) * (1.f / DM) + EPS);
#pragma unroll
            for (int i = 0; i < 4; ++i) { const int c = 8 * lane + 512 * i;
#pragma unroll
                for (int h2 = 0; h2 < 2; ++h2) {
                    const f32x4 g = *(const f32x4*)(g_ffn_post + c + 4 * h2), ga = *(const f32x4*)(md + 10240 + c + 4 * h2);
                    const f32x4 gg = g * ga;
#pragma unroll
                    for (int r2 = 0; r2 < 2; ++r2) {
                        const u32x2 xw = *(const u32x2*)(X1B + (size_t)(m + r2) * DM + c + 4 * h2);
                        const float xv[4] = {bf_lo(xw.x), bf_hi(xw.x), bf_lo(xw.y), bf_hi(xw.y)};
                        f32x4 r;
#pragma unroll
                        for (int e = 0; e < 4; ++e) r[e] = xv[e] + gg[e] * (v[r2][i][4 * h2 + e] * rstd[r2]);
                        *(f32x4*)(Y_ + (size_t)(m + r2) * DM + c + 4 * h2) = r; } } }
        }
    }
#undef IN
#undef SEAM
#undef ws
#undef x_prompt
#undef x_sample
#undef cvec
#undef cache_a_k
#undef cache_a_v
#undef cache_b_k
#undef cache_b_v
#undef c_ctx
#undef w_mod
#undef b_mod
#undef g_attn_pre
#undef g_attn_post
#undef g_ffn_pre
#undef g_ffn_post
#undef w_in
#undef rpb
#undef g_qnorm
#undef g_knorm
#undef w_out
#undef w_up
#undef conv_w
#undef conv_b
#undef w_down
#undef Y_
#undef st_ak
#undef st_av
#undef st_bk
#undef st_bv
#undef MOD
#undef MODP
#undef WIN
#undef WOUT
#undef WUP
#undef WDN
#undef XN
#undef CAK
#undef CAV
#undef CBK
#undef CBV
#undef QA
#undef KA
#undef VA
#undef QB
#undef KB
#undef VB
#undef OB
#undef P1
#undef P2
#undef ACT
#undef HBUF
#undef X1B
}

extern "C" void kernel_launch(void* const* d_in, const int* in_sizes, int n_in, void* d_out, int out_size, void* d_ws, size_t ws_size, hipStream_t stream) {
    static int grid = 0;
    if (grid == 0) {
        if (n_in != 23 || ws_size < WS_END) { fprintf(stderr, "kernel_launch: unexpected n_in %d or ws_size %zu (need %zu)\n", n_in, ws_size, (size_t)WS_END); grid = -1; return; }
        int dev = 0, cus = 0, per_cu = 0;
        hipGetDevice(&dev);
        hipDeviceGetAttribute(&cus, hipDeviceAttributeMultiprocessorCount, dev);
        if (hipFuncSetAttribute((const void*)mk_fwd, hipFuncAttributeMaxDynamicSharedMemorySize, LDS_BYTES) != hipSuccess) { fprintf(stderr, "kernel_launch: hipFuncSetAttribute failed\n"); grid = -1; return; }
        if (hipOccupancyMaxActiveBlocksPerMultiprocessor(&per_cu, (const void*)mk_fwd, 512, LDS_BYTES) != hipSuccess || per_cu < 1) { fprintf(stderr, "kernel_launch: occupancy query failed (%d)\n", per_cu); per_cu = 1; }
        (void)hipGetLastError();
        grid = cus * (per_cu > 1 ? 1 : per_cu);
        if (grid > 256) grid = 256;
    }
    if (grid < 0) return;
    if (hipMemsetAsync((char*)d_ws + WS_CTL, 0, CTL_BYTES, stream) != hipSuccess) { fprintf(stderr, "kernel_launch: memset failed\n"); return; }
    Args a{};
    for (int i = 0; i < 23; ++i) a.in[i] = (const float*)d_in[i];
    a.out = (float*)d_out; a.ws = (unsigned char*)d_ws; a.ph_lo = 0; a.ph_hi = 12;
    void* kargs[] = {&a};
    hipError_t e = hipLaunchCooperativeKernel((const void*)mk_fwd, dim3(grid), dim3(512), kargs, LDS_BYTES, stream);
    if (e != hipSuccess) fprintf(stderr, "kernel_launch: cooperative launch failed: %s (grid %d)\n", hipGetErrorString(e), grid);
}
```

```cpp
#include <hip/hip_runtime.h>
#include <hip/hip_cooperative_groups.h>
#include <cstdio>
#include <cstdint>
namespace cg = cooperative_groups;

#define LAS __attribute__((address_space(3)))
typedef unsigned short bf16_t;
typedef short bf16x8 __attribute__((ext_vector_type(8)));
typedef short s16x4 __attribute__((ext_vector_type(4)));
typedef float f32x4 __attribute__((ext_vector_type(4)));
typedef float f32x16 __attribute__((ext_vector_type(16)));
typedef unsigned u32x4 __attribute__((ext_vector_type(4)));
typedef unsigned u32x2 __attribute__((ext_vector_type(2)));

constexpr int DM = 2048, MTOK = 16384, NCTX = 8192, DFF = 5632, NUP = 11264, NIN = 4608, NMOD = 12288;
constexpr float EPS = 1e-6f;
constexpr int CHROWS = 4096;

constexpr size_t MiB = 1u << 20;
constexpr size_t WS_MOD = 0, WS_WDN = 1 * MiB, WS_XN = 23 * MiB, WS_WIN = 87 * MiB, WS_WOUT = 105 * MiB, WS_WUP = 113 * MiB;
constexpr size_t WS_CAK = 157 * MiB, WS_CAV = 161 * MiB, WS_CBK = 165 * MiB, WS_CBV = 166 * MiB;
constexpr size_t WS_QA = 167 * MiB, WS_KA = 199 * MiB, WS_VA = 231 * MiB, WS_QB = 263 * MiB, WS_KB = 295 * MiB, WS_VB = 303 * MiB;
constexpr size_t WS_O = 311 * MiB, WS_MODP = 311 * MiB;
constexpr size_t WS_P1 = 167 * MiB;
constexpr size_t WS_ACT = 157 * MiB, WS_U = 333 * MiB, WS_X1 = 341 * MiB;
constexpr size_t WS_P2 = 23 * MiB;
constexpr size_t WS_END = 421 * MiB;

constexpr int LDS_BYTES = 147456, MISC_OFF = 147200;
constexpr size_t WS_CTL = 512 * 1024, CTL_BYTES = 16384;

__device__ __forceinline__ unsigned cvt_pk_bf16(float lo, float hi) { unsigned r; asm volatile("v_cvt_pk_bf16_f32 %0, %1, %2" : "=v"(r) : "v"(lo), "v"(hi)); return r; }
__device__ __forceinline__ float bf_lo(unsigned w) { return __uint_as_float(w << 16); }
__device__ __forceinline__ float bf_hi(unsigned w) { return __uint_as_float(w & 0xffff0000u); }
__device__ __forceinline__ int tid_of(int wave_s) { unsigned z; asm volatile("v_mov_b32 %0, 0" : "=v"(z) :: "memory");
    return wave_s * 64 + (int)__builtin_amdgcn_mbcnt_hi(~0u, __builtin_amdgcn_mbcnt_lo(~0u, z)); }
__device__ __forceinline__ float wave_sum(float v) {
#pragma unroll
    for (int o = 1; o < 64; o <<= 1) v += __shfl_xor(v, o);
    return v;
}


#define XB_TMO      128
#define XB_XCNT(j)  (256  + 64 * (j))
#define XB_XSUB(j)  (1280 + 64 * (j))
#define XB_XGEN(j)  (2304 + 64 * (j))
#define XB_TOP      3328
#define XB_TOPGEN   3392
#define XCD_BAR_WORDS 3456
#define XB_SPIN_CAP (1u << 18)
__device__ __forceinline__ unsigned xb_ld(unsigned* p)              { return __hip_atomic_load(p, __ATOMIC_RELAXED, __HIP_MEMORY_SCOPE_AGENT); }
__device__ __forceinline__ unsigned xb_add(unsigned* p, unsigned v) { return __hip_atomic_fetch_add(p, v, __ATOMIC_RELAXED, __HIP_MEMORY_SCOPE_AGENT); }
__device__ __forceinline__ unsigned xb_xcc_id() { return (unsigned)__builtin_amdgcn_s_getreg((3 << 11) | 20) & 0xFu; }
#define XB_SPIN(cond, bar) do { unsigned _sp = 0; while (cond) { __builtin_amdgcn_s_sleep(1); \
    if ((++_sp & 255u) == 0u) { if (xb_ld(&(bar)[XB_TMO])) break; if (_sp > XB_SPIN_CAP) { atomicAdd(&(bar)[XB_TMO], 1u); break; } } } } while (0)
struct XcdBarrier { unsigned* bar; unsigned x; volatile LAS unsigned* st; };
__device__ __forceinline__ XcdBarrier xcd_barrier_post(unsigned* bar, volatile LAS unsigned* st, int wave_s) {
    XcdBarrier b; b.bar = bar; b.x = xb_xcc_id(); b.st = st;
    if (tid_of(wave_s) == 0) (void)xb_add(&bar[XB_XCNT(b.x)], 1u);
    return b;
}
__device__ __forceinline__ void xcd_barrier_complete(unsigned* bar, unsigned x, unsigned& nloc, unsigned& nx) {
    const unsigned G = gridDim.x * gridDim.y * gridDim.z;
    unsigned sum, cnt, mine, sp = 0u;
    for (;;) {
        sum = 0u; cnt = 0u; mine = 0u;
#pragma unroll
        for (unsigned j = 0; j < 16; ++j) { const unsigned c = xb_ld(&bar[XB_XCNT(j)]); sum += c; cnt += (c > 0u) ? 1u : 0u; mine = (j == x) ? c : mine; }
        if (sum == G) break;
        __builtin_amdgcn_s_sleep(1);
        if ((++sp & 255u) == 0u) { if (xb_ld(&bar[XB_TMO])) break; if (sp > XB_SPIN_CAP) { atomicAdd(&bar[XB_TMO], 1u); break; } }
    }
    nloc = mine > 0u ? mine : 1u; nx = cnt > 0u ? cnt : 1u;
}
__device__ __forceinline__ void xcd_barrier(const XcdBarrier& b, int wave_s) {
    asm volatile("s_waitcnt vmcnt(0)" ::: "memory");
    __syncthreads();
    if (tid_of(wave_s) == 0) {
        unsigned* bar = b.bar;
        __builtin_amdgcn_s_waitcnt(0);
        unsigned nloc = b.st[0], nx = b.st[1];
        if (nloc == 0u) { xcd_barrier_complete(bar, b.x, nloc, nx); b.st[0] = nloc; b.st[1] = nx; }
        const unsigned old = xb_add(&bar[XB_XSUB(b.x)], 1u);
        const unsigned gen = old / nloc;
        if (old + 1u == (gen + 1u) * nloc) {
            __builtin_amdgcn_fence(__ATOMIC_RELEASE, "agent");
            asm volatile("s_waitcnt vmcnt(0)" ::: "memory");
            const unsigned og = xb_add(&bar[XB_TOP], 1u);
            const unsigned tg = og / nx;
            if (og + 1u == (tg + 1u) * nx) xb_add(&bar[XB_TOPGEN], 1u);
            else XB_SPIN(xb_ld(&bar[XB_TOPGEN]) == tg, bar);
            __builtin_amdgcn_fence(__ATOMIC_ACQUIRE, "agent");
            xb_add(&bar[XB_XGEN(b.x)], 1u);
            asm volatile("s_waitcnt vmcnt(0)" ::: "memory");
        } else {
            XB_SPIN(xb_ld(&bar[XB_XGEN(b.x)]) == gen, bar);
            __builtin_amdgcn_fence(__ATOMIC_ACQUIRE, "agent");
            asm volatile("s_waitcnt vmcnt(0)" ::: "memory");
        }
    }
    __syncthreads();
}

namespace pg8 {
constexpr int BM = 256, BK = 64, HALF = 128, HTB = HALF * BK * 2, STAGE_BYTES = 8 * HTB, NXCD = 8, WGM = 8;
__host__ __device__ __forceinline__ int lds_byte(int r, int c) { const int st = (r >> 4) * 2 + (c >> 5), rr = r & 15, cc = c & 31, ob = rr * 64 + cc * 2; return st * 1024 + (ob ^ (((ob >> 9) & 1) << 5)); }
__host__ __device__ __forceinline__ void stage_rc(int b, int& R, int& C) { const int st = b / 1024, sb = b % 1024, swz = sb ^ (((sb >> 9) & 1) << 5); R = (st >> 1) * 16 + swz / 64; C = (st & 1) * 32 + (swz % 64) / 2; }
__host__ __device__ __forceinline__ int perm32(int rho) { const int n = rho >> 4, i = rho & 15; return 8 * (i >> 2) + 4 * n + (i & 3); }

struct Unit { int pm, pn; };
struct Gemm { const bf16_t* A; const bf16_t* Bt; int M, N, K; };

struct StaticOrder {
    int nM, nN, nwg, G, c;
    __host__ __device__ void init(int M, int N, int G_, int c_) { nM = M / BM; nN = N / BM; nwg = nM * nN; G = G_; c = c_; }
    __host__ __device__ bool next(int i, Unit& u) const {
        const long L = (long)i * G + c; if (L >= nwg) return false;
        int wgid = (int)L; { const int q = nwg / NXCD, r = nwg % NXCD, xcd = wgid % NXCD, off = wgid / NXCD; wgid = (xcd < r ? xcd * (q + 1) : r * (q + 1) + (xcd - r) * q) + off; }
        const int nig = WGM * nN, gid = wgid / nig, fm = gid * WGM, gsz = (nM - fm) < WGM ? (nM - fm) : WGM;
        u.pm = fm + ((wgid % nig) % gsz); u.pn = (wgid % nig) / gsz; return true;
    }
    __device__ __forceinline__ void a_ready(const Unit&) const {}
    __device__ __forceinline__ void done(const Unit&) const {}
};

__device__ __forceinline__ u32x4 quad_xpose(u32x4 w, int src4) {
    u32x4 r;
    r.x = (unsigned)__builtin_amdgcn_ds_bpermute(src4, (int)w.x); r.y = (unsigned)__builtin_amdgcn_ds_bpermute(src4, (int)w.y);
    r.z = (unsigned)__builtin_amdgcn_ds_bpermute(src4, (int)w.z); r.w = (unsigned)__builtin_amdgcn_ds_bpermute(src4, (int)w.w);
    return r;
}
struct EpiF32 {
    static constexpr bool PERM = false, AFTER_DRAIN = false;
    float* C; int ldc;
    __device__ __forceinline__ void operator()(const f32x4 (&acc)[2][2][4][2], const Unit& u, int wr, int wc, int fr, int fq) const {
        const int row0 = u.pm * BM + wr * 64 + fr, col0 = u.pn * BM + wc * 32 + 4 * fq;
#pragma unroll
        for (int ai = 0; ai < 2; ++ai)
#pragma unroll
            for (int m = 0; m < 4; ++m) { float* rowp = C + (size_t)(row0 + ai * HALF + m * 16) * ldc + col0;
#pragma unroll
                for (int bj = 0; bj < 2; ++bj)
#pragma unroll
                    for (int n = 0; n < 2; ++n) *(f32x4*)(rowp + bj * HALF + n * 16) = acc[ai][bj][m][n]; }
    }
};
struct EpiBf16 {
    static constexpr bool PERM = true, AFTER_DRAIN = false;
    bf16_t* O; int ldc;
    __device__ __forceinline__ void operator()(const f32x4 (&acc)[2][2][4][2], const Unit& u, int wr, int wc, int fr, int fq) const {
        const int ln = fr + 16 * fq, r4 = ln >> 2, c4 = ln & 3, src4 = 4 * (16 * c4 + r4);
        const int row0 = u.pm * BM + wr * 64 + r4, col0 = u.pn * BM + wc * 32 + 8 * c4;
#pragma unroll
        for (int ai = 0; ai < 2; ++ai)
#pragma unroll
            for (int m = 0; m < 4; ++m) { bf16_t* rowp = O + (size_t)(row0 + ai * HALF + m * 16) * ldc + col0;
#pragma unroll
                for (int bj = 0; bj < 2; ++bj) { const f32x4 v0 = acc[ai][bj][m][0], v1 = acc[ai][bj][m][1];
                    u32x4 w; w.x = cvt_pk_bf16(v0[0], v0[1]); w.y = cvt_pk_bf16(v0[2], v0[3]); w.z = cvt_pk_bf16(v1[0], v1[1]); w.w = cvt_pk_bf16(v1[2], v1[3]);
                    *(u32x4*)(rowp + bj * HALF) = quad_xpose(w, src4); } }
    }
};
struct EpiQKV {
    static constexpr bool PERM = true, AFTER_DRAIN = false;
    bf16_t *QA, *KA, *VA, *QB, *KB, *VB; float *sak, *sav, *sbv;
    __device__ __forceinline__ void operator()(const f32x4 (&acc)[2][2][4][2], const Unit& u, int wr, int wc, int fr, int fq) const {
        const int pn = u.pn, pm = u.pm;
        bf16_t* buf; int H, h0; float* st = nullptr;
        if (pn < 4) { buf = QA; H = 8; h0 = 2 * pn; }
        else if (pn < 8) { buf = KA; H = 8; h0 = 2 * (pn - 4); st = sak; }
        else if (pn < 12) { buf = VA; H = 8; h0 = 2 * (pn - 8); st = sav; }
        else if (pn < 16) { buf = QB; H = 8; h0 = 2 * (pn - 12); }
        else if (pn == 16) { buf = KB; H = 2; h0 = 0; }
        else { buf = VB; H = 2; h0 = 0; st = sbv; }
        const bool ctx = pm < 32;
        int b, t0, L; size_t reg;
        if (ctx) { b = pm; t0 = 0; L = 256; reg = 0; } else { b = (pm - 32) >> 2; t0 = ((pm - 32) & 3) * 256; L = 1024; reg = (size_t)NCTX * H * 128; }
#pragma unroll
        for (int bj = 0; bj < 2; ++bj) {
            const int h = h0 + bj;
            bf16_t* base = buf + reg + ((size_t)(b * H + h) * L + t0) * 128 + wc * 32 + 8 * fq;
            float* sbase = st + ((size_t)(b * H + h) * 256) * 128 + wc * 32 + 8 * fq;
#pragma unroll
            for (int ai = 0; ai < 2; ++ai)
#pragma unroll
                for (int m = 0; m < 4; ++m) {
                    const int t = ai * HALF + wr * 64 + m * 16 + fr;
                    const f32x4 v0 = acc[ai][bj][m][0], v1 = acc[ai][bj][m][1];
                    u32x4 w; w.x = cvt_pk_bf16(v0[0], v0[1]); w.y = cvt_pk_bf16(v0[2], v0[3]); w.z = cvt_pk_bf16(v1[0], v1[1]); w.w = cvt_pk_bf16(v1[2], v1[3]);
                    *(u32x4*)(base + (size_t)t * 128) = w;
                    if (ctx && st) { *(f32x4*)(sbase + (size_t)t * 128) = v0; *(f32x4*)(sbase + (size_t)t * 128 + 4) = v1; }
                    asm volatile("" ::: "memory");
                }
        }
    }
};


template <int CTRL> __device__ __forceinline__ float dppf(float old, float src) {
    return __builtin_bit_cast(float, __builtin_amdgcn_update_dpp(__builtin_bit_cast(int, old), __builtin_bit_cast(int, src), CTRL, 0xF, 0xF, false));
}
struct EpiConv {
    static constexpr bool PERM = true, AFTER_DRAIN = false;
    bf16_t* ACT; float* HB; const float* cw; const float* cb; LAS float* H;
    __device__ __forceinline__ void operator()(const f32x4 (&acc)[2][2][4][2], const Unit& u, int wr, int wc, int fr, int fq) const {
        const int pm = u.pm, pn = u.pn;
        const int cl = 32 * wc + 8 * fq, j0 = 128 * pn + cl;
#pragma unroll
        for (int ai = 0; ai < 2; ++ai) { const int blk = ai * 2 + wr;
            if (fr == 0) {
#pragma unroll
                for (int bj = 0; bj < 2; ++bj)
#pragma unroll
                    for (int n = 0; n < 2; ++n) *(LAS f32x4*)(H + ((blk * 2 + 0) * 2 + bj) * 128 + cl + 4 * n) = acc[ai][bj][0][n]; }
            if (fr == 15) {
#pragma unroll
                for (int bj = 0; bj < 2; ++bj)
#pragma unroll
                    for (int n = 0; n < 2; ++n) *(LAS f32x4*)(H + ((blk * 2 + 1) * 2 + bj) * 128 + cl + 4 * n) = acc[ai][bj][3][n]; } }
        if (pm >= 32) { const int lt = pm - 32;
            if (wr == 0 && fr < 2) {
#pragma unroll
                for (int bj = 0; bj < 2; ++bj)
#pragma unroll
                    for (int n = 0; n < 2; ++n) *(f32x4*)(HB + ((size_t)((lt * 4 + fr) * 2 + bj)) * DFF + j0 + 4 * n) = acc[0][bj][0][n]; }
            if (wr == 1 && fr >= 14) {
#pragma unroll
                for (int bj = 0; bj < 2; ++bj)
#pragma unroll
                    for (int n = 0; n < 2; ++n) *(f32x4*)(HB + ((size_t)((lt * 4 + fr - 12) * 2 + bj)) * DFF + j0 + 4 * n) = acc[1][bj][3][n]; } }
        asm volatile("s_waitcnt lgkmcnt(0)" ::: "memory"); __builtin_amdgcn_s_barrier(); asm volatile("" ::: "memory");
        u32x2 keep[2][4];
        const int ln = fr + 16 * fq, r4 = ln >> 2, c4 = ln & 3, src4 = 4 * (16 * c4 + r4);
#pragma unroll
        for (int n = 0; n < 2; ++n) {
            f32x4 w[3][2], bs[2];
#pragma unroll
            for (int bj = 0; bj < 2; ++bj) { bs[bj] = *(const f32x4*)(cb + bj * DFF + j0 + 4 * n);
#pragma unroll
                for (int k = 0; k < 3; ++k) w[k][bj] = *(const f32x4*)(cw + (size_t)k * NUP + bj * DFF + j0 + 4 * n); }
#pragma unroll
            for (int ai = 0; ai < 2; ++ai) { const int blk = ai * 2 + wr;
                f32x4 hu[2], hd[2];
#pragma unroll
                for (int bj = 0; bj < 2; ++bj) {
                    hu[bj] = (blk > 0) ? *(const LAS f32x4*)(H + (((blk - 1) * 2 + 1) * 2 + bj) * 128 + cl + 4 * n) : (f32x4){0.f, 0.f, 0.f, 0.f};
                    hd[bj] = (blk < 3) ? *(const LAS f32x4*)(H + (((blk + 1) * 2 + 0) * 2 + bj) * 128 + cl + 4 * n) : (f32x4){0.f, 0.f, 0.f, 0.f}; }
#pragma unroll
                for (int m = 0; m < 4; ++m) {
                    float a[4];
#pragma unroll
                    for (int e = 0; e < 4; ++e) {
                        float r[2];
#pragma unroll
                        for (int bj = 0; bj < 2; ++bj) {
                            const float cur = acc[ai][bj][m][n][e];
                            const float upT = (m == 0) ? hu[bj][e] : dppf<0x121>(0.f, acc[ai][bj][m == 0 ? 0 : m - 1][n][e]);
                            const float up = dppf<0x111>(upT, cur);
                            const float dnT = (m == 3) ? hd[bj][e] : dppf<0x12F>(0.f, acc[ai][bj][m == 3 ? 3 : m + 1][n][e]);
                            const float dn = dppf<0x101>(dnT, cur);
                            r[bj] = w[0][bj][e] * up + w[1][bj][e] * cur + w[2][bj][e] * dn + bs[bj][e];
                        }
                        a[e] = r[1] * __builtin_amdgcn_rcpf(1.f + __expf(-r[1])) * r[0];
                    }
                    u32x2 ow; ow.x = cvt_pk_bf16(a[0], a[1]); ow.y = cvt_pk_bf16(a[2], a[3]);
                    if (n == 0) keep[ai][m] = ow;
                    else { u32x4 w16; w16.x = keep[ai][m].x; w16.y = keep[ai][m].y; w16.z = ow.x; w16.w = ow.y;
                        *(u32x4*)(ACT + (size_t)(pm * BM + ai * HALF + wr * 64 + m * 16 + r4) * DFF + 128 * pn + 32 * wc + 8 * c4) = quad_xpose(w16, src4); }
                }
            }
        }
    }
};

template <class Epi, class Sched, bool ALIGN_EPI = true>
__device__ __forceinline__ void gemm_phase(LAS unsigned char* lds, const Gemm g, const Sched& S, const Epi& E, int wave_s) {
    const int tid = tid_of(wave_s);
    const int wid = wave_s, lane = tid & 63, wr = wid >> 2, wc = wid & 3, fr = lane & 15, fq = lane >> 4;
    const int K = g.K, nt = K / BK;
    unsigned voffA[2], voffB[2];
#pragma unroll
    for (int i = 0; i < 2; ++i) { int R, C; stage_rc(tid * 16 + i * 8192, R, C); const int Rb = Epi::PERM ? ((R & ~31) + perm32(R & 31)) : R;
        voffA[i] = (unsigned)(R * K + C) * 2u; voffB[i] = (unsigned)(Rb * K + C) * 2u; }
    const size_t kstep = (size_t)(BK * 2);
    const size_t hstep = (size_t)HALF * K * 2;
    const size_t tstep = 2 * hstep;
    const unsigned ldsw = (unsigned)wid * 1024u;
    const int aoff = lds_byte(wr * 64 + fr, fq * 8), boff = lds_byte(wc * 32 + fr, fq * 8);
#define PG8_SA(b, h) (((b) * 2 + (h)) * HTB)
#define PG8_SB(b, h) ((4 + (b) * 2 + (h)) * HTB)
#define PG8_STAGE(bufoff, gbase, voff) do { _Pragma("unroll") for (int _i = 0; _i < 2; ++_i) \
        __builtin_amdgcn_global_load_lds((const unsigned*)((const char*)(gbase) + (voff)[_i]), (LAS unsigned*)(lds + (bufoff) + ldsw + _i * 8192), 16, 0, 0); } while (0)
#define PG8_LDA(dst, b, h) do { _Pragma("unroll") for (int m = 0; m < 4; ++m) _Pragma("unroll") for (int k = 0; k < 2; ++k) dst[m][k] = *(const LAS bf16x8*)(lds + PG8_SA(b, h) + aoff + m * 2048 + k * 1024); } while (0)
#define PG8_LDB(dst, b, h) do { _Pragma("unroll") for (int n = 0; n < 2; ++n) _Pragma("unroll") for (int k = 0; k < 2; ++k) dst[n][k] = *(const LAS bf16x8*)(lds + PG8_SB(b, h) + boff + n * 2048 + k * 1024); } while (0)
#define PG8_MMA(ai, bj, At, Bt) do { __builtin_amdgcn_s_setprio(1); _Pragma("unroll") for (int m = 0; m < 4; ++m) _Pragma("unroll") for (int n = 0; n < 2; ++n) _Pragma("unroll") for (int k = 0; k < 2; ++k) \
        acc[ai][bj][m][n] = __builtin_amdgcn_mfma_f32_16x16x32_bf16(Bt[n][k], At[m][k], acc[ai][bj][m][n], 0, 0, 0); __builtin_amdgcn_s_setprio(0); } while (0)
#define PG8_WAIT_V(n) asm volatile("s_waitcnt vmcnt(" #n ")" ::: "memory")
#define PG8_WAIT_L(n) asm volatile("s_waitcnt lgkmcnt(" #n ")" ::: "memory")
#define PG8_BAR __builtin_amdgcn_s_barrier()
#define PG8_SCHED __builtin_amdgcn_sched_barrier(0)
    Unit cur, nxt; int ui = 0;
    if (!S.next(0, cur)) return;
    f32x4 acc[2][2][4][2];
#pragma unroll
    for (int a = 0; a < 2; ++a)
#pragma unroll
        for (int b = 0; b < 2; ++b)
#pragma unroll
            for (int m = 0; m < 4; ++m)
#pragma unroll
                for (int n = 0; n < 2; ++n) acc[a][b][m][n] = (f32x4){0.f, 0.f, 0.f, 0.f};
    bf16x8 At[4][2], B0[2][2], B1[2][2];
    const char* cA = (const char*)g.A + (size_t)cur.pm * tstep; const char* cB = (const char*)g.Bt + (size_t)cur.pn * tstep;
    S.a_ready(cur);
    PG8_STAGE(PG8_SB(0, 0), cB, voffB); PG8_STAGE(PG8_SB(0, 1), cB + hstep, voffB); PG8_STAGE(PG8_SA(0, 0), cA, voffA); PG8_STAGE(PG8_SA(0, 1), cA + hstep, voffA);
    if (wr == 1) PG8_BAR;
    PG8_WAIT_V(2); PG8_BAR;
    PG8_STAGE(PG8_SB(1, 0), cB + kstep, voffB); PG8_STAGE(PG8_SA(1, 0), cA + kstep, voffA); PG8_STAGE(PG8_SB(1, 1), cB + hstep + kstep, voffB);
    PG8_WAIT_V(6); PG8_BAR;
    for (;;) {
        const bool has_next = S.next(ui + 1, nxt);
        const char* nA = has_next ? (const char*)g.A + (size_t)nxt.pm * tstep : cA; const char* nB = has_next ? (const char*)g.Bt + (size_t)nxt.pn * tstep : cB;
        for (int t = 0; t < nt; t += 2) {
            const bool last = (t == nt - 2);
            const char* a1 = cA + (size_t)(t + 1) * kstep;
            const char* a2 = last ? nA : cA + (size_t)(t + 2) * kstep; const char* b2 = last ? nB : cB + (size_t)(t + 2) * kstep;
            const char* a3 = a2 + kstep; const char* b3 = b2 + kstep;
            if (last && has_next) S.a_ready(nxt);
            PG8_LDB(B0, 0, 0); PG8_LDB(B1, 0, 1); PG8_SCHED; PG8_LDA(At, 0, 0); PG8_STAGE(PG8_SA(1, 1), a1 + hstep, voffA);
            PG8_WAIT_V(8); PG8_WAIT_L(0); PG8_BAR; PG8_MMA(0, 0, At, B0); PG8_MMA(0, 1, At, B1); PG8_BAR; PG8_SCHED;
            PG8_LDA(At, 0, 1); PG8_STAGE(PG8_SB(0, 0), b2, voffB); PG8_STAGE(PG8_SB(0, 1), b2 + hstep, voffB); PG8_STAGE(PG8_SA(0, 0), a2, voffA);
            PG8_WAIT_V(8); PG8_WAIT_L(0); PG8_BAR; PG8_MMA(1, 0, At, B0); PG8_MMA(1, 1, At, B1); PG8_BAR; PG8_SCHED;
            PG8_LDB(B0, 1, 0); PG8_LDB(B1, 1, 1); PG8_SCHED; PG8_LDA(At, 1, 0); PG8_STAGE(PG8_SA(0, 1), a2 + hstep, voffA);
            PG8_WAIT_V(8); PG8_WAIT_L(0); PG8_BAR; PG8_MMA(0, 0, At, B0); PG8_MMA(0, 1, At, B1); PG8_BAR; PG8_SCHED;
            PG8_LDA(At, 1, 1); PG8_STAGE(PG8_SB(1, 0), b3, voffB); PG8_STAGE(PG8_SB(1, 1), b3 + hstep, voffB); PG8_STAGE(PG8_SA(1, 0), a3, voffA);
            PG8_WAIT_V(8); PG8_WAIT_L(0); PG8_BAR; PG8_MMA(1, 0, At, B0); PG8_MMA(1, 1, At, B1); PG8_BAR; PG8_SCHED;
        }
        if constexpr (ALIGN_EPI) { if (wr == 0) PG8_BAR; }
        E(acc, cur, wr, wc, fr, fq); S.done(cur);
        if (!has_next) break;
#pragma unroll
        for (int a = 0; a < 2; ++a)
#pragma unroll
            for (int b = 0; b < 2; ++b)
#pragma unroll
                for (int m = 0; m < 4; ++m)
#pragma unroll
                    for (int n = 0; n < 2; ++n) acc[a][b][m][n] = (f32x4){0.f, 0.f, 0.f, 0.f};
        cur = nxt; cA = nA; cB = nB; ++ui;
        if constexpr (ALIGN_EPI) { if (wr == 1) PG8_BAR; }
    }
    PG8_WAIT_V(0);
    if constexpr (!ALIGN_EPI) { if (wr == 0) PG8_BAR; }
    PG8_BAR;
#undef PG8_SA
#undef PG8_SB
#undef PG8_STAGE
#undef PG8_LDA
#undef PG8_LDB
#undef PG8_MMA
#undef PG8_WAIT_V
#undef PG8_WAIT_L
#undef PG8_BAR
#undef PG8_SCHED
}
}

namespace att {
constexpr int D = 128, NW = 8, QBLK = 32, KVBLK = 64;
constexpr float SCALE = 0.088388347648318440f;
constexpr float THR = 8.f;
constexpr int SHM_V = KVBLK * D * 2, SHM_K = KVBLK * D * 2, SHM_ATTN = 2 * SHM_V + 2 * SHM_K + NW * 64 * 4;
constexpr int BIAS_OFF = SHM_ATTN, BIAS_FLOATS = 704;
constexpr int OST_OFF = 73728, OST_WAVE = 32 * 272;
#define KSWZ(row, colB) ((row) * 256 + ((colB) ^ (((row) & 7) << 4)))
#define SBAR() __builtin_amdgcn_sched_barrier(0)
__device__ __forceinline__ int crow(int r, int hi) { return (r & 3) + 8 * (r >> 2) + 4 * hi; }
__device__ __forceinline__ unsigned cvtpk(float lo, float hi) { unsigned r; asm volatile("v_cvt_pk_bf16_f32 %0, %1, %2" : "=v"(r) : "v"(lo), "v"(hi)); return r; }
__device__ __forceinline__ bf16x8 ld8(const bf16_t* p) { return *reinterpret_cast<const bf16x8*>(p); }

__device__ __forceinline__ void partialSM(f32x16& p0, f32x16& p1, float& m_reg, float& mn, float& alpha) {
  constexpr float C = SCALE * 1.4426950408889634f;
  float pmax = p0[0];
#pragma unroll
  for (int r = 1; r < 16; ++r) pmax = fmaxf(pmax, p0[r]);
#pragma unroll
  for (int r = 0; r < 16; ++r) pmax = fmaxf(pmax, p1[r]);
  { auto rr = __builtin_amdgcn_permlane32_swap(__float_as_uint(pmax), __float_as_uint(pmax), false, false);
    pmax = fmaxf(__uint_as_float(rr[0]), __uint_as_float(rr[1])); }
  if (__builtin_expect(__all(pmax - m_reg <= THR / SCALE), 1)) { mn = m_reg; alpha = 1.f; }
  else { mn = fmaxf(m_reg, pmax); alpha = __builtin_amdgcn_exp2f((m_reg - mn) * C); m_reg = mn; }
  float mnC = -mn * C;
#pragma unroll
  for (int r = 0; r < 16; ++r) p0[r] = fmaf(p0[r], C, mnC);
#pragma unroll
  for (int r = 0; r < 16; ++r) p1[r] = fmaf(p1[r], C, mnC);
#pragma unroll
  for (int r = 0; r < 16; ++r) p0[r] = __builtin_amdgcn_exp2f(p0[r]);
}
__device__ __forceinline__ void finishSM(f32x16& p0, f32x16& p1, float alpha, float& l_reg, bf16x8& pa0, bf16x8& pa1, bf16x8& pa2, bf16x8& pa3) {
#pragma unroll
  for (int r = 0; r < 16; ++r) p1[r] = __builtin_amdgcn_exp2f(p1[r]);
  float ps = 0;
#pragma unroll
  for (int r = 0; r < 16; ++r) ps += p0[r];
#pragma unroll
  for (int r = 0; r < 16; ++r) ps += p1[r];
  { auto rr = __builtin_amdgcn_permlane32_swap(__float_as_uint(ps), __float_as_uint(ps), false, false);
    ps = __uint_as_float(rr[0]) + __uint_as_float(rr[1]); }
  l_reg = l_reg * alpha + ps;
#define PK4(P, BASE, OUT) do { unsigned a0 = cvtpk(P[BASE + 0], P[BASE + 1]), a1 = cvtpk(P[BASE + 2], P[BASE + 3]);   \
    unsigned b0 = cvtpk(P[BASE + 4], P[BASE + 5]), b1 = cvtpk(P[BASE + 6], P[BASE + 7]);                              \
    auto r0 = __builtin_amdgcn_permlane32_swap(a0, b0, false, false); auto r1 = __builtin_amdgcn_permlane32_swap(a1, b1, false, false); \
    u32x4 w = {r0[0], r1[0], r0[1], r1[1]}; OUT = *reinterpret_cast<bf16x8*>(&w); } while (0)
  PK4(p0, 0, pa0); PK4(p0, 8, pa1); PK4(p1, 0, pa2); PK4(p1, 8, pa3);
#undef PK4
}
__device__ __forceinline__ void qkt(f32x16& p0, f32x16& p1, const char* Ks, const bf16x8* qr, int r32, int hi) {
  p0 = f32x16{}; p1 = f32x16{};
#pragma unroll
  for (int d0 = 0; d0 < 8; ++d0) { int cb = (d0 * 16 + hi * 8) * 2;
    bf16x8 b0 = *reinterpret_cast<const bf16x8*>(Ks + KSWZ(r32, cb));
    bf16x8 b1 = *reinterpret_cast<const bf16x8*>(Ks + KSWZ(32 + r32, cb));
    p0 = __builtin_amdgcn_mfma_f32_32x32x16_bf16(b0, qr[d0], p0, 0, 0, 0);
    p1 = __builtin_amdgcn_mfma_f32_32x32x16_bf16(b1, qr[d0], p1, 0, 0, 0); }
}
__device__ __forceinline__ int v_st(int k, int c) { const int kk = (k & ~0xC) | ((k & 4) << 1) | ((k & 8) >> 1); return ((kk >> 3) * 4 + (c >> 5)) * 512 + ((kk & 7) * 32 + (c & 31)) * 2; }
__device__ __forceinline__ int v_rd_base(int lane) { return ((lane & 3) << 3) | (((lane >> 2) & 3) << 6) | (((lane >> 4) & 1) << 5) | (((lane >> 5) & 1) << 8); }
constexpr int v_rd_off(int d0, int ks, int half) { return d0 * 512 + ks * 4096 + half * 2048; }
template <int OFF> __device__ __forceinline__ s16x4 tr_read(int vb) {
  s16x4 r; asm volatile("ds_read_b64_tr_b16 %0, %1 offset:%2" : "=&v"(r) : "v"(vb), "i"(OFF) : "memory"); return r;
}
template <int D0> __device__ __forceinline__ void pv_one(f32x16& od, int vb, bf16x8 pa0, bf16x8 pa1, bf16x8 pa2, bf16x8 pa3) {
  const s16x4 l0 = tr_read<v_rd_off(D0, 0, 0)>(vb), h0 = tr_read<v_rd_off(D0, 0, 1)>(vb), l1 = tr_read<v_rd_off(D0, 1, 0)>(vb), h1 = tr_read<v_rd_off(D0, 1, 1)>(vb);
  const s16x4 l2 = tr_read<v_rd_off(D0, 2, 0)>(vb), h2 = tr_read<v_rd_off(D0, 2, 1)>(vb), l3 = tr_read<v_rd_off(D0, 3, 0)>(vb), h3 = tr_read<v_rd_off(D0, 3, 1)>(vb);
  asm volatile("s_waitcnt lgkmcnt(0)" ::: "memory"); SBAR();
#define PK(L, H) (bf16x8){L[0], L[1], L[2], L[3], H[0], H[1], H[2], H[3]}
  od = __builtin_amdgcn_mfma_f32_32x32x16_bf16(pa0, PK(l0, h0), od, 0, 0, 0);
  od = __builtin_amdgcn_mfma_f32_32x32x16_bf16(pa1, PK(l1, h1), od, 0, 0, 0);
  od = __builtin_amdgcn_mfma_f32_32x32x16_bf16(pa2, PK(l2, h2), od, 0, 0, 0);
  od = __builtin_amdgcn_mfma_f32_32x32x16_bf16(pa3, PK(l3, h3), od, 0, 0, 0);
#undef PK
}
__device__ __forceinline__ void pv_d0(f32x16* o, int vb, bf16x8 pa0, bf16x8 pa1, bf16x8 pa2, bf16x8 pa3) {
  pv_one<0>(o[0], vb, pa0, pa1, pa2, pa3); pv_one<1>(o[1], vb, pa0, pa1, pa2, pa3); pv_one<2>(o[2], vb, pa0, pa1, pa2, pa3); pv_one<3>(o[3], vb, pa0, pa1, pa2, pa3);
}

template <bool NB, int QN = 0>
__device__ __forceinline__ void attn_body(const bf16_t* __restrict__ Qb, const bf16_t* __restrict__ K0, const bf16_t* __restrict__ V0, int nt0,
                                          const bf16_t* __restrict__ K1, const bf16_t* __restrict__ V1, int NT,
                                          bf16_t* __restrict__ Ob, char* lds, int nb_r0, int nb_krlo, int wave_s,
                                          const float* __restrict__ gq = nullptr, int tpos0 = 0) {
  const int tid = tid_of(wave_s);
  const int wid = wave_s, lane = tid & 63, r32 = lane & 31, hi = lane >> 5;
  char* V_lds = lds; char* K_lds = lds + 2 * SHM_V;
  float* ws = (float*)(lds + 2 * SHM_V + 2 * SHM_K) + wid * 64; float* li_l = ws; float* al_l = ws + 32;
  float m_reg = -1e30f, l_reg = 0; f32x16 o[4] = {}; bf16x8 qr[8];
  const bf16_t* Qw = Qb + (size_t)(wid * QBLK + r32) * D + hi * 8;
#pragma unroll
  for (int d0 = 0; d0 < 8; ++d0) qr[d0] = ld8(Qw + d0 * 16);
  if constexpr (QN != 0) {
    float qf[8][8]; float ss = 0.f;
#pragma unroll
    for (int d0 = 0; d0 < 8; ++d0) { const u32x4 w = __builtin_bit_cast(u32x4, qr[d0]);
      qf[d0][0] = bf_lo(w.x); qf[d0][1] = bf_hi(w.x); qf[d0][2] = bf_lo(w.y); qf[d0][3] = bf_hi(w.y); qf[d0][4] = bf_lo(w.z); qf[d0][5] = bf_hi(w.z); qf[d0][6] = bf_lo(w.w); qf[d0][7] = bf_hi(w.w);
#pragma unroll
      for (int e = 0; e < 8; ++e) ss += qf[d0][e] * qf[d0][e]; }
    ss += __shfl_xor(ss, 32);
    const float rstd = rsqrtf(ss * (1.f / 128.f) + EPS);
#pragma unroll
    for (int d0 = 0; d0 < 8; ++d0) { const f32x4 g0 = *(const f32x4*)(gq + d0 * 16 + hi * 8), g1 = *(const f32x4*)(gq + d0 * 16 + hi * 8 + 4);
#pragma unroll
      for (int e = 0; e < 4; ++e) { qf[d0][e] *= rstd * g0[e]; qf[d0][4 + e] *= rstd * g1[e]; } }
    if constexpr (QN == 2) {
      const int tq = tpos0 + wid * QBLK + r32;
#pragma unroll
      for (int dh = 0; dh < 2; ++dh)
#pragma unroll
        for (int e = 0; e < 8; ++e) {
          const float fr_ = __builtin_amdgcn_exp2f(-(float)(dh * 16 + hi * 8 + e) * (13.287712379549449f / 32.f)) * 0.15915494309189535f;
#pragma unroll
          for (int H = 0; H < 2; ++H) {
            float rev = (float)(H ? (tq & 63) : (tq >> 6)) * fr_; rev -= floorf(rev);
            const float sn = __builtin_amdgcn_sinf(rev), cn = __builtin_amdgcn_cosf(rev);
            const float x1 = qf[4 * H + dh][e], x2 = qf[4 * H + dh + 2][e];
            qf[4 * H + dh][e] = x1 * cn - x2 * sn; qf[4 * H + dh + 2][e] = x2 * cn + x1 * sn; } }
    }
#pragma unroll
    for (int d0 = 0; d0 < 8; ++d0) { u32x4 w; w.x = cvtpk(qf[d0][0], qf[d0][1]); w.y = cvtpk(qf[d0][2], qf[d0][3]); w.z = cvtpk(qf[d0][4], qf[d0][5]); w.w = cvtpk(qf[d0][6], qf[d0][7]);
      qr[d0] = __builtin_bit_cast(bf16x8, w); }
  }
  const int sr = tid >> 4, sc = (tid & 15) * 8, vst0 = v_st(sr, sc), vst1 = v_st(32 + sr, sc);
  const int vb0 = (int)(uintptr_t)V_lds + v_rd_base(lane);
  const int nq_r = nb_r0 + (wid >> 1), nq_c = 32 * (wid & 1) + r32;
  const int nrs = min(max(nq_r - 4, 0), 8), ncs = min(max(nq_c - 8, 0), 48);
  const float* btab = (const float*)(lds + BIAS_OFF) + 64 + 15 - nq_c + 4 * hi;
  struct { bf16x8 vs0, vs1, ks0, ks1; } sr_[2];
#define KPTR(j) ((j) < nt0 ? K0 + (size_t)(j) * (KVBLK * D) : K1 + (size_t)((j) - nt0) * (KVBLK * D))
#define VPTR(j) ((j) < nt0 ? V0 + (size_t)(j) * (KVBLK * D) : V1 + (size_t)((j) - nt0) * (KVBLK * D))
#define SLOAD(i, j) do { const bf16_t* kp_ = KPTR(j); const bf16_t* vp_ = VPTR(j); \
    sr_[i].vs0 = ld8(vp_ + sr * D + sc); sr_[i].vs1 = ld8(vp_ + (32 + sr) * D + sc); \
    sr_[i].ks0 = ld8(kp_ + sr * D + sc); sr_[i].ks1 = ld8(kp_ + (32 + sr) * D + sc); } while (0)
#define SWRITE(b, i) do { *(bf16x8*)(V_lds + (b) * SHM_V + vst0) = sr_[i].vs0;          \
    *(bf16x8*)(V_lds + (b) * SHM_V + vst1) = sr_[i].vs1; int kc = sc * 2;               \
    *(bf16x8*)(K_lds + (b) * SHM_K + KSWZ(sr, kc)) = sr_[i].ks0;                       \
    *(bf16x8*)(K_lds + (b) * SHM_K + KSWZ(32 + sr, kc)) = sr_[i].ks1; } while (0)
#define SWAIT() asm volatile("s_waitcnt vmcnt(4)" ::: "memory")
#define RESC(a) do { if (__any((a) < 1.f)) { if (hi == 0) al_l[r32] = (a); asm volatile("s_waitcnt lgkmcnt(0)" ::: "memory"); \
    _Pragma("unroll") for (int d = 0; d < 4; ++d) _Pragma("unroll") for (int r = 0; r < 16; ++r) o[d][r] *= al_l[crow(r, hi)]; } } while (0)
#define NBMASK(P0, P1, j) do { if (NB && (j) >= 4) { const int kr_ = nb_krlo + (j) - 4; \
    if ((unsigned)(kr_ - nrs) >= 8u) { _Pragma("unroll") for (int r = 0; r < 16; ++r) { P0[r] = -1e30f; P1[r] = -1e30f; } } \
    else { const float* tb_ = btab + (kr_ - nq_r + 7) * 31; const int kb_ = 4 * hi - ncs; \
      _Pragma("unroll") for (int r = 0; r < 16; ++r) { const int c0_ = (r & 3) + 8 * (r >> 2); \
        P0[r] = ((unsigned)(kb_ + c0_) < 16u) ? P0[r] + tb_[c0_] : -1e30f; \
        P1[r] = ((unsigned)(kb_ + c0_ + 32) < 16u) ? P1[r] + tb_[c0_ + 32] : -1e30f; } } } } while (0)
  f32x16 pA0, pA1, pB0, pB1; float mnA, mnB, alA, alB; bf16x8 pa0, pa1, pa2, pa3;
  constexpr int SE = 0, SO = 1;
  SLOAD(SE, 0); asm volatile("s_waitcnt vmcnt(0)" ::: "memory"); SWRITE(0, SE); __syncthreads();
  qkt(pA0, pA1, K_lds, qr, r32, hi); partialSM(pA0, pA1, m_reg, mnA, alA);
  SLOAD(SO, 1); if (2 < NT) SLOAD(SE, 2);
  SWAIT(); SWRITE(1, SO); __syncthreads();
  for (int j = 1; j + 1 < NT; j += 2) {
    SBAR(); qkt(pB0, pB1, K_lds + SHM_K, qr, r32, hi);
    finishSM(pA0, pA1, alA, l_reg, pa0, pa1, pa2, pa3); SBAR();
    SLOAD(SO, j + 2); SBAR();
    pv_d0(o, vb0, pa0, pa1, pa2, pa3); NBMASK(pB0, pB1, j); partialSM(pB0, pB1, m_reg, mnB, alB);
    __syncthreads(); SWAIT(); SWRITE(0, SE);
    RESC(alB); __syncthreads();
    SBAR(); qkt(pA0, pA1, K_lds, qr, r32, hi);
    finishSM(pB0, pB1, alB, l_reg, pa0, pa1, pa2, pa3); SBAR();
    if (j + 3 < NT) SLOAD(SE, j + 3); SBAR();
    pv_d0(o, vb0 + SHM_V, pa0, pa1, pa2, pa3); NBMASK(pA0, pA1, j + 1); partialSM(pA0, pA1, m_reg, mnA, alA);
    __syncthreads(); SWAIT(); SWRITE(1, SO);
    RESC(alA); __syncthreads();
  }
  SBAR(); qkt(pB0, pB1, K_lds + SHM_K, qr, r32, hi);
  finishSM(pA0, pA1, alA, l_reg, pa0, pa1, pa2, pa3); SBAR();
  pv_d0(o, vb0, pa0, pa1, pa2, pa3); NBMASK(pB0, pB1, NT - 1); partialSM(pB0, pB1, m_reg, mnB, alB);
  __syncthreads(); RESC(alB);
  finishSM(pB0, pB1, alB, l_reg, pa0, pa1, pa2, pa3); SBAR();
  pv_d0(o, vb0 + SHM_V, pa0, pa1, pa2, pa3);
  if (hi == 0) li_l[r32] = l_reg; asm volatile("s_waitcnt lgkmcnt(0)" ::: "memory");
  float rli[16];
#pragma unroll
  for (int r = 0; r < 16; ++r) rli[r] = __builtin_amdgcn_rcpf(li_l[crow(r, hi)]);
  char* ost = lds + OST_OFF + wid * OST_WAVE;
#pragma unroll
  for (int r = 0; r < 16; ++r) { const int orow = crow(r, hi);
#pragma unroll
    for (int d0 = 0; d0 < 4; ++d0) { const float v = o[d0][r] * rli[r]; *(bf16_t*)(ost + orow * 272 + (d0 * 32 + r32) * 2) = (bf16_t)(cvtpk(v, v) & 0xffffu); } }
  asm volatile("s_waitcnt lgkmcnt(0)" ::: "memory");
  bf16_t* Ow = Ob + (size_t)(wid * QBLK) * DM;
#pragma unroll
  for (int i = 0; i < 8; ++i) { const int row = (lane >> 4) + 4 * i, ch = lane & 15;
    const u32x4 w = *(const u32x4*)(ost + row * 272 + ch * 16);
    *(u32x4*)(Ow + (size_t)row * DM + ch * 8) = w; }
#undef KPTR
#undef VPTR
#undef SLOAD
#undef SWRITE
#undef SWAIT
#undef RESC
#undef NBMASK
}
}

__device__ __forceinline__ unsigned f2bf(float f) { unsigned u = __builtin_bit_cast(unsigned, f); return (u + 0x7fffu + ((u >> 16) & 1u)) >> 16; }
__device__ __forceinline__ unsigned pk2(float lo, float hi) { return f2bf(lo) | (f2bf(hi) << 16); }
#define LDS_WAIT() asm volatile("s_waitcnt lgkmcnt(0)" ::: "memory")
template <bool UPMAP> __device__ __forceinline__ void transpose_item(const float* __restrict__ W, int K, int N, bf16_t* __restrict__ WT, LAS float* scr, int item, int lane) {
    const int nblk = N / 32, kb = item / nblk, nb = item % nblk, k0 = 64 * kb, n0 = 32 * nb;
    const int d0 = UPMAP ? (n0 < DFF ? (n0 >> 7) * 256 + (n0 & 127) : ((n0 - DFF) >> 7) * 256 + 128 + ((n0 - DFF) & 127)) : n0;
    {
        const int r8 = lane >> 3, c4 = lane & 7;
        f32x4 v[8];
#pragma unroll
        for (int g = 0; g < 8; ++g) v[g] = *(const f32x4*)(W + (size_t)(k0 + 8 * g + r8) * N + n0 + 4 * c4);
#pragma unroll
        for (int g = 0; g < 8; ++g) { LAS float* d = scr + (8 * g + r8) * 33 + 4 * c4; d[0] = v[g][0]; d[1] = v[g][1]; d[2] = v[g][2]; d[3] = v[g][3]; }
    }
    LDS_WAIT(); asm volatile("" ::: "memory");
    const int c = lane & 7;
#pragma unroll
    for (int j = 0; j < 4; ++j) { const int n = (lane >> 3) + 8 * j; const LAS float* s = scr + (8 * c) * 33 + n;
        u32x4 o; o.x = pk2(s[0 * 33], s[1 * 33]); o.y = pk2(s[2 * 33], s[3 * 33]); o.z = pk2(s[4 * 33], s[5 * 33]); o.w = pk2(s[6 * 33], s[7 * 33]);
        *(u32x4*)(WT + (size_t)(d0 + n) * K + k0 + 8 * c) = o; }
    LDS_WAIT(); asm volatile("" ::: "memory");
}

struct Args { const float* in[23]; float* out; unsigned char* ws; int ph_lo, ph_hi; };

__global__ void __launch_bounds__(512, 2) mk_fwd(Args args) {
    extern __shared__ __attribute__((aligned(16))) unsigned char lds[];
    cg::grid_group grid = cg::this_grid();
    const int G = gridDim.x, bx = blockIdx.x, NGW = G * 8;
    const int wave_s = __builtin_amdgcn_readfirstlane((int)threadIdx.x >> 6);
#define PHASE_IDS const int tid = tid_of(wave_s); const int lane = tid & 63, wave = wave_s; \
    const int gw = bx * 8 + wave, gwi = wave * G + bx; (void)lane; (void)gw; (void)gwi; (void)tid;
#define ws (args.ws)
#define x_prompt (args.in[0])
#define x_sample (args.in[1])
#define cvec (args.in[2])
#define cache_a_k (args.in[3])
#define cache_a_v (args.in[4])
#define cache_b_k (args.in[5])
#define cache_b_v (args.in[6])
#define c_ctx (args.in[7])
#define w_mod (args.in[8])
#define b_mod (args.in[9])
#define g_attn_pre (args.in[10])
#define g_attn_post (args.in[11])
#define g_ffn_pre (args.in[12])
#define g_ffn_post (args.in[13])
#define w_in (args.in[14])
#define rpb (args.in[15])
#define g_qnorm (args.in[16])
#define g_knorm (args.in[17])
#define w_out (args.in[18])
#define w_up (args.in[19])
#define conv_w (args.in[20])
#define conv_b (args.in[21])
#define w_down (args.in[22])
#define Y_ (args.out)
#define st_ak (args.out + (size_t)MTOK * DM)
#define st_av (args.out + (size_t)MTOK * DM + (size_t)32 * 8 * 256 * 128)
#define st_bk (args.out + (size_t)MTOK * DM + (size_t)2 * 32 * 8 * 256 * 128)
#define st_bv (args.out + (size_t)MTOK * DM + (size_t)2 * 32 * 8 * 256 * 128 + (size_t)32 * 2 * 256 * 128)
#define MOD ((float*)(ws + WS_MOD))
#define MODP ((float*)(ws + WS_MODP))
#define WIN ((bf16_t*)(ws + WS_WIN))
#define WOUT ((bf16_t*)(ws + WS_WOUT))
#define WUP ((bf16_t*)(ws + WS_WUP))
#define WDN ((bf16_t*)(ws + WS_WDN))
#define XN ((bf16_t*)(ws + WS_XN))
#define CAK ((bf16_t*)(ws + WS_CAK))
#define CAV ((bf16_t*)(ws + WS_CAV))
#define CBK ((bf16_t*)(ws + WS_CBK))
#define CBV ((bf16_t*)(ws + WS_CBV))
#define QA ((bf16_t*)(ws + WS_QA))
#define KA ((bf16_t*)(ws + WS_KA))
#define VA ((bf16_t*)(ws + WS_VA))
#define QB ((bf16_t*)(ws + WS_QB))
#define KB ((bf16_t*)(ws + WS_KB))
#define VB ((bf16_t*)(ws + WS_VB))
#define OB ((bf16_t*)(ws + WS_O))
#define P1 ((bf16_t*)(ws + WS_P1))
#define P2 ((bf16_t*)(ws + WS_P2))
#define ACT ((bf16_t*)(ws + WS_ACT))
#define HBUF ((float*)(ws + WS_U))
#define X1B ((bf16_t*)(ws + WS_X1))
    LAS unsigned char* ldsl = (LAS unsigned char*)lds;

    const int lo = args.ph_lo, hi = args.ph_hi;
#ifndef PH_MASK
#define PH_MASK 0xFFF
#endif
#define IN(k) (((PH_MASK >> (k)) & 1) && lo <= (k) && (k) < hi)
    { const int t0 = tid_of(wave_s); if (t0 < 16) ((volatile LAS unsigned*)(ldsl + MISC_OFF))[t0] = 0u; }
    __syncthreads();
    const XcdBarrier xbar = xcd_barrier_post((unsigned*)(ws + WS_CTL), (volatile LAS unsigned*)(ldsl + MISC_OFF), wave_s);
#define SEAM(k) do { if (IN(k) && IN((k) + 1)) { if ((k) == 0) grid.sync(); else xcd_barrier(xbar, wave_s); } } while (0)

    if (IN(0)) {
        PHASE_IDS
        LAS float* cs = (LAS float*)ldsl;
        for (int idx = tid; idx < 9 * 2048; idx += 512) { const int j = idx >> 11, k = idx & 2047; const float c = (j == 0) ? c_ctx[k] : cvec[(j - 1) * 2048 + k];
            cs[k * 9 + j] = c / (1.f + __expf(-c)); }
        __syncthreads();
        for (int ch = bx; ch < 256; ch += G) {
            const int vc = (ch & 7) * 32 + (ch >> 3), rsub = lane / 12, c4 = lane - 12 * rsub;
            f32x4 acc[9];
#pragma unroll
            for (int j = 0; j < 9; ++j) acc[j] = (f32x4){0.f, 0.f, 0.f, 0.f};
            if (rsub < 5) {
                const float* wp = w_mod + (size_t)(wave * 256 + rsub) * NMOD + vc * 48 + 4 * c4;
                const LAS float* sp = cs + (wave * 256 + rsub) * 9;
#pragma unroll 8
                for (int it = 0; it < 51; ++it) {
                    const f32x4 w = *(const f32x4*)(wp + (size_t)(5 * it) * NMOD);
                    const LAS float* s2 = sp + 45 * it;
#pragma unroll
                    for (int j = 0; j < 9; ++j) acc[j] += w * s2[j];
                }
                if (rsub == 0) {
                    const f32x4 w = *(const f32x4*)(wp + (size_t)255 * NMOD);
                    const LAS float* s2 = sp + 9 * 255;
#pragma unroll
                    for (int j = 0; j < 9; ++j) acc[j] += w * s2[j];
                }
            }
            __syncthreads();
            LAS float* red = (LAS float*)ldsl;
#pragma unroll
            for (int j = 0; j < 9; ++j) *(LAS f32x4*)(red + tid * 36 + 4 * j) = acc[j];
            __syncthreads();
            if (tid < 432) { const int j = tid / 48, col = tid - 48 * j, cc = col >> 2, e = col & 3;
                float sum = b_mod[vc * 48 + col];
#pragma unroll
                for (int w = 0; w < 8; ++w)
#pragma unroll
                    for (int r5 = 0; r5 < 5; ++r5) sum += red[(w * 64 + r5 * 12 + cc) * 36 + 4 * j + e];
                MOD[(size_t)j * NMOD + vc * 48 + col] = sum; }
            __syncthreads();
            if (ch + G < 256) {
                for (int idx = tid; idx < 9 * 2048; idx += 512) { const int j = idx >> 11, k = idx & 2047; const float c = (j == 0) ? c_ctx[k] : cvec[(j - 1) * 2048 + k];
                    cs[k * 9 + j] = c / (1.f + __expf(-c)); }
                __syncthreads();
            }
        }
        LAS float* scr = (LAS float*)(ldsl + wave * 8448);
        constexpr int I_IN = 32 * 144, I_OUT = 32 * 64;
        for (int it = gwi; it < I_IN + I_OUT; it += NGW) {
            if (it < I_IN) transpose_item<false>(w_in, DM, NIN, WIN, scr, it, lane);
            else transpose_item<false>(w_out, DM, DM, WOUT, scr, it - I_IN, lane);
        }
        {
            constexpr int NA8 = 8 * 8 * 256 * 128 / 8, NB8 = 8 * 2 * 256 * 128 / 8;
            for (int i = bx * 512 + tid; i < 2 * NA8 + 2 * NB8; i += G * 512) {
                const float* src; bf16_t* dst; int j = i;
                if (j < NA8) { src = cache_a_k; dst = CAK; } else if ((j -= NA8) < NA8) { src = cache_a_v; dst = CAV; }
                else if ((j -= NA8) < NB8) { src = cache_b_k; dst = CBK; } else { j -= NB8; src = cache_b_v; dst = CBV; }
                const f32x4 a = *(const f32x4*)(src + (size_t)j * 8), b = *(const f32x4*)(src + (size_t)j * 8 + 4);
                u32x4 w; w.x = cvt_pk_bf16(a[0], a[1]); w.y = cvt_pk_bf16(a[2], a[3]); w.z = cvt_pk_bf16(b[0], b[1]); w.w = cvt_pk_bf16(b[2], b[3]);
                *(u32x4*)(dst + (size_t)j * 8) = w;
            }
        }
    }
    SEAM(0);
    if (IN(2)) {
        PHASE_IDS
        for (int m = 2 * gw; m < MTOK; m += 2 * NGW) {
            const float* xr = (m < NCTX) ? x_prompt + (size_t)m * DM : x_sample + (size_t)(m - NCTX) * DM;
            const float* md = MOD + (size_t)((m < NCTX) ? 0 : 1 + ((m - NCTX) >> 10)) * NMOD;
            f32x4 v[2][4][2]; float ss[2] = {0.f, 0.f};
#pragma unroll
            for (int r2 = 0; r2 < 2; ++r2)
#pragma unroll
                for (int i = 0; i < 4; ++i) { v[r2][i][0] = *(const f32x4*)(xr + (size_t)r2 * DM + 8 * lane + 512 * i); v[r2][i][1] = *(const f32x4*)(xr + (size_t)r2 * DM + 8 * lane + 512 * i + 4); }
#pragma unroll
            for (int r2 = 0; r2 < 2; ++r2)
#pragma unroll
                for (int i = 0; i < 4; ++i)
#pragma unroll
                    for (int h2 = 0; h2 < 2; ++h2) { const f32x4 t = v[r2][i][h2]; ss[r2] += (t[0] * t[0] + t[1] * t[1]) + (t[2] * t[2] + t[3] * t[3]); }
            const float rstd0 = rsqrtf(wave_sum(ss[0]) * (1.f / DM) + EPS), rstd1 = rsqrtf(wave_sum(ss[1]) * (1.f / DM) + EPS);
            bf16_t* orow = XN + (size_t)m * DM;
#pragma unroll
            for (int i = 0; i < 4; ++i) { const int c = 8 * lane + 512 * i;
                f32x4 r0[2], r1[2];
#pragma unroll
                for (int h2 = 0; h2 < 2; ++h2) {
                    const f32x4 g = *(const f32x4*)(g_attn_pre + c + 4 * h2), sh = *(const f32x4*)(md + c + 4 * h2), sc = *(const f32x4*)(md + 2048 + c + 4 * h2);
                    const f32x4 gs = g * (sc + 1.f);
                    r0[h2] = v[0][i][h2] * rstd0 * gs + sh; r1[h2] = v[1][i][h2] * rstd1 * gs + sh; }
                u32x4 w0, w1;
                w0.x = cvt_pk_bf16(r0[0][0], r0[0][1]); w0.y = cvt_pk_bf16(r0[0][2], r0[0][3]); w0.z = cvt_pk_bf16(r0[1][0], r0[1][1]); w0.w = cvt_pk_bf16(r0[1][2], r0[1][3]);
                w1.x = cvt_pk_bf16(r1[0][0], r1[0][1]); w1.y = cvt_pk_bf16(r1[0][2], r1[0][3]); w1.z = cvt_pk_bf16(r1[1][0], r1[1][1]); w1.w = cvt_pk_bf16(r1[1][2], r1[1][3]);
                *(u32x4*)(orow + c) = w0; *(u32x4*)(orow + DM + c) = w1; }
        }
    }
    SEAM(2);
    if (IN(3)) {
        pg8::Gemm g{XN, WIN, MTOK, NIN, DM}; pg8::StaticOrder S; S.init(MTOK, NIN, G, bx);
        pg8::EpiQKV E{QA, KA, VA, QB, KB, VB, st_ak, st_av, st_bv};
        const int hb = G >> 1;
        if (bx >= hb) {
            PHASE_IDS
            LAS float* scr = (LAS float*)(ldsl + wave * 8448);
            constexpr int I_UP = 32 * 352, I_DN = 88 * 64;
            for (int it = wave * (G - hb) + (bx - hb); it < I_UP + I_DN; it += 8 * (G - hb)) {
                if (it < I_UP) transpose_item<true>(w_up, DM, NUP, WUP, scr, it, lane);
                else transpose_item<false>(w_down, DFF, DM, WDN, scr, it - I_UP, lane);
            }
            __syncthreads();
        }
        pg8::gemm_phase<pg8::EpiQKV, pg8::StaticOrder, true>(ldsl, g, S, E, wave_s);
    }
    SEAM(3);
    if (IN(4)) {
        PHASE_IDS
        const int vs = lane >> 3, part = lane & 7, hsel = part >> 2;
        const int ib = 16 * (part & 1);
        const float sgn = (part & 2) ? 1.f : -1.f;
        constexpr int NIQ = MTOK * 8 / 8, NIK = MTOK * 2 / 8;
        for (int itv = NIQ + gw; itv < NIQ + NIK; itv += NGW) {
            const bool isq = itv < NIQ; const int H = isq ? 8 : 2;
            const int vv = (isq ? itv : itv - NIQ) * 8 + vs;
            bf16_t* p = (isq ? QB : KB) + (size_t)vv * 128 + 16 * part;
            const float* gp = (isq ? g_qnorm : g_knorm) + 16 * part;
            const u32x4 w0 = *(const u32x4*)p, w1 = *(const u32x4*)(p + 8);
            float e[16];
#pragma unroll
            for (int q = 0; q < 4; ++q) { e[2 * q] = bf_lo(w0[q]); e[2 * q + 1] = bf_hi(w0[q]); e[8 + 2 * q] = bf_lo(w1[q]); e[8 + 2 * q + 1] = bf_hi(w1[q]); }
            float ss = 0.f;
#pragma unroll
            for (int j = 0; j < 16; ++j) ss += e[j] * e[j];
            ss += __shfl_xor(ss, 1); ss += __shfl_xor(ss, 2); ss += __shfl_xor(ss, 4);
            const float rstd = rsqrtf(ss * (1.f / 128.f) + EPS);
#pragma unroll
            for (int q = 0; q < 4; ++q) { const f32x4 g = *(const f32x4*)(gp + 4 * q);
#pragma unroll
                for (int t = 0; t < 4; ++t) e[4 * q + t] *= rstd * g[t]; }
            const int nctxv = NCTX * H;
            if (vv >= nctxv) {
                const int t = (vv - nctxv) & 1023; const float pos = (float)(hsel ? (t & 63) : (t >> 6));
#pragma unroll
                for (int j = 0; j < 16; ++j) {
                    const float other = __shfl_xor(e[j], 2);
                    float rev = pos * (exp2f(-(float)(ib + j) * (13.287712379549449f / 32.f)) * 0.15915494309189535f); rev -= floorf(rev);
                    const float sn = __builtin_amdgcn_sinf(rev), cn = __builtin_amdgcn_cosf(rev);
                    e[j] = e[j] * cn + sgn * other * sn;
                }
            } else if (!isq) {
                float* sp = st_bk + (size_t)vv * 128 + 16 * part;
#pragma unroll
                for (int q = 0; q < 4; ++q) *(f32x4*)(sp + 4 * q) = (f32x4){e[4 * q], e[4 * q + 1], e[4 * q + 2], e[4 * q + 3]};
            }
            u32x4 o0, o1;
#pragma unroll
            for (int q = 0; q < 4; ++q) { o0[q] = cvt_pk_bf16(e[2 * q], e[2 * q + 1]); o1[q] = cvt_pk_bf16(e[8 + 2 * q], e[8 + 2 * q + 1]); }
            *(u32x4*)p = o0; *(u32x4*)(p + 8) = o1;
        }
    }
    SEAM(4);
    if (IN(5)) {
        char* al = (char*)lds;
#ifndef AT_MASK
#define AT_MASK 15
#endif
        if (AT_MASK & 1) for (int u0 = bx; u0 < 256; u0 += G) { const int u = (G == 256) ? ((u0 & 7) * 32 + (u0 >> 3)) : u0;
                const int b = u >> 3, h = u & 7; const size_t off = ((size_t)(b * 8 + h) * 256) * 128;
                att::attn_body<false>(QA + off, KA + off, VA + off, 4, KA + off, VA + off, 4, OB + (size_t)(b * 256) * DM + h * 128, al, 0, 0, wave_s);
                __syncthreads();
        }
        if (AT_MASK & 2) for (int u0 = bx; u0 < 256; u0 += G) { const int u = (G == 256) ? ((u0 & 7) * 32 + (u0 >> 3)) : u0;
                const int b = u >> 3, qh = u & 7, kvh = qh >> 2; const size_t qoff = ((size_t)(b * 8 + qh) * 256) * 128, koff = ((size_t)(b * 2 + kvh) * 256) * 128;
                att::attn_body<false, 1>(QB + qoff, KB + koff, VB + koff, 4, KB + koff, VB + koff, 4, OB + (size_t)(b * 256) * DM + 1024 + qh * 128, al, 0, 0, wave_s, g_qnorm, 0);
                __syncthreads();
        }
        if (AT_MASK & 4) for (int u0 = bx; u0 < 256; u0 += G) { const int u = (G == 256) ? ((u0 & 7) * 32 + (u0 >> 3)) : u0;
                const int b = u >> 5, qh = (u >> 2) & 7, qb = u & 3, kvh = qh >> 2;
                const size_t qoff = (size_t)NCTX * 8 * 128 + ((size_t)(b * 8 + qh) * 1024 + qb * 256) * 128;
                const size_t coff = ((size_t)(b * 2 + kvh) * 256) * 128, koff = (size_t)NCTX * 2 * 128 + ((size_t)(b * 2 + kvh) * 1024) * 128;
                att::attn_body<false, 2>(QB + qoff, CBK + coff, CBV + coff, 4, KB + koff, VB + koff, 20, OB + (size_t)(NCTX + b * 1024 + qb * 256) * DM + 1024 + qh * 128, al, 0, 0, wave_s, g_qnorm, qb * 256);
                __syncthreads();
        }
        if (AT_MASK & 8) for (int u0 = bx; u0 < 256; u0 += G) { const int u = (G == 256) ? ((u0 & 7) * 32 + (u0 >> 3)) : u0;
                const int b = u >> 5, h = (u >> 2) & 7, qb = u & 3;
                PHASE_IDS
                float* bt = (float*)(al + att::BIAS_OFF);
                for (int i = tid; i < att::BIAS_FLOATS; i += 512) { const int k = i - 64; bt[i] = (k >= 0 && k < 465) ? rpb[h * 465 + k] * (1.f / att::SCALE) : 0.f; }
                const int krlo = (qb == 0 || qb == 1) ? 0 : (qb == 2 ? 4 : 8), nrows = (qb == 0 || qb == 3) ? 8 : 12;
                const size_t qoff = (size_t)NCTX * 8 * 128 + ((size_t)(b * 8 + h) * 1024 + qb * 256) * 128;
                const size_t coff = ((size_t)(b * 8 + h) * 256) * 128, koff = (size_t)NCTX * 8 * 128 + ((size_t)(b * 8 + h) * 1024 + krlo * 64) * 128;
                att::attn_body<true>(QA + qoff, CAK + coff, CAV + coff, 4, KA + koff, VA + koff, 4 + nrows, OB + (size_t)(NCTX + b * 1024 + qb * 256) * DM + h * 128, al, qb * 4, krlo, wave_s);
                __syncthreads();
        }
    }
    SEAM(5);
    if (IN(6)) {
        pg8::Gemm g{OB, WOUT, MTOK, DM, DM}; pg8::StaticOrder S; S.init(MTOK, DM, G, bx);
        pg8::EpiBf16 E{P1, DM};
        pg8::gemm_phase<pg8::EpiBf16, pg8::StaticOrder, true>(ldsl, g, S, E, wave_s);
    }
    SEAM(6);
    if (IN(7)) {
        PHASE_IDS
        for (int m = 2 * gw; m < MTOK; m += 2 * NGW) {
            const float* xr = (m < NCTX) ? x_prompt + (size_t)m * DM : x_sample + (size_t)(m - NCTX) * DM;
            const float* md = MOD + (size_t)((m < NCTX) ? 0 : 1 + ((m - NCTX) >> 10)) * NMOD;
            const bf16_t* pr = P1 + (size_t)m * DM;
            float v[2][4][8]; float ss[2] = {0.f, 0.f};
            u32x4 pw[2][4];
#pragma unroll
            for (int r2 = 0; r2 < 2; ++r2)
#pragma unroll
                for (int i = 0; i < 4; ++i) pw[r2][i] = *(const u32x4*)(pr + (size_t)r2 * DM + 8 * lane + 512 * i);
#pragma unroll
            for (int r2 = 0; r2 < 2; ++r2)
#pragma unroll
                for (int i = 0; i < 4; ++i)
#pragma unroll
                    for (int q = 0; q < 4; ++q) { const float lo_ = bf_lo(pw[r2][i][q]), hi_ = bf_hi(pw[r2][i][q]); v[r2][i][2 * q] = lo_; v[r2][i][2 * q + 1] = hi_; ss[r2] += lo_ * lo_ + hi_ * hi_; }
            float rstd[2]; rstd[0] = rsqrtf(wave_sum(ss[0]) * (1.f / DM) + EPS); rstd[1] = rsqrtf(wave_sum(ss[1]) * (1.f / DM) + EPS);
            float ss2[2] = {0.f, 0.f};
#pragma unroll
            for (int i = 0; i < 4; ++i) { const int c = 8 * lane + 512 * i;
                float gg[8];
#pragma unroll
                for (int h2 = 0; h2 < 2; ++h2) {
                    const f32x4 g = *(const f32x4*)(g_attn_post + c + 4 * h2), ga = *(const f32x4*)(md + 4096 + c + 4 * h2);
#pragma unroll
                    for (int e = 0; e < 4; ++e) gg[4 * h2 + e] = g[e] * ga[e]; }
#pragma unroll
                for (int r2 = 0; r2 < 2; ++r2) {
                    const f32x4 xa = *(const f32x4*)(xr + (size_t)r2 * DM + c), xb = *(const f32x4*)(xr + (size_t)r2 * DM + c + 4);
                    float r[8];
#pragma unroll
                    for (int e = 0; e < 8; ++e) { r[e] = (e < 4 ? xa[e & 3] : xb[e & 3]) + gg[e] * (v[r2][i][e] * rstd[r2]); v[r2][i][e] = r[e]; ss2[r2] += r[e] * r[e]; }
                    u32x4 w; w.x = cvt_pk_bf16(r[0], r[1]); w.y = cvt_pk_bf16(r[2], r[3]); w.z = cvt_pk_bf16(r[4], r[5]); w.w = cvt_pk_bf16(r[6], r[7]);
                    *(u32x4*)(X1B + (size_t)(m + r2) * DM + c) = w; } }
            float rs2[2]; rs2[0] = rsqrtf(wave_sum(ss2[0]) * (1.f / DM) + EPS); rs2[1] = rsqrtf(wave_sum(ss2[1]) * (1.f / DM) + EPS);
            bf16_t* orow = XN + (size_t)m * DM;
#pragma unroll
            for (int i = 0; i < 4; ++i) { const int c = 8 * lane + 512 * i;
                float gsv[8], shv[8];
#pragma unroll
                for (int h2 = 0; h2 < 2; ++h2) {
                    const f32x4 g = *(const f32x4*)(g_ffn_pre + c + 4 * h2), sh = *(const f32x4*)(md + 6144 + c + 4 * h2), sc = *(const f32x4*)(md + 8192 + c + 4 * h2);
#pragma unroll
                    for (int e = 0; e < 4; ++e) { gsv[4 * h2 + e] = g[e] * (sc[e] + 1.f); shv[4 * h2 + e] = sh[e]; } }
#pragma unroll
                for (int r2 = 0; r2 < 2; ++r2) {
                    float r[8];
#pragma unroll
                    for (int e = 0; e < 8; ++e) r[e] = v[r2][i][e] * rs2[r2] * gsv[e] + shv[e];
                    u32x4 w; w.x = cvt_pk_bf16(r[0], r[1]); w.y = cvt_pk_bf16(r[2], r[3]); w.z = cvt_pk_bf16(r[4], r[5]); w.w = cvt_pk_bf16(r[6], r[7]);
                    *(u32x4*)(orow + (size_t)r2 * DM + c) = w; } }
        }
    }
    SEAM(7);
    if (IN(8)) {
        pg8::Gemm g{XN, WUP, MTOK, NUP, DM}; pg8::StaticOrder S; S.init(MTOK, NUP, G, bx);
        pg8::EpiConv E{ACT, HBUF, conv_w, conv_b, (LAS float*)(ldsl + 131072)};
        pg8::gemm_phase<pg8::EpiConv, pg8::StaticOrder, true>(ldsl, g, S, E, wave_s);
    }
    SEAM(8);
    if (IN(9)) {
        PHASE_IDS
        for (int it = gw; it < 32 * 2 * 22; it += NGW) {
            const int seg = it % 22, side = (it / 22) & 1, lt = it / 44; const int q = lt & 3;
            if ((side == 0 && q == 0) || (side == 1 && q == 3)) continue;
            const int ch = seg * 256 + lane * 4;
            f32x4 r[2];
#pragma unroll
            for (int bj = 0; bj < 2; ++bj) {
                const float* hp = HBUF + (size_t)bj * DFF + ch;
                const f32x4 up = *(const f32x4*)(hp + (size_t)((side ? lt * 4 + 2 : (lt - 1) * 4 + 3) * 2) * DFF);
                const f32x4 cu = *(const f32x4*)(hp + (size_t)((side ? lt * 4 + 3 : lt * 4 + 0) * 2) * DFF);
                const f32x4 dn = *(const f32x4*)(hp + (size_t)((side ? (lt + 1) * 4 + 0 : lt * 4 + 1) * 2) * DFF);
                const f32x4 w0 = *(const f32x4*)(conv_w + bj * DFF + ch), w1 = *(const f32x4*)(conv_w + NUP + bj * DFF + ch), w2 = *(const f32x4*)(conv_w + 2 * NUP + bj * DFF + ch);
                r[bj] = w0 * up + w1 * cu + w2 * dn + *(const f32x4*)(conv_b + bj * DFF + ch);
            }
            float a[4];
#pragma unroll
            for (int e = 0; e < 4; ++e) a[e] = r[1][e] * __builtin_amdgcn_rcpf(1.f + __expf(-r[1][e])) * r[0][e];
            u32x2 ow; ow.x = cvt_pk_bf16(a[0], a[1]); ow.y = cvt_pk_bf16(a[2], a[3]);
            *(u32x2*)(ACT + (size_t)(NCTX + lt * 256 + (side ? 255 : 0)) * DFF + ch) = ow;
        }
    }
    SEAM(9);
    if (IN(10)) {
        PHASE_IDS
        pg8::Gemm g{ACT, WDN, MTOK, DM, DFF}; pg8::StaticOrder S; S.init(MTOK, DM, G, bx);
        pg8::EpiBf16 E{P2, DM};
        pg8::gemm_phase<pg8::EpiBf16, pg8::StaticOrder, true>(ldsl, g, S, E, wave_s);
    }
    SEAM(10);
    if (IN(11)) {
        PHASE_IDS
        for (int m = 2 * gw; m < MTOK; m += 2 * NGW) {
            const float* md = MOD + (size_t)((m < NCTX) ? 0 : 1 + ((m - NCTX) >> 10)) * NMOD;
            const bf16_t* pr = P2 + (size_t)m * DM;
            float v[2][4][8]; float ss[2] = {0.f, 0.f};
            u32x4 pw[2][4];
#pragma unroll
            for (int r2 = 0; r2 < 2; ++r2)
#pragma unroll
                for (int i = 0; i < 4; ++i) pw[r2][i] = *(const u32x4*)(pr + (size_t)r2 * DM + 8 * lane + 512 * i);
#pragma unroll
            for (int r2 = 0; r2 < 2; ++r2)
#pragma unroll
                for (int i = 0; i < 4; ++i)
#pragma unroll
                    for (int q = 0; q < 4; ++q) { const float lo_ = bf_lo(pw[r2][i][q]), hi_ = bf_hi(pw[r2][i][q]); v[r2][i][2 * q] = lo_; v[r2][i][2 * q + 1] = hi_; ss[r2] += lo_ * lo_ + hi_ * hi_; }
            float rstd[2]; rstd[0] = rsqrtf(wave_sum(ss[0]) * (1.f / DM) + EPS); rstd[1] = rsqrtf(wave_sum(ss[1]) * (1.f / DM) + EPS);
#pragma unroll
            for (int i = 0; i < 4; ++i) { const int c = 8 * lane + 512 * i;
#pragma unroll
                for (int h2 = 0; h2 < 2; ++h2) {
                    const f32x4 g = *(const f32x4*)(g_ffn_post + c + 4 * h2), ga = *(const f32x4*)(md + 10240 + c + 4 * h2);
                    const f32x4 gg = g * ga;
#pragma unroll
                    for (int r2 = 0; r2 < 2; ++r2) {
                        const u32x2 xw = *(const u32x2*)(X1B + (size_t)(m + r2) * DM + c + 4 * h2);
                        const float xv[4] = {bf_lo(xw.x), bf_hi(xw.x), bf_lo(xw.y), bf_hi(xw.y)};
                        f32x4 r;
#pragma unroll
                        for (int e = 0; e < 4; ++e) r[e] = xv[e] + gg[e] * (v[r2][i][4 * h2 + e] * rstd[r2]);
                        *(f32x4*)(Y_ + (size_t)(m + r2) * DM + c + 4 * h2) = r; } } }
        }
    }
#undef IN
#undef SEAM
#undef ws
#undef x_prompt
#undef x_sample
#undef cvec
#undef cache_a_k
#undef cache_a_v
#undef cache_b_k
#undef cache_b_v
#undef c_ctx
#undef w_mod
#undef b_mod
#undef g_attn_pre
#undef g_attn_post
#undef g_ffn_pre
#undef g_ffn_post
#undef w_in
#undef rpb
#undef g_qnorm
#undef g_knorm
#undef w_out
#undef w_up
#undef conv_w
#undef conv_b
#undef w_down
#undef Y_
#undef st_ak
#undef st_av
#undef st_bk
#undef st_bv
#undef MOD
#undef MODP
#undef WIN
#undef WOUT
#undef WUP
#undef WDN
#undef XN
#undef CAK
#undef CAV
#undef CBK
#undef CBV
#undef QA
#undef KA
#undef VA
#undef QB
#undef KB
#undef VB
#undef OB
#undef P1
#undef P2
#undef ACT
#undef HBUF
#undef X1B
}

extern "C" void kernel_launch(void* const* d_in, const int* in_sizes, int n_in, void* d_out, int out_size, void* d_ws, size_t ws_size, hipStream_t stream) {
    static int grid = 0;
    if (grid == 0) {
        if (n_in != 23 || ws_size < WS_END) { fprintf(stderr, "kernel_launch: unexpected n_in %d or ws_size %zu (need %zu)\n", n_in, ws_size, (size_t)WS_END); grid = -1; return; }
        int dev = 0, cus = 0, per_cu = 0;
        hipGetDevice(&dev);
        hipDeviceGetAttribute(&cus, hipDeviceAttributeMultiprocessorCount, dev);
        if (hipFuncSetAttribute((const void*)mk_fwd, hipFuncAttributeMaxDynamicSharedMemorySize, LDS_BYTES) != hipSuccess) { fprintf(stderr, "kernel_launch: hipFuncSetAttribute failed\n"); grid = -1; return; }
        if (hipOccupancyMaxActiveBlocksPerMultiprocessor(&per_cu, (const void*)mk_fwd, 512, LDS_BYTES) != hipSuccess || per_cu < 1) { fprintf(stderr, "kernel_launch: occupancy query failed (%d)\n", per_cu); per_cu = 1; }
        (void)hipGetLastError();
        grid = cus * (per_cu > 1 ? 1 : per_cu);
        if (grid > 256) grid = 256;
    }
    if (grid < 0) return;
    if (hipMemsetAsync((char*)d_ws + WS_CTL, 0, CTL_BYTES, stream) != hipSuccess) { fprintf(stderr, "kernel_launch: memset failed\n"); return; }
    Args a{};
    for (int i = 0; i < 23; ++i) a.in[i] = (const float*)d_in[i];
    a.out = (float*)d_out; a.ws = (unsigned char*)d_ws; a.ph_lo = 0; a.ph_hi = 12;
    void* kargs[] = {&a};
    hipError_t e = hipLaunchCooperativeKernel((const void*)mk_fwd, dim3(grid), dim3(512), kargs, LDS_BYTES, stream);
    if (e != hipSuccess) fprintf(stderr, "kernel_launch: cooperative launch failed: %s (grid %d)\n", hipGetErrorString(e), grid);
}
```

```cpp
#include <hip/hip_runtime.h>
#include <hip/hip_cooperative_groups.h>
#include <cstdio>
#include <cstdint>
namespace cg = cooperative_groups;

#define LAS __attribute__((address_space(3)))
typedef unsigned short bf16_t;
typedef short bf16x8 __attribute__((ext_vector_type(8)));
typedef short s16x4 __attribute__((ext_vector_type(4)));
typedef float f32x4 __attribute__((ext_vector_type(4)));
typedef float f32x16 __attribute__((ext_vector_type(16)));
typedef unsigned u32x4 __attribute__((ext_vector_type(4)));
typedef unsigned u32x2 __attribute__((ext_vector_type(2)));

constexpr int DM = 2048, MTOK = 16384, NCTX = 8192, DFF = 5632, NUP = 11264, NIN = 4608, NMOD = 12288;
constexpr float EPS = 1e-6f;
constexpr int CHROWS = 4096;

constexpr size_t MiB = 1u << 20;
constexpr size_t WS_MOD = 0, WS_WDN = 1 * MiB, WS_XN = 23 * MiB, WS_WIN = 87 * MiB, WS_WOUT = 105 * MiB, WS_WUP = 113 * MiB;
constexpr size_t WS_CAK = 157 * MiB, WS_CAV = 161 * MiB, WS_CBK = 165 * MiB, WS_CBV = 166 * MiB;
constexpr size_t WS_QA = 167 * MiB, WS_KA = 199 * MiB, WS_VA = 231 * MiB, WS_QB = 263 * MiB, WS_KB = 295 * MiB, WS_VB = 303 * MiB;
constexpr size_t WS_O = 311 * MiB, WS_MODP = 311 * MiB;
constexpr size_t WS_P1 = 167 * MiB;
constexpr size_t WS_ACT = 157 * MiB, WS_U = 333 * MiB, WS_X1 = 341 * MiB;
constexpr size_t WS_P2 = 23 * MiB;
constexpr size_t WS_END = 421 * MiB;

constexpr int LDS_BYTES = 147456, MISC_OFF = 147200;
constexpr size_t WS_CTL = 512 * 1024, CTL_BYTES = 16384;

__device__ __forceinline__ unsigned cvt_pk_bf16(float lo, float hi) { unsigned r; asm volatile("v_cvt_pk_bf16_f32 %0, %1, %2" : "=v"(r) : "v"(lo), "v"(hi)); return r; }
__device__ __forceinline__ float bf_lo(unsigned w) { return __uint_as_float(w << 16); }
__device__ __forceinline__ float bf_hi(unsigned w) { return __uint_as_float(w & 0xffff0000u); }
__device__ __forceinline__ int tid_of(int wave_s) { unsigned z; asm volatile("v_mov_b32 %0, 0" : "=v"(z) :: "memory");
    return wave_s * 64 + (int)__builtin_amdgcn_mbcnt_hi(~0u, __builtin_amdgcn_mbcnt_lo(~0u, z)); }
__device__ __forceinline__ float wave_sum(float v) {
#pragma unroll
    for (int o = 1; o < 64; o <<= 1) v += __shfl_xor(v, o);
    return v;
}


#define XB_TMO      128
#define XB_XCNT(j)  (256  + 64 * (j))
#define XB_XSUB(j)  (1280 + 64 * (j))
#define XB_XGEN(j)  (2304 + 64 * (j))
#define XB_TOP      3328
#define XB_TOPGEN   3392
#define XCD_BAR_WORDS 3456
#define XB_SPIN_CAP (1u << 18)
__device__ __forceinline__ unsigned xb_ld(unsigned* p)              { return __hip_atomic_load(p, __ATOMIC_RELAXED, __HIP_MEMORY_SCOPE_AGENT); }
__device__ __forceinline__ unsigned xb_add(unsigned* p, unsigned v) { return __hip_atomic_fetch_add(p, v, __ATOMIC_RELAXED, __HIP_MEMORY_SCOPE_AGENT); }
__device__ __forceinline__ unsigned xb_xcc_id() { return (unsigned)__builtin_amdgcn_s_getreg((3 << 11) | 20) & 0xFu; }
#define XB_SPIN(cond, bar) do { unsigned _sp = 0; while (cond) { __builtin_amdgcn_s_sleep(1); \
    if ((++_sp & 255u) == 0u) { if (xb_ld(&(bar)[XB_TMO])) break; if (_sp > XB_SPIN_CAP) { atomicAdd(&(bar)[XB_TMO], 1u); break; } } } } while (0)
struct XcdBarrier { unsigned* bar; unsigned x; volatile LAS unsigned* st; };
__device__ __forceinline__ XcdBarrier xcd_barrier_post(unsigned* bar, volatile LAS unsigned* st, int wave_s) {
    XcdBarrier b; b.bar = bar; b.x = xb_xcc_id(); b.st = st;
    if (tid_of(wave_s) == 0) (void)xb_add(&bar[XB_XCNT(b.x)], 1u);
    return b;
}
__device__ __forceinline__ void xcd_barrier_complete(unsigned* bar, unsigned x, unsigned& nloc, unsigned& nx) {
    const unsigned G = gridDim.x * gridDim.y * gridDim.z;
    unsigned sum, cnt, mine, sp = 0u;
    for (;;) {
        sum = 0u; cnt = 0u; mine = 0u;
#pragma unroll
        for (unsigned j = 0; j < 16; ++j) { const unsigned c = xb_ld(&bar[XB_XCNT(j)]); sum += c; cnt += (c > 0u) ? 1u : 0u; mine = (j == x) ? c : mine; }
        if (sum == G) break;
        __builtin_amdgcn_s_sleep(1);
        if ((++sp & 255u) == 0u) { if (xb_ld(&bar[XB_TMO])) break; if (sp > XB_SPIN_CAP) { atomicAdd(&bar[XB_TMO], 1u); break; } }
    }
    nloc = mine > 0u ? mine : 1u; nx = cnt > 0u ? cnt : 1u;
}
__device__ __forceinline__ void xcd_barrier(const XcdBarrier& b, int wave_s) {
    asm volatile("s_waitcnt vmcnt(0)" ::: "memory");
    __syncthreads();
    if (tid_of(wave_s) == 0) {
        unsigned* bar = b.bar;
        __builtin_amdgcn_s_waitcnt(0);
        unsigned nloc = b.st[0], nx = b.st[1];
        if (nloc == 0u) { xcd_barrier_complete(bar, b.x, nloc, nx); b.st[0] = nloc; b.st[1] = nx; }
        const unsigned old = xb_add(&bar[XB_XSUB(b.x)], 1u);
        const unsigned gen = old / nloc;
        if (old + 1u == (gen + 1u) * nloc) {
            __builtin_amdgcn_fence(__ATOMIC_RELEASE, "agent");
            asm volatile("s_waitcnt vmcnt(0)" ::: "memory");
            const unsigned og = xb_add(&bar[XB_TOP], 1u);
            const unsigned tg = og / nx;
            if (og + 1u == (tg + 1u) * nx) xb_add(&bar[XB_TOPGEN], 1u);
            else XB_SPIN(xb_ld(&bar[XB_TOPGEN]) == tg, bar);
            __builtin_amdgcn_fence(__ATOMIC_ACQUIRE, "agent");
            xb_add(&bar[XB_XGEN(b.x)], 1u);
            asm volatile("s_waitcnt vmcnt(0)" ::: "memory");
        } else {
            XB_SPIN(xb_ld(&bar[XB_XGEN(b.x)]) == gen, bar);
            __builtin_amdgcn_fence(__ATOMIC_ACQUIRE, "agent");
            asm volatile("s_waitcnt vmcnt(0)" ::: "memory");
        }
    }
    __syncthreads();
}

namespace pg8 {
constexpr int BM = 256, BK = 64, HALF = 128, HTB = HALF * BK * 2, STAGE_BYTES = 8 * HTB, NXCD = 8, WGM = 8;
__host__ __device__ __forceinline__ int lds_byte(int r, int c) { const int st = (r >> 4) * 2 + (c >> 5), rr = r & 15, cc = c & 31, ob = rr * 64 + cc * 2; return st * 1024 + (ob ^ (((ob >> 9) & 1) << 5)); }
__host__ __device__ __forceinline__ void stage_rc(int b, int& R, int& C) { const int st = b / 1024, sb = b % 1024, swz = sb ^ (((sb >> 9) & 1) << 5); R = (st >> 1) * 16 + swz / 64; C = (st & 1) * 32 + (swz % 64) / 2; }
__host__ __device__ __forceinline__ int perm32(int rho) { const int n = rho >> 4, i = rho & 15; return 8 * (i >> 2) + 4 * n + (i & 3); }

struct Unit { int pm, pn; };
struct Gemm { const bf16_t* A; const bf16_t* Bt; int M, N, K; };

struct StaticOrder {
    int nM, nN, nwg, G, c;
    __host__ __device__ void init(int M, int N, int G_, int c_) { nM = M / BM; nN = N / BM; nwg = nM * nN; G = G_; c = c_; }
    __host__ __device__ bool next(int i, Unit& u) const {
        const long L = (long)i * G + c; if (L >= nwg) return false;
        int wgid = (int)L; { const int q = nwg / NXCD, r = nwg % NXCD, xcd = wgid % NXCD, off = wgid / NXCD; wgid = (xcd < r ? xcd * (q + 1) : r * (q + 1) + (xcd - r) * q) + off; }
        const int nig = WGM * nN, gid = wgid / nig, fm = gid * WGM, gsz = (nM - fm) < WGM ? (nM - fm) : WGM;
        u.pm = fm + ((wgid % nig) % gsz); u.pn = (wgid % nig) / gsz; return true;
    }
    __device__ __forceinline__ void a_ready(const Unit&) const {}
    __device__ __forceinline__ void done(const Unit&) const {}
};

__device__ __forceinline__ u32x4 quad_xpose(u32x4 w, int src4) {
    u32x4 r;
    r.x = (unsigned)__builtin_amdgcn_ds_bpermute(src4, (int)w.x); r.y = (unsigned)__builtin_amdgcn_ds_bpermute(src4, (int)w.y);
    r.z = (unsigned)__builtin_amdgcn_ds_bpermute(src4, (int)w.z); r.w = (unsigned)__builtin_amdgcn_ds_bpermute(src4, (int)w.w);
    return r;
}
struct EpiF32 {
    static constexpr bool PERM = false, AFTER_DRAIN = false;
    float* C; int ldc;
    __device__ __forceinline__ void operator()(const f32x4 (&acc)[2][2][4][2], const Unit& u, int wr, int wc, int fr, int fq) const {
        const int row0 = u.pm * BM + wr * 64 + fr, col0 = u.pn * BM + wc * 32 + 4 * fq;
#pragma unroll
        for (int ai = 0; ai < 2; ++ai)
#pragma unroll
            for (int m = 0; m < 4; ++m) { float* rowp = C + (size_t)(row0 + ai * HALF + m * 16) * ldc + col0;
#pragma unroll
                for (int bj = 0; bj < 2; ++bj)
#pragma unroll
                    for (int n = 0; n < 2; ++n) *(f32x4*)(rowp + bj * HALF + n * 16) = acc[ai][bj][m][n]; }
    }
};
struct EpiBf16 {
    static constexpr bool PERM = true, AFTER_DRAIN = false;
    bf16_t* O; int ldc;
    __device__ __forceinline__ void operator()(const f32x4 (&acc)[2][2][4][2], const Unit& u, int wr, int wc, int fr, int fq) const {
        const int ln = fr + 16 * fq, r4 = ln >> 2, c4 = ln & 3, src4 = 4 * (16 * c4 + r4);
        const int row0 = u.pm * BM + wr * 64 + r4, col0 = u.pn * BM + wc * 32 + 8 * c4;
#pragma unroll
        for (int ai = 0; ai < 2; ++ai)
#pragma unroll
            for (int m = 0; m < 4; ++m) { bf16_t* rowp = O + (size_t)(row0 + ai * HALF + m * 16) * ldc + col0;
#pragma unroll
                for (int bj = 0; bj < 2; ++bj) { const f32x4 v0 = acc[ai][bj][m][0], v1 = acc[ai][bj][m][1];
                    u32x4 w; w.x = cvt_pk_bf16(v0[0], v0[1]); w.y = cvt_pk_bf16(v0[2], v0[3]); w.z = cvt_pk_bf16(v1[0], v1[1]); w.w = cvt_pk_bf16(v1[2], v1[3]);
                    *(u32x4*)(rowp + bj * HALF) = quad_xpose(w, src4); } }
    }
};
struct EpiQKV {
    static constexpr bool PERM = true, AFTER_DRAIN = false;
    bf16_t *QA, *KA, *VA, *QB, *KB, *VB; float *sak, *sav, *sbv;
    __device__ __forceinline__ void operator()(const f32x4 (&acc)[2][2][4][2], const Unit& u, int wr, int wc, int fr, int fq) const {
        const int pn = u.pn, pm = u.pm;
        bf16_t* buf; int H, h0; float* st = nullptr;
        if (pn < 4) { buf = QA; H = 8; h0 = 2 * pn; }
        else if (pn < 8) { buf = KA; H = 8; h0 = 2 * (pn - 4); st = sak; }
        else if (pn < 12) { buf = VA; H = 8; h0 = 2 * (pn - 8); st = sav; }
        else if (pn < 16) { buf = QB; H = 8; h0 = 2 * (pn - 12); }
        else if (pn == 16) { buf = KB; H = 2; h0 = 0; }
        else { buf = VB; H = 2; h0 = 0; st = sbv; }
        const bool ctx = pm < 32;
        int b, t0, L; size_t reg;
        if (ctx) { b = pm; t0 = 0; L = 256; reg = 0; } else { b = (pm - 32) >> 2; t0 = ((pm - 32) & 3) * 256; L = 1024; reg = (size_t)NCTX * H * 128; }
#pragma unroll
        for (int bj = 0; bj < 2; ++bj) {
            const int h = h0 + bj;
            bf16_t* base = buf + reg + ((size_t)(b * H + h) * L + t0) * 128 + wc * 32 + 8 * fq;
            float* sbase = st + ((size_t)(b * H + h) * 256) * 128 + wc * 32 + 8 * fq;
#pragma unroll
            for (int ai = 0; ai < 2; ++ai)
#pragma unroll
                for (int m = 0; m < 4; ++m) {
                    const int t = ai * HALF + wr * 64 + m * 16 + fr;
                    const f32x4 v0 = acc[ai][bj][m][0], v1 = acc[ai][bj][m][1];
                    u32x4 w; w.x = cvt_pk_bf16(v0[0], v0[1]); w.y = cvt_pk_bf16(v0[2], v0[3]); w.z = cvt_pk_bf16(v1[0], v1[1]); w.w = cvt_pk_bf16(v1[2], v1[3]);
                    *(u32x4*)(base + (size_t)t * 128) = w;
                    if (ctx && st) { *(f32x4*)(sbase + (size_t)t * 128) = v0; *(f32x4*)(sbase + (size_t)t * 128 + 4) = v1; }
                    asm volatile("" ::: "memory");
                }
        }
    }
};


template <int CTRL> __device__ __forceinline__ float dppf(float old, float src) {
    return __builtin_bit_cast(float, __builtin_amdgcn_update_dpp(__builtin_bit_cast(int, old), __builtin_bit_cast(int, src), CTRL, 0xF, 0xF, false));
}
struct EpiConv {
    static constexpr bool PERM = true, AFTER_DRAIN = false;
    bf16_t* ACT; float* HB; const float* cw; const float* cb; LAS float* H;
    __device__ __forceinline__ void operator()(const f32x4 (&acc)[2][2][4][2], const Unit& u, int wr, int wc, int fr, int fq) const {
        const int pm = u.pm, pn = u.pn;
        const int cl = 32 * wc + 8 * fq, j0 = 128 * pn + cl;
#pragma unroll
        for (int ai = 0; ai < 2; ++ai) { const int blk = ai * 2 + wr;
            if (fr == 0) {
#pragma unroll
                for (int bj = 0; bj < 2; ++bj)
#pragma unroll
                    for (int n = 0; n < 2; ++n) *(LAS f32x4*)(H + ((blk * 2 + 0) * 2 + bj) * 128 + cl + 4 * n) = acc[ai][bj][0][n]; }
            if (fr == 15) {
#pragma unroll
                for (int bj = 0; bj < 2; ++bj)
#pragma unroll
                    for (int n = 0; n < 2; ++n) *(LAS f32x4*)(H + ((blk * 2 + 1) * 2 + bj) * 128 + cl + 4 * n) = acc[ai][bj][3][n]; } }
        if (pm >= 32) { const int lt = pm - 32;
            if (wr == 0 && fr < 2) {
#pragma unroll
                for (int bj = 0; bj < 2; ++bj)
#pragma unroll
                    for (int n = 0; n < 2; ++n) *(f32x4*)(HB + ((size_t)((lt * 4 + fr) * 2 + bj)) * DFF + j0 + 4 * n) = acc[0][bj][0][n]; }
            if (wr == 1 && fr >= 14) {
#pragma unroll
                for (int bj = 0; bj < 2; ++bj)
#pragma unroll
                    for (int n = 0; n < 2; ++n) *(f32x4*)(HB + ((size_t)((lt * 4 + fr - 12) * 2 + bj)) * DFF + j0 + 4 * n) = acc[1][bj][3][n]; } }
        asm volatile("s_waitcnt lgkmcnt(0)" ::: "memory"); __builtin_amdgcn_s_barrier(); asm volatile("" ::: "memory");
        u32x2 keep[2][4];
        const int ln = fr + 16 * fq, r4 = ln >> 2, c4 = ln & 3, src4 = 4 * (16 * c4 + r4);
#pragma unroll
        for (int n = 0; n < 2; ++n) {
            f32x4 w[3][2], bs[2];
#pragma unroll
            for (int bj = 0; bj < 2; ++bj) { bs[bj] = *(const f32x4*)(cb + bj * DFF + j0 + 4 * n);
#pragma unroll
                for (int k = 0; k < 3; ++k) w[k][bj] = *(const f32x4*)(cw + (size_t)k * NUP + bj * DFF + j0 + 4 * n); }
#pragma unroll
            for (int ai = 0; ai < 2; ++ai) { const int blk = ai * 2 + wr;
                f32x4 hu[2], hd[2];
#pragma unroll
                for (int bj = 0; bj < 2; ++bj) {
                    hu[bj] = (blk > 0) ? *(const LAS f32x4*)(H + (((blk - 1) * 2 + 1) * 2 + bj) * 128 + cl + 4 * n) : (f32x4){0.f, 0.f, 0.f, 0.f};
                    hd[bj] = (blk < 3) ? *(const LAS f32x4*)(H + (((blk + 1) * 2 + 0) * 2 + bj) * 128 + cl + 4 * n) : (f32x4){0.f, 0.f, 0.f, 0.f}; }
#pragma unroll
                for (int m = 0; m < 4; ++m) {
                    float a[4];
#pragma unroll
                    for (int e = 0; e < 4; ++e) {
                        float r[2];
#pragma unroll
                        for (int bj = 0; bj < 2; ++bj) {
                            const float cur = acc[ai][bj][m][n][e];
                            const float upT = (m == 0) ? hu[bj][e] : dppf<0x121>(0.f, acc[ai][bj][m == 0 ? 0 : m - 1][n][e]);
                            const float up = dppf<0x111>(upT, cur);
                            const float dnT = (m == 3) ? hd[bj][e] : dppf<0x12F>(0.f, acc[ai][bj][m == 3 ? 3 : m + 1][n][e]);
                            const float dn = dppf<0x101>(dnT, cur);
                            r[bj] = w[0][bj][e] * up + w[1][bj][e] * cur + w[2][bj][e] * dn + bs[bj][e];
                        }
                        a[e] = r[1] * __builtin_amdgcn_rcpf(1.f + __expf(-r[1])) * r[0];
                    }
                    u32x2 ow; ow.x = cvt_pk_bf16(a[0], a[1]); ow.y = cvt_pk_bf16(a[2], a[3]);
                    if (n == 0) keep[ai][m] = ow;
                    else { u32x4 w16; w16.x = keep[ai][m].x; w16.y = keep[ai][m].y; w16.z = ow.x; w16.w = ow.y;
                        *(u32x4*)(ACT + (size_t)(pm * BM + ai * HALF + wr * 64 + m * 16 + r4) * DFF + 128 * pn + 32 * wc + 8 * c4) = quad_xpose(w16, src4); }
                }
            }
        }
    }
};

template <class Epi, class Sched, bool ALIGN_EPI = true>
__device__ __forceinline__ void gemm_phase(LAS unsigned char* lds, const Gemm g, const Sched& S, const Epi& E, int wave_s) {
    const int tid = tid_of(wave_s);
    const int wid = wave_s, lane = tid & 63, wr = wid >> 2, wc = wid & 3, fr = lane & 15, fq = lane >> 4;
    const int K = g.K, nt = K / BK;
    unsigned voffA[2], voffB[2];
#pragma unroll
    for (int i = 0; i < 2; ++i) { int R, C; stage_rc(tid * 16 + i * 8192, R, C); const int Rb = Epi::PERM ? ((R & ~31) + perm32(R & 31)) : R;
        voffA[i] = (unsigned)(R * K + C) * 2u; voffB[i] = (unsigned)(Rb * K + C) * 2u; }
    const size_t kstep = (size_t)(BK * 2);
    const size_t hstep = (size_t)HALF * K * 2;
    const size_t tstep = 2 * hstep;
    const unsigned ldsw = (unsigned)wid * 1024u;
    const int aoff = lds_byte(wr * 64 + fr, fq * 8), boff = lds_byte(wc * 32 + fr, fq * 8);
#define PG8_SA(b, h) (((b) * 2 + (h)) * HTB)
#define PG8_SB(b, h) ((4 + (b) * 2 + (h)) * HTB)
#define PG8_STAGE(bufoff, gbase, voff) do { _Pragma("unroll") for (int _i = 0; _i < 2; ++_i) \
        __builtin_amdgcn_global_load_lds((const unsigned*)((const char*)(gbase) + (voff)[_i]), (LAS unsigned*)(lds + (bufoff) + ldsw + _i * 8192), 16, 0, 0); } while (0)
#define PG8_LDA(dst, b, h) do { _Pragma("unroll") for (int m = 0; m < 4; ++m) _Pragma("unroll") for (int k = 0; k < 2; ++k) dst[m][k] = *(const LAS bf16x8*)(lds + PG8_SA(b, h) + aoff + m * 2048 + k * 1024); } while (0)
#define PG8_LDB(dst, b, h) do { _Pragma("unroll") for (int n = 0; n < 2; ++n) _Pragma("unroll") for (int k = 0; k < 2; ++k) dst[n][k] = *(const LAS bf16x8*)(lds + PG8_SB(b, h) + boff + n * 2048 + k * 1024); } while (0)
#define PG8_MMA(ai, bj, At, Bt) do { __builtin_amdgcn_s_setprio(1); _Pragma("unroll") for (int m = 0; m < 4; ++m) _Pragma("unroll") for (int n = 0; n < 2; ++n) _Pragma("unroll") for (int k = 0; k < 2; ++k) \
        acc[ai][bj][m][n] = __builtin_amdgcn_mfma_f32_16x16x32_bf16(Bt[n][k], At[m][k], acc[ai][bj][m][n], 0, 0, 0); __builtin_amdgcn_s_setprio(0); } while (0)
#define PG8_WAIT_V(n) asm volatile("s_waitcnt vmcnt(" #n ")" ::: "memory")
#define PG8_WAIT_L(n) asm volatile("s_waitcnt lgkmcnt(" #n ")" ::: "memory")
#define PG8_BAR __builtin_amdgcn_s_barrier()
#define PG8_SCHED __builtin_amdgcn_sched_barrier(0)
    Unit cur, nxt; int ui = 0;
    if (!S.next(0, cur)) return;
    f32x4 acc[2][2][4][2];
#pragma unroll
    for (int a = 0; a < 2; ++a)
#pragma unroll
        for (int b = 0; b < 2; ++b)
#pragma unroll
            for (int m = 0; m < 4; ++m)
#pragma unroll
                for (int n = 0; n < 2; ++n) acc[a][b][m][n] = (f32x4){0.f, 0.f, 0.f, 0.f};
    bf16x8 At[4][2], B0[2][2], B1[2][2];
    const char* cA = (const char*)g.A + (size_t)cur.pm * tstep; const char* cB = (const char*)g.Bt + (size_t)cur.pn * tstep;
    S.a_ready(cur);
    PG8_STAGE(PG8_SB(0, 0), cB, voffB); PG8_STAGE(PG8_SB(0, 1), cB + hstep, voffB); PG8_STAGE(PG8_SA(0, 0), cA, voffA); PG8_STAGE(PG8_SA(0, 1), cA + hstep, voffA);
    if (wr == 1) PG8_BAR;
    PG8_WAIT_V(2); PG8_BAR;
    PG8_STAGE(PG8_SB(1, 0), cB + kstep, voffB); PG8_STAGE(PG8_SA(1, 0), cA + kstep, voffA); PG8_STAGE(PG8_SB(1, 1), cB + hstep + kstep, voffB);
    PG8_WAIT_V(6); PG8_BAR;
    for (;;) {
        const bool has_next = S.next(ui + 1, nxt);
        const char* nA = has_next ? (const char*)g.A + (size_t)nxt.pm * tstep : cA; const char* nB = has_next ? (const char*)g.Bt + (size_t)nxt.pn * tstep : cB;
        for (int t = 0; t < nt; t += 2) {
            const bool last = (t == nt - 2);
            const char* a1 = cA + (size_t)(t + 1) * kstep;
            const char* a2 = last ? nA : cA + (size_t)(t + 2) * kstep; const char* b2 = last ? nB : cB + (size_t)(t + 2) * kstep;
            const char* a3 = a2 + kstep; const char* b3 = b2 + kstep;
            if (last && has_next) S.a_ready(nxt);
            PG8_LDB(B0, 0, 0); PG8_LDB(B1, 0, 1); PG8_SCHED; PG8_LDA(At, 0, 0); PG8_STAGE(PG8_SA(1, 1), a1 + hstep, voffA);
            PG8_WAIT_V(8); PG8_WAIT_L(0); PG8_BAR; PG8_MMA(0, 0, At, B0); PG8_MMA(0, 1, At, B1); PG8_BAR; PG8_SCHED;
            PG8_LDA(At, 0, 1); PG8_STAGE(PG8_SB(0, 0), b2, voffB); PG8_STAGE(PG8_SB(0, 1), b2 + hstep, voffB); PG8_STAGE(PG8_SA(0, 0), a2, voffA);
            PG8_WAIT_V(8); PG8_WAIT_L(0); PG8_BAR; PG8_MMA(1, 0, At, B0); PG8_MMA(1, 1, At, B1); PG8_BAR; PG8_SCHED;
            PG8_LDB(B0, 1, 0); PG8_LDB(B1, 1, 1); PG8_SCHED; PG8_LDA(At, 1, 0); PG8_STAGE(PG8_SA(0, 1), a2 + hstep, voffA);
            PG8_WAIT_V(8); PG8_WAIT_L(0); PG8_BAR; PG8_MMA(0, 0, At, B0); PG8_MMA(0, 1, At, B1); PG8_BAR; PG8_SCHED;
            PG8_LDA(At, 1, 1); PG8_STAGE(PG8_SB(1, 0), b3, voffB); PG8_STAGE(PG8_SB(1, 1), b3 + hstep, voffB); PG8_STAGE(PG8_SA(1, 0), a3, voffA);
            PG8_WAIT_V(8); PG8_WAIT_L(0); PG8_BAR; PG8_MMA(1, 0, At, B0); PG8_MMA(1, 1, At, B1); PG8_BAR; PG8_SCHED;
        }
        if constexpr (ALIGN_EPI) { if (wr == 0) PG8_BAR; }
        E(acc, cur, wr, wc, fr, fq); S.done(cur);
        if (!has_next) break;
#pragma unroll
        for (int a = 0; a < 2; ++a)
#pragma unroll
            for (int b = 0; b < 2; ++b)
#pragma unroll
                for (int m = 0; m < 4; ++m)
#pragma unroll
                    for (int n = 0; n < 2; ++n) acc[a][b][m][n] = (f32x4){0.f, 0.f, 0.f, 0.f};
        cur = nxt; cA = nA; cB = nB; ++ui;
        if constexpr (ALIGN_EPI) { if (wr == 1) PG8_BAR; }
    }
    PG8_WAIT_V(0);
    if constexpr (!ALIGN_EPI) { if (wr == 0) PG8_BAR; }
    PG8_BAR;
#undef PG8_SA
#undef PG8_SB
#undef PG8_STAGE
#undef PG8_LDA
#undef PG8_LDB
#undef PG8_MMA
#undef PG8_WAIT_V
#undef PG8_WAIT_L
#undef PG8_BAR
#undef PG8_SCHED
}
}

namespace att {
constexpr int D = 128, NW = 8, QBLK = 32, KVBLK = 64;
constexpr float SCALE = 0.088388347648318440f;
constexpr float THR = 8.f;
constexpr int SHM_V = KVBLK * D * 2, SHM_K = KVBLK * D * 2, SHM_ATTN = 2 * SHM_V + 2 * SHM_K + NW * 64 * 4;
constexpr int BIAS_OFF = SHM_ATTN, BIAS_FLOATS = 704;
constexpr int OST_OFF = 73728, OST_WAVE = 32 * 272;
#define KSWZ(row, colB) ((row) * 256 + ((colB) ^ (((row) & 7) << 4)))
#define SBAR() __builtin_amdgcn_sched_barrier(0)
__device__ __forceinline__ int crow(int r, int hi) { return (r & 3) + 8 * (r >> 2) + 4 * hi; }
__device__ __forceinline__ unsigned cvtpk(float lo, float hi) { unsigned r; asm volatile("v_cvt_pk_bf16_f32 %0, %1, %2" : "=v"(r) : "v"(lo), "v"(hi)); return r; }
__device__ __forceinline__ bf16x8 ld8(const bf16_t* p) { return *reinterpret_cast<const bf16x8*>(p); }

__device__ __forceinline__ void partialSM(f32x16& p0, f32x16& p1, float& m_reg, float& mn, float& alpha) {
  constexpr float C = SCALE * 1.4426950408889634f;
  float pmax = p0[0];
#pragma unroll
  for (int r = 1; r < 16; ++r) pmax = fmaxf(pmax, p0[r]);
#pragma unroll
  for (int r = 0; r < 16; ++r) pmax = fmaxf(pmax, p1[r]);
  { auto rr = __builtin_amdgcn_permlane32_swap(__float_as_uint(pmax), __float_as_uint(pmax), false, false);
    pmax = fmaxf(__uint_as_float(rr[0]), __uint_as_float(rr[1])); }
  if (__builtin_expect(__all(pmax - m_reg <= THR / SCALE), 1)) { mn = m_reg; alpha = 1.f; }
  else { mn = fmaxf(m_reg, pmax); alpha = __builtin_amdgcn_exp2f((m_reg - mn) * C); m_reg = mn; }
  float mnC = -mn * C;
#pragma unroll
  for (int r = 0; r < 16; ++r) p0[r] = fmaf(p0[r], C, mnC);
#pragma unroll
  for (int r = 0; r < 16; ++r) p1[r] = fmaf(p1[r], C, mnC);
#pragma unroll
  for (int r = 0; r < 16; ++r) p0[r] = __builtin_amdgcn_exp2f(p0[r]);
}
__device__ __forceinline__ void finishSM(f32x16& p0, f32x16& p1, float alpha, float& l_reg, bf16x8& pa0, bf16x8& pa1, bf16x8& pa2, bf16x8& pa3) {
#pragma unroll
  for (int r = 0; r < 16; ++r) p1[r] = __builtin_amdgcn_exp2f(p1[r]);
  float ps = 0;
#pragma unroll
  for (int r = 0; r < 16; ++r) ps += p0[r];
#pragma unroll
  for (int r = 0; r < 16; ++r) ps += p1[r];
  { auto rr = __builtin_amdgcn_permlane32_swap(__float_as_uint(ps), __float_as_uint(ps), false, false);
    ps = __uint_as_float(rr[0]) + __uint_as_float(rr[1]); }
  l_reg = l_reg * alpha + ps;
#define PK4(P, BASE, OUT) do { unsigned a0 = cvtpk(P[BASE + 0], P[BASE + 1]), a1 = cvtpk(P[BASE + 2], P[BASE + 3]);   \
    unsigned b0 = cvtpk(P[BASE + 4], P[BASE + 5]), b1 = cvtpk(P[BASE + 6], P[BASE + 7]);                              \
    auto r0 = __builtin_amdgcn_permlane32_swap(a0, b0, false, false); auto r1 = __builtin_amdgcn_permlane32_swap(a1, b1, false, false); \
    u32x4 w = {r0[0], r1[0], r0[1], r1[1]}; OUT = *reinterpret_cast<bf16x8*>(&w); } while (0)
  PK4(p0, 0, pa0); PK4(p0, 8, pa1); PK4(p1, 0, pa2); PK4(p1, 8, pa3);
#undef PK4
}
__device__ __forceinline__ void qkt(f32x16& p0, f32x16& p1, const char* Ks, const bf16x8* qr, int r32, int hi) {
  p0 = f32x16{}; p1 = f32x16{};
#pragma unroll
  for (int d0 = 0; d0 < 8; ++d0) { int cb = (d0 * 16 + hi * 8) * 2;
    bf16x8 b0 = *reinterpret_cast<const bf16x8*>(Ks + KSWZ(r32, cb));
    bf16x8 b1 = *reinterpret_cast<const bf16x8*>(Ks + KSWZ(32 + r32, cb));
    p0 = __builtin_amdgcn_mfma_f32_32x32x16_bf16(b0, qr[d0], p0, 0, 0, 0);
    p1 = __builtin_amdgcn_mfma_f32_32x32x16_bf16(b1, qr[d0], p1, 0, 0, 0); }
}
__device__ __forceinline__ int v_st(int k, int c) { const int kk = (k & ~0xC) | ((k & 4) << 1) | ((k & 8) >> 1); return ((kk >> 3) * 4 + (c >> 5)) * 512 + ((kk & 7) * 32 + (c & 31)) * 2; }
__device__ __forceinline__ int v_rd_base(int lane) { return ((lane & 3) << 3) | (((lane >> 2) & 3) << 6) | (((lane >> 4) & 1) << 5) | (((lane >> 5) & 1) << 8); }
constexpr int v_rd_off(int d0, int ks, int half) { return d0 * 512 + ks * 4096 + half * 2048; }
template <int OFF> __device__ __forceinline__ s16x4 tr_read(int vb) {
  s16x4 r; asm volatile("ds_read_b64_tr_b16 %0, %1 offset:%2" : "=&v"(r) : "v"(vb), "i"(OFF) : "memory"); return r;
}
template <int D0> __device__ __forceinline__ void pv_one(f32x16& od, int vb, bf16x8 pa0, bf16x8 pa1, bf16x8 pa2, bf16x8 pa3) {
  const s16x4 l0 = tr_read<v_rd_off(D0, 0, 0)>(vb), h0 = tr_read<v_rd_off(D0, 0, 1)>(vb), l1 = tr_read<v_rd_off(D0, 1, 0)>(vb), h1 = tr_read<v_rd_off(D0, 1, 1)>(vb);
  const s16x4 l2 = tr_read<v_rd_off(D0, 2, 0)>(vb), h2 = tr_read<v_rd_off(D0, 2, 1)>(vb), l3 = tr_read<v_rd_off(D0, 3, 0)>(vb), h3 = tr_read<v_rd_off(D0, 3, 1)>(vb);
  asm volatile("s_waitcnt lgkmcnt(0)" ::: "memory"); SBAR();
#define PK(L, H) (bf16x8){L[0], L[1], L[2], L[3], H[0], H[1], H[2], H[3]}
  od = __builtin_amdgcn_mfma_f32_32x32x16_bf16(pa0, PK(l0, h0), od, 0, 0, 0);
  od = __builtin_amdgcn_mfma_f32_32x32x16_bf16(pa1, PK(l1, h1), od, 0, 0, 0);
  od = __builtin_amdgcn_mfma_f32_32x32x16_bf16(pa2, PK(l2, h2), od, 0, 0, 0);
  od = __builtin_amdgcn_mfma_f32_32x32x16_bf16(pa3, PK(l3, h3), od, 0, 0, 0);
#undef PK
}
__device__ __forceinline__ void pv_d0(f32x16* o, int vb, bf16x8 pa0, bf16x8 pa1, bf16x8 pa2, bf16x8 pa3) {
  pv_one<0>(o[0], vb, pa0, pa1, pa2, pa3); pv_one<1>(o[1], vb, pa0, pa1, pa2, pa3); pv_one<2>(o[2], vb, pa0, pa1, pa2, pa3); pv_one<3>(o[3], vb, pa0, pa1, pa2, pa3);
}

template <bool NB, int QN = 0>
__device__ __forceinline__ void attn_body(const bf16_t* __restrict__ Qb, const bf16_t* __restrict__ K0, const bf16_t* __restrict__ V0, int nt0,
                                          const bf16_t* __restrict__ K1, const bf16_t* __restrict__ V1, int NT,
                                          bf16_t* __restrict__ Ob, char* lds, int nb_r0, int nb_krlo, int wave_s,
                                          const float* __restrict__ gq = nullptr, int tpos0 = 0) {
  const int tid = tid_of(wave_s);
  const int wid = wave_s, lane = tid & 63, r32 = lane & 31, hi = lane >> 5;
  char* V_lds = lds; char* K_lds = lds + 2 * SHM_V;
  float* ws = (float*)(lds + 2 * SHM_V + 2 * SHM_K) + wid * 64; float* li_l = ws; float* al_l = ws + 32;
  float m_reg = -1e30f, l_reg = 0; f32x16 o[4] = {}; bf16x8 qr[8];
  const bf16_t* Qw = Qb + (size_t)(wid * QBLK + r32) * D + hi * 8;
#pragma unroll
  for (int d0 = 0; d0 < 8; ++d0) qr[d0] = ld8(Qw + d0 * 16);
  if constexpr (QN != 0) {
    float qf[8][8]; float ss = 0.f;
#pragma unroll
    for (int d0 = 0; d0 < 8; ++d0) { const u32x4 w = __builtin_bit_cast(u32x4, qr[d0]);
      qf[d0][0] = bf_lo(w.x); qf[d0][1] = bf_hi(w.x); qf[d0][2] = bf_lo(w.y); qf[d0][3] = bf_hi(w.y); qf[d0][4] = bf_lo(w.z); qf[d0][5] = bf_hi(w.z); qf[d0][6] = bf_lo(w.w); qf[d0][7] = bf_hi(w.w);
#pragma unroll
      for (int e = 0; e < 8; ++e) ss += qf[d0][e] * qf[d0][e]; }
    ss += __shfl_xor(ss, 32);
    const float rstd = rsqrtf(ss * (1.f / 128.f) + EPS);
#pragma unroll
    for (int d0 = 0; d0 < 8; ++d0) { const f32x4 g0 = *(const f32x4*)(gq + d0 * 16 + hi * 8), g1 = *(const f32x4*)(gq + d0 * 16 + hi * 8 + 4);
#pragma unroll
      for (int e = 0; e < 4; ++e) { qf[d0][e] *= rstd * g0[e]; qf[d0][4 + e] *= rstd * g1[e]; } }
    if constexpr (QN == 2) {
      const int tq = tpos0 + wid * QBLK + r32;
#pragma unroll
      for (int dh = 0; dh < 2; ++dh)
#pragma unroll
        for (int e = 0; e < 8; ++e) {
          const float fr_ = __builtin_amdgcn_exp2f(-(float)(dh * 16 + hi * 8 + e) * (13.287712379549449f / 32.f)) * 0.15915494309189535f;
#pragma unroll
          for (int H = 0; H < 2; ++H) {
            float rev = (float)(H ? (tq & 63) : (tq >> 6)) * fr_; rev -= floorf(rev);
            const float sn = __builtin_amdgcn_sinf(rev), cn = __builtin_amdgcn_cosf(rev);
            const float x1 = qf[4 * H + dh][e], x2 = qf[4 * H + dh + 2][e];
            qf[4 * H + dh][e] = x1 * cn - x2 * sn; qf[4 * H + dh + 2][e] = x2 * cn + x1 * sn; } }
    }
#pragma unroll
    for (int d0 = 0; d0 < 8; ++d0) { u32x4 w; w.x = cvtpk(qf[d0][0], qf[d0][1]); w.y = cvtpk(qf[d0][2], qf[d0][3]); w.z = cvtpk(qf[d0][4], qf[d0][5]); w.w = cvtpk(qf[d0][6], qf[d0][7]);
      qr[d0] = __builtin_bit_cast(bf16x8, w); }
  }
  const int sr = tid >> 4, sc = (tid & 15) * 8, vst0 = v_st(sr, sc), vst1 = v_st(32 + sr, sc);
  const int vb0 = (int)(uintptr_t)V_lds + v_rd_base(lane);
  const int nq_r = nb_r0 + (wid >> 1), nq_c = 32 * (wid & 1) + r32;
  const int nrs = min(max(nq_r - 4, 0), 8), ncs = min(max(nq_c - 8, 0), 48);
  const float* btab = (const float*)(lds + BIAS_OFF) + 64 + 15 - nq_c + 4 * hi;
  struct { bf16x8 vs0, vs1, ks0, ks1; } sr_[2];
#define KPTR(j) ((j) < nt0 ? K0 + (size_t)(j) * (KVBLK * D) : K1 + (size_t)((j) - nt0) * (KVBLK * D))
#define VPTR(j) ((j) < nt0 ? V0 + (size_t)(j) * (KVBLK * D) : V1 + (size_t)((j) - nt0) * (KVBLK * D))
#define SLOAD(i, j) do { const bf16_t* kp_ = KPTR(j); const bf16_t* vp_ = VPTR(j); \
    sr_[i].vs0 = ld8(vp_ + sr * D + sc); sr_[i].vs1 = ld8(vp_ + (32 + sr) * D + sc); \
    sr_[i].ks0 = ld8(kp_ + sr * D + sc); sr_[i].ks1 = ld8(kp_ + (32 + sr) * D + sc); } while (0)
#define SWRITE(b, i) do { *(bf16x8*)(V_lds + (b) * SHM_V + vst0) = sr_[i].vs0;          \
    *(bf16x8*)(V_lds + (b) * SHM_V + vst1) = sr_[i].vs1; int kc = sc * 2;               \
    *(bf16x8*)(K_lds + (b) * SHM_K + KSWZ(sr, kc)) = sr_[i].ks0;                       \
    *(bf16x8*)(K_lds + (b) * SHM_K + KSWZ(32 + sr, kc)) = sr_[i].ks1; } while (0)
#define SWAIT() asm volatile("s_waitcnt vmcnt(4)" ::: "memory")
#define RESC(a) do { if (__any((a) < 1.f)) { if (hi == 0) al_l[r32] = (a); asm volatile("s_waitcnt lgkmcnt(0)" ::: "memory"); \
    _Pragma("unroll") for (int d = 0; d < 4; ++d) _Pragma("unroll") for (int r = 0; r < 16; ++r) o[d][r] *= al_l[crow(r, hi)]; } } while (0)
#define NBMASK(P0, P1, j) do { if (NB && (j) >= 4) { const int kr_ = nb_krlo + (j) - 4; \
    if ((unsigned)(kr_ - nrs) >= 8u) { _Pragma("unroll") for (int r = 0; r < 16; ++r) { P0[r] = -1e30f; P1[r] = -1e30f; } } \
    else { const float* tb_ = btab + (kr_ - nq_r + 7) * 31; const int kb_ = 4 * hi - ncs; \
      _Pragma("unroll") for (int r = 0; r < 16; ++r) { const int c0_ = (r & 3) + 8 * (r >> 2); \
        P0[r] = ((unsigned)(kb_ + c0_) < 16u) ? P0[r] + tb_[c0_] : -1e30f; \
        P1[r] = ((unsigned)(kb_ + c0_ + 32) < 16u) ? P1[r] + tb_[c0_ + 32] : -1e30f; } } } } while (0)
  f32x16 pA0, pA1, pB0, pB1; float mnA, mnB, alA, alB; bf16x8 pa0, pa1, pa2, pa3;
  constexpr int SE = 0, SO = 1;
  SLOAD(SE, 0); asm volatile("s_waitcnt vmcnt(0)" ::: "memory"); SWRITE(0, SE); __syncthreads();
  qkt(pA0, pA1, K_lds, qr, r32, hi); partialSM(pA0, pA1, m_reg, mnA, alA);
  SLOAD(SO, 1); if (2 < NT) SLOAD(SE, 2);
  SWAIT(); SWRITE(1, SO); __syncthreads();
  for (int j = 1; j + 1 < NT; j += 2) {
    SBAR(); qkt(pB0, pB1, K_lds + SHM_K, qr, r32, hi);
    finishSM(pA0, pA1, alA, l_reg, pa0, pa1, pa2, pa3); SBAR();
    SLOAD(SO, j + 2); SBAR();
    pv_d0(o, vb0, pa0, pa1, pa2, pa3); NBMASK(pB0, pB1, j); partialSM(pB0, pB1, m_reg, mnB, alB);
    __syncthreads(); SWAIT(); SWRITE(0, SE);
    RESC(alB); __syncthreads();
    SBAR(); qkt(pA0, pA1, K_lds, qr, r32, hi);
    finishSM(pB0, pB1, alB, l_reg, pa0, pa1, pa2, pa3); SBAR();
    if (j + 3 < NT) SLOAD(SE, j + 3); SBAR();
    pv_d0(o, vb0 + SHM_V, pa0, pa1, pa2, pa3); NBMASK(pA0, pA1, j + 1); partialSM(pA0, pA1, m_reg, mnA, alA);
    __syncthreads(); SWAIT(); SWRITE(1, SO);
    RESC(alA); __syncthreads();
  }
  SBAR(); qkt(pB0, pB1, K_lds + SHM_K, qr, r32, hi);
  finishSM(pA0, pA1, alA, l_reg, pa0, pa1, pa2, pa3); SBAR();
  pv_d0(o, vb0, pa0, pa1, pa2, pa3); NBMASK(pB0, pB1, NT - 1); partialSM(pB0, pB1, m_reg, mnB, alB);
  __syncthreads(); RESC(alB);
  finishSM(pB0, pB1, alB, l_reg, pa0, pa1, pa2, pa3); SBAR();
  pv_d0(o, vb0 + SHM_V, pa0, pa1, pa2, pa3);
  if (hi == 0) li_l[r32] = l_reg; asm volatile("s_waitcnt lgkmcnt(0)" ::: "memory");
  float rli[16];
#pragma unroll
  for (int r = 0; r < 16; ++r) rli[r] = __builtin_amdgcn_rcpf(li_l[crow(r, hi)]);
  char* ost = lds + OST_OFF + wid * OST_WAVE;
#pragma unroll
  for (int r = 0; r < 16; ++r) { const int orow = crow(r, hi);
#pragma unroll
    for (int d0 = 0; d0 < 4; ++d0) { const float v = o[d0][r] * rli[r]; *(bf16_t*)(ost + orow * 272 + (d0 * 32 + r32) * 2) = (bf16_t)(cvtpk(v, v) & 0xffffu); } }
  asm volatile("s_waitcnt lgkmcnt(0)" ::: "memory");
  bf16_t* Ow = Ob + (size_t)(wid * QBLK) * DM;
#pragma unroll
  for (int i = 0; i < 8; ++i) { const int row = (lane >> 4) + 4 * i, ch = lane & 15;
    const u32x4 w = *(const u32x4*)(ost + row * 272 + ch * 16);
    *(u32x4*)(Ow + (size_t)row * DM + ch * 8) = w; }
#undef KPTR
#undef VPTR
#undef SLOAD
#undef SWRITE
#undef SWAIT
#undef RESC
#undef NBMASK
}
}

__device__ __forceinline__ unsigned f2bf(float f) { unsigned u = __builtin_bit_cast(unsigned, f); return (u + 0x7fffu + ((u >> 16) & 1u)) >> 16; }
__device__ __forceinline__ unsigned pk2(float lo, float hi) { return f2bf(lo) | (f2bf(hi) << 16); }
#define LDS_WAIT() asm volatile("s_waitcnt lgkmcnt(0)" ::: "memory")
template <bool UPMAP> __device__ __forceinline__ void transpose_item(const float* __restrict__ W, int K, int N, bf16_t* __restrict__ WT, LAS float* scr, int item, int lane) {
    const int nblk = N / 32, kb = item / nblk, nb = item % nblk, k0 = 64 * kb, n0 = 32 * nb;
    const int d0 = UPMAP ? (n0 < DFF ? (n0 >> 7) * 256 + (n0 & 127) : ((n0 - DFF) >> 7) * 256 + 128 + ((n0 - DFF) & 127)) : n0;
    {
        const int r8 = lane >> 3, c4 = lane & 7;
        f32x4 v[8];
#pragma unroll
        for (int g = 0; g < 8; ++g) v[g] = *(const f32x4*)(W + (size_t)(k0 + 8 * g + r8) * N + n0 + 4 * c4);
#pragma unroll
        for (int g = 0; g < 8; ++g) { LAS float* d = scr + (8 * g + r8) * 33 + 4 * c4; d[0] = v[g][0]; d[1] = v[g][1]; d[2] = v[g][2]; d[3] = v[g][3]; }
    }
    LDS_WAIT(); asm volatile("" ::: "memory");
    const int c = lane & 7;
#pragma unroll
    for (int j = 0; j < 4; ++j) { const int n = (lane >> 3) + 8 * j; const LAS float* s = scr + (8 * c) * 33 + n;
        u32x4 o; o.x = pk2(s[0 * 33], s[1 * 33]); o.y = pk2(s[2 * 33], s[3 * 33]); o.z = pk2(s[4 * 33], s[5 * 33]); o.w = pk2(s[6 * 33], s[7 * 33]);
        *(u32x4*)(WT + (size_t)(d0 + n) * K + k0 + 8 * c) = o; }
    LDS_WAIT(); asm volatile("" ::: "memory");
}

struct Args { const float* in[23]; float* out; unsigned char* ws; int ph_lo, ph_hi; };

__global__ void __launch_bounds__(512, 2) mk_fwd(Args args) {
    extern __shared__ __attribute__((aligned(16))) unsigned char lds[];
    cg::grid_group grid = cg::this_grid();
    const int G = gridDim.x, bx = blockIdx.x, NGW = G * 8;
    const int wave_s = __builtin_amdgcn_readfirstlane((int)threadIdx.x >> 6);
#define PHASE_IDS const int tid = tid_of(wave_s); const int lane = tid & 63, wave = wave_s; \
    const int gw = bx * 8 + wave, gwi = wave * G + bx; (void)lane; (void)gw; (void)gwi; (void)tid;
#define ws (args.ws)
#define x_prompt (args.in[0])
#define x_sample (args.in[1])
#define cvec (args.in[2])
#define cache_a_k (args.in[3])
#define cache_a_v (args.in[4])
#define cache_b_k (args.in[5])
#define cache_b_v (args.in[6])
#define c_ctx (args.in[7])
#define w_mod (args.in[8])
#define b_mod (args.in[9])
#define g_attn_pre (args.in[10])
#define g_attn_post (args.in[11])
#define g_ffn_pre (args.in[12])
#define g_ffn_post (args.in[13])
#define w_in (args.in[14])
#define rpb (args.in[15])
#define g_qnorm (args.in[16])
#define g_knorm (args.in[17])
#define w_out (args.in[18])
#define w_up (args.in[19])
#define conv_w (args.in[20])
#define conv_b (args.in[21])
#define w_down (args.in[22])
#define Y_ (args.out)
#define st_ak (args.out + (size_t)MTOK * DM)
#define st_av (args.out + (size_t)MTOK * DM + (size_t)32 * 8 * 256 * 128)
#define st_bk (args.out + (size_t)MTOK * DM + (size_t)2 * 32 * 8 * 256 * 128)
#define st_bv (args.out + (size_t)MTOK * DM + (size_t)2 * 32 * 8 * 256 * 128 + (size_t)32 * 2 * 256 * 128)
#define MOD ((float*)(ws + WS_MOD))
#define MODP ((float*)(ws + WS_MODP))
#define WIN ((bf16_t*)(ws + WS_WIN))
#define WOUT ((bf16_t*)(ws + WS_WOUT))
#define WUP ((bf16_t*)(ws + WS_WUP))
#define WDN ((bf16_t*)(ws + WS_WDN))
#define XN ((bf16_t*)(ws + WS_XN))
#define CAK ((bf16_t*)(ws + WS_CAK))
#define CAV ((bf16_t*)(ws + WS_CAV))
#define CBK ((bf16_t*)(ws + WS_CBK))
#define CBV ((bf16_t*)(ws + WS_CBV))
#define QA ((bf16_t*)(ws + WS_QA))
#define KA ((bf16_t*)(ws + WS_KA))
#define VA ((bf16_t*)(ws + WS_VA))
#define QB ((bf16_t*)(ws + WS_QB))
#define KB ((bf16_t*)(ws + WS_KB))
#define VB ((bf16_t*)(ws + WS_VB))
#define OB ((bf16_t*)(ws + WS_O))
#define P1 ((bf16_t*)(ws + WS_P1))
#define P2 ((bf16_t*)(ws + WS_P2))
#define ACT ((bf16_t*)(ws + WS_ACT))
#define HBUF ((float*)(ws + WS_U))
#define X1B ((bf16_t*)(ws + WS_X1))
    LAS unsigned char* ldsl = (LAS unsigned char*)lds;

    const int lo = args.ph_lo, hi = args.ph_hi;
#ifndef PH_MASK
#define PH_MASK 0xFFF
#endif
#define IN(k) (((PH_MASK >> (k)) & 1) && lo <= (k) && (k) < hi)
    { const int t0 = tid_of(wave_s); if (t0 < 16) ((volatile LAS unsigned*)(ldsl + MISC_OFF))[t0] = 0u; }
    __syncthreads();
    const XcdBarrier xbar = xcd_barrier_post((unsigned*)(ws + WS_CTL), (volatile LAS unsigned*)(ldsl + MISC_OFF), wave_s);
#define SEAM(k) do { if (IN(k) && IN((k) + 1)) { if ((k) == 0) grid.sync(); else xcd_barrier(xbar, wave_s); } } while (0)

    if (IN(0)) {
        PHASE_IDS
        LAS float* cs = (LAS float*)ldsl;
        for (int idx = tid; idx < 9 * 2048; idx += 512) { const int j = idx >> 11, k = idx & 2047; const float c = (j == 0) ? c_ctx[k] : cvec[(j - 1) * 2048 + k];
            cs[k * 9 + j] = c / (1.f + __expf(-c)); }
        __syncthreads();
        for (int ch = bx; ch < 256; ch += G) {
            const int vc = (ch & 7) * 32 + (ch >> 3), rsub = lane / 12, c4 = lane - 12 * rsub;
            f32x4 acc[9];
#pragma unroll
            for (int j = 0; j < 9; ++j) acc[j] = (f32x4){0.f, 0.f, 0.f, 0.f};
            if (rsub < 5) {
                const float* wp = w_mod + (size_t)(wave * 256 + rsub) * NMOD + vc * 48 + 4 * c4;
                const LAS float* sp = cs + (wave * 256 + rsub) * 9;
#pragma unroll 8
                for (int it = 0; it < 51; ++it) {
                    const f32x4 w = *(const f32x4*)(wp + (size_t)(5 * it) * NMOD);
                    const LAS float* s2 = sp + 45 * it;
#pragma unroll
                    for (int j = 0; j < 9; ++j) acc[j] += w * s2[j];
                }
                if (rsub == 0) {
                    const f32x4 w = *(const f32x4*)(wp + (size_t)255 * NMOD);
                    const LAS float* s2 = sp + 9 * 255;
#pragma unroll
                    for (int j = 0; j < 9; ++j) acc[j] += w * s2[j];
                }
            }
            __syncthreads();
            LAS float* red = (LAS float*)ldsl;
#pragma unroll
            for (int j = 0; j < 9; ++j) *(LAS f32x4*)(red + tid * 36 + 4 * j) = acc[j];
            __syncthreads();
            if (tid < 432) { const int j = tid / 48, col = tid - 48 * j, cc = col >> 2, e = col & 3;
                float sum = b_mod[vc * 48 + col];
#pragma unroll
                for (int w = 0; w < 8; ++w)
#pragma unroll
                    for (int r5 = 0; r5 < 5; ++r5) sum += red[(w * 64 + r5 * 12 + cc) * 36 + 4 * j + e];
                MOD[(size_t)j * NMOD + vc * 48 + col] = sum; }
            __syncthreads();
            if (ch + G < 256) {
                for (int idx = tid; idx < 9 * 2048; idx += 512) { const int j = idx >> 11, k = idx & 2047; const float c = (j == 0) ? c_ctx[k] : cvec[(j - 1) * 2048 + k];
                    cs[k * 9 + j] = c / (1.f + __expf(-c)); }
                __syncthreads();
            }
        }
        LAS float* scr = (LAS float*)(ldsl + wave * 8448);
        constexpr int I_IN = 32 * 144, I_OUT = 32 * 64;
        for (int it = gwi; it < I_IN + I_OUT; it += NGW) {
            if (it < I_IN) transpose_item<false>(w_in, DM, NIN, WIN, scr, it, lane);
            else transpose_item<false>(w_out, DM, DM, WOUT, scr, it - I_IN, lane);
        }
        {
            constexpr int NA8 = 8 * 8 * 256 * 128 / 8, NB8 = 8 * 2 * 256 * 128 / 8;
            for (int i = bx * 512 + tid; i < 2 * NA8 + 2 * NB8; i += G * 512) {
                const float* src; bf16_t* dst; int j = i;
                if (j < NA8) { src = cache_a_k; dst = CAK; } else if ((j -= NA8) < NA8) { src = cache_a_v; dst = CAV; }
                else if ((j -= NA8) < NB8) { src = cache_b_k; dst = CBK; } else { j -= NB8; src = cache_b_v; dst = CBV; }
                const f32x4 a = *(const f32x4*)(src + (size_t)j * 8), b = *(const f32x4*)(src + (size_t)j * 8 + 4);
                u32x4 w; w.x = cvt_pk_bf16(a[0], a[1]); w.y = cvt_pk_bf16(a[2], a[3]); w.z = cvt_pk_bf16(b[0], b[1]); w.w = cvt_pk_bf16(b[2], b[3]);
                *(u32x4*)(dst + (size_t)j * 8) = w;
            }
        }
    }
    SEAM(0);
    if (IN(2)) {
        PHASE_IDS
        for (int m = 2 * gw; m < MTOK; m += 2 * NGW) {
            const float* xr = (m < NCTX) ? x_prompt + (size_t)m * DM : x_sample + (size_t)(m - NCTX) * DM;
            const float* md = MOD + (size_t)((m < NCTX) ? 0 : 1 + ((m - NCTX) >> 10)) * NMOD;
            f32x4 v[2][4][2]; float ss[2] = {0.f, 0.f};
#pragma unroll
            for (int r2 = 0; r2 < 2; ++r2)
#pragma unroll
                for (int i = 0; i < 4; ++i) { v[r2][i][0] = *(const f32x4*)(xr + (size_t)r2 * DM + 8 * lane + 512 * i); v[r2][i][1] = *(const f32x4*)(xr + (size_t)r2 * DM + 8 * lane + 512 * i + 4); }
#pragma unroll
            for (int r2 = 0; r2 < 2; ++r2)
#pragma unroll
                for (int i = 0; i < 4; ++i)
#pragma unroll
                    for (int h2 = 0; h2 < 2; ++h2) { const f32x4 t = v[r2][i][h2]; ss[r2] += (t[0] * t[0] + t[1] * t[1]) + (t[2] * t[2] + t[3] * t[3]); }
            const float rstd0 = rsqrtf(wave_sum(ss[0]) * (1.f / DM) + EPS), rstd1 = rsqrtf(wave_sum(ss[1]) * (1.f / DM) + EPS);
            bf16_t* orow = XN + (size_t)m * DM;
#pragma unroll
            for (int i = 0; i < 4; ++i) { const int c = 8 * lane + 512 * i;
                f32x4 r0[2], r1[2];
#pragma unroll
                for (int h2 = 0; h2 < 2; ++h2) {
                    const f32x4 g = *(const f32x4*)(g_attn_pre + c + 4 * h2), sh = *(const f32x4*)(md + c + 4 * h2), sc = *(const f32x4*)(md + 2048 + c + 4 * h2);
                    const f32x4 gs = g * (sc + 1.f);
                    r0[h2] = v[0][i][h2] * rstd0 * gs + sh; r1[h2] = v[1][i][h2] * rstd1 * gs + sh; }
                u32x4 w0, w1;
                w0.x = cvt_pk_bf16(r0[0][0], r0[0][1]); w0.y = cvt_pk_bf16(r0[0][2], r0[0][3]); w0.z = cvt_pk_bf16(r0[1][0], r0[1][1]); w0.w = cvt_pk_bf16(r0[1][2], r0[1][3]);
                w1.x = cvt_pk_bf16(r1[0][0], r1[0][1]); w1.y = cvt_pk_bf16(r1[0][2], r1[0][3]); w1.z = cvt_pk_bf16(r1[1][0], r1[1][1]); w1.w = cvt_pk_bf16(r1[1][2], r1[1][3]);
                *(u32x4*)(orow + c) = w0; *(u32x4*)(orow + DM + c) = w1; }
        }
    }
    SEAM(2);
    if (IN(3)) {
        pg8::Gemm g{XN, WIN, MTOK, NIN, DM}; pg8::StaticOrder S; S.init(MTOK, NIN, G, bx);
        pg8::EpiQKV E{QA, KA, VA, QB, KB, VB, st_ak, st_av, st_bv};
        const int hb = G >> 1;
        if (bx >= hb) {
            PHASE_IDS
            LAS float* scr = (LAS float*)(ldsl + wave * 8448);
            constexpr int I_UP = 32 * 352, I_DN = 88 * 64;
            for (int it = wave * (G - hb) + (bx - hb); it < I_UP + I_DN; it += 8 * (G - hb)) {
                if (it < I_UP) transpose_item<true>(w_up, DM, NUP, WUP, scr, it, lane);
                else transpose_item<false>(w_down, DFF, DM, WDN, scr, it - I_UP, lane);
            }
            __syncthreads();
        }
        pg8::gemm_phase<pg8::EpiQKV, pg8::StaticOrder, true>(ldsl, g, S, E, wave_s);
    }
    SEAM(3);
    if (IN(4)) {
        PHASE_IDS
        const int vs = lane >> 3, part = lane & 7, hsel = part >> 2;
        const int ib = 16 * (part & 1);
        const float sgn = (part & 2) ? 1.f : -1.f;
        constexpr int NIQ = MTOK * 8 / 8, NIK = MTOK * 2 / 8;
        for (int itv = NIQ + gw; itv < NIQ + NIK; itv += NGW) {
            const bool isq = itv < NIQ; const int H = isq ? 8 : 2;
            const int vv = (isq ? itv : itv - NIQ) * 8 + vs;
            bf16_t* p = (isq ? QB : KB) + (size_t)vv * 128 + 16 * part;
            const float* gp = (isq ? g_qnorm : g_knorm) + 16 * part;
            const u32x4 w0 = *(const u32x4*)p, w1 = *(const u32x4*)(p + 8);
            float e[16];
#pragma unroll
            for (int q = 0; q < 4; ++q) { e[2 * q] = bf_lo(w0[q]); e[2 * q + 1] = bf_hi(w0[q]); e[8 + 2 * q] = bf_lo(w1[q]); e[8 + 2 * q + 1] = bf_hi(w1[q]); }
            float ss = 0.f;
#pragma unroll
            for (int j = 0; j < 16; ++j) ss += e[j] * e[j];
            ss += __shfl_xor(ss, 1); ss += __shfl_xor(ss, 2); ss += __shfl_xor(ss, 4);
            const float rstd = rsqrtf(ss * (1.f / 128.f) + EPS);
#pragma unroll
            for (int q = 0; q < 4; ++q) { const f32x4 g = *(const f32x4*)(gp + 4 * q);
#pragma unroll
                for (int t = 0; t < 4; ++t) e[4 * q + t] *= rstd * g[t]; }
            const int nctxv = NCTX * H;
            if (vv >= nctxv) {
                const int t = (vv - nctxv) & 1023; const float pos = (float)(hsel ? (t & 63) : (t >> 6));
#pragma unroll
                for (int j = 0; j < 16; ++j) {
                    const float other = __shfl_xor(e[j], 2);
                    float rev = pos * (exp2f(-(float)(ib + j) * (13.287712379549449f / 32.f)) * 0.15915494309189535f); rev -= floorf(rev);
                    const float sn = __builtin_amdgcn_sinf(rev), cn = __builtin_amdgcn_cosf(rev);
                    e[j] = e[j] * cn + sgn * other * sn;
                }
            } else if (!isq) {
                float* sp = st_bk + (size_t)vv * 128 + 16 * part;
#pragma unroll
                for (int q = 0; q < 4; ++q) *(f32x4*)(sp + 4 * q) = (f32x4){e[4 * q], e[4 * q + 1], e[4 * q + 2], e[4 * q + 3]};
            }
            u32x4 o0, o1;
#pragma unroll
            for (int q = 0; q < 4; ++q) { o0[q] = cvt_pk_bf16(e[2 * q], e[2 * q + 1]); o1[q] = cvt_pk_bf16(e[8 + 2 * q], e[8 + 2 * q + 1]); }
            *(u32x4*)p = o0; *(u32x4*)(p + 8) = o1;
        }
    }
    SEAM(4);
    if (IN(5)) {
        char* al = (char*)lds;
#ifndef AT_MASK
#define AT_MASK 15
#endif
        if (AT_MASK & 1) for (int u0 = bx; u0 < 256; u0 += G) { const int u = (G == 256) ? ((u0 & 7) * 32 + (u0 >> 3)) : u0;
                const int b = u >> 3, h = u & 7; const size_t off = ((size_t)(b * 8 + h) * 256) * 128;
                att::attn_body<false>(QA + off, KA + off, VA + off, 4, KA + off, VA + off, 4, OB + (size_t)(b * 256) * DM + h * 128, al, 0, 0, wave_s);
                __syncthreads();
        }
        if (AT_MASK & 2) for (int u0 = bx; u0 < 256; u0 += G) { const int u = (G == 256) ? ((u0 & 7) * 32 + (u0 >> 3)) : u0;
                const int b = u >> 3, qh = u & 7, kvh = qh >> 2; const size_t qoff = ((size_t)(b * 8 + qh) * 256) * 128, koff = ((size_t)(b * 2 + kvh) * 256) * 128;
                att::attn_body<false, 1>(QB + qoff, KB + koff, VB + koff, 4, KB + koff, VB + koff, 4, OB + (size_t)(b * 256) * DM + 1024 + qh * 128, al, 0, 0, wave_s, g_qnorm, 0);
                __syncthreads();
        }
        if (AT_MASK & 4) for (int u0 = bx; u0 < 256; u0 += G) { const int u = (G == 256) ? ((u0 & 7) * 32 + (u0 >> 3)) : u0;
                const int b = u >> 5, qh = (u >> 2) & 7, qb = u & 3, kvh = qh >> 2;
                const size_t qoff = (size_t)NCTX * 8 * 128 + ((size_t)(b * 8 + qh) * 1024 + qb * 256) * 128;
                const size_t coff = ((size_t)(b * 2 + kvh) * 256) * 128, koff = (size_t)NCTX * 2 * 128 + ((size_t)(b * 2 + kvh) * 1024) * 128;
                att::attn_body<false, 2>(QB + qoff, CBK + coff, CBV + coff, 4, KB + koff, VB + koff, 20, OB + (size_t)(NCTX + b * 1024 + qb * 256) * DM + 1024 + qh * 128, al, 0, 0, wave_s, g_qnorm, qb * 256);
                __syncthreads();
        }
        if (AT_MASK & 8) for (int u0 = bx; u0 < 256; u0 += G) { const int u = (G == 256) ? ((u0 & 7) * 32 + (u0 >> 3)) : u0;
                const int b = u >> 5, h = (u >> 2) & 7, qb = u & 3;
                PHASE_IDS
                float* bt = (float*)(al + att::BIAS_OFF);
                for (int i = tid; i < att::BIAS_FLOATS; i += 512) { const int k = i - 64; bt[i] = (k >= 0 && k < 465) ? rpb[h * 465 + k] * (1.f / att::SCALE) : 0.f; }
                const int krlo = (qb == 0 || qb == 1) ? 0 : (qb == 2 ? 4 : 8), nrows = (qb == 0 || qb == 3) ? 8 : 12;
                const size_t qoff = (size_t)NCTX * 8 * 128 + ((size_t)(b * 8 + h) * 1024 + qb * 256) * 128;
                const size_t coff = ((size_t)(b * 8 + h) * 256) * 128, koff = (size_t)NCTX * 8 * 128 + ((size_t)(b * 8 + h) * 1024 + krlo * 64) * 128;
                att::attn_body<true>(QA + qoff, CAK + coff, CAV + coff, 4, KA + koff, VA + koff, 4 + nrows, OB + (size_t)(NCTX + b * 1024 + qb * 256) * DM + h * 128, al, qb * 4, krlo, wave_s);
                __syncthreads();
        }
    }
    SEAM(5);
    if (IN(6)) {
        pg8::Gemm g{OB, WOUT, MTOK, DM, DM}; pg8::StaticOrder S; S.init(MTOK, DM, G, bx);
        pg8::EpiBf16 E{P1, DM};
        pg8::gemm_phase<pg8::EpiBf16, pg8::StaticOrder, true>(ldsl, g, S, E, wave_s);
    }
    SEAM(6);
    if (IN(7)) {
        PHASE_IDS
        for (int m = 2 * gw; m < MTOK; m += 2 * NGW) {
            const float* xr = (m < NCTX) ? x_prompt + (size_t)m * DM : x_sample + (size_t)(m - NCTX) * DM;
            const float* md = MOD + (size_t)((m < NCTX) ? 0 : 1 + ((m - NCTX) >> 10)) * NMOD;
            const bf16_t* pr = P1 + (size_t)m * DM;
            float v[2][4][8]; float ss[2] = {0.f, 0.f};
            u32x4 pw[2][4];
#pragma unroll
            for (int r2 = 0; r2 < 2; ++r2)
#pragma unroll
                for (int i = 0; i < 4; ++i) pw[r2][i] = *(const u32x4*)(pr + (size_t)r2 * DM + 8 * lane + 512 * i);
#pragma unroll
            for (int r2 = 0; r2 < 2; ++r2)
#pragma unroll
                for (int i = 0; i < 4; ++i)
#pragma unroll
                    for (int q = 0; q < 4; ++q) { const float lo_ = bf_lo(pw[r2][i][q]), hi_ = bf_hi(pw[r2][i][q]); v[r2][i][2 * q] = lo_; v[r2][i][2 * q + 1] = hi_; ss[r2] += lo_ * lo_ + hi_ * hi_; }
            float rstd[2]; rstd[0] = rsqrtf(wave_sum(ss[0]) * (1.f / DM) + EPS); rstd[1] = rsqrtf(wave_sum(ss[1]) * (1.f / DM) + EPS);
            float ss2[2] = {0.f, 0.f};
#pragma unroll
            for (int i = 0; i < 4; ++i) { const int c = 8 * lane + 512 * i;
                float gg[8];
#pragma unroll
                for (int h2 = 0; h2 < 2; ++h2) {
                    const f32x4 g = *(const f32x4*)(g_attn_post + c + 4 * h2), ga = *(const f32x4*)(md + 4096 + c + 4 * h2);
#pragma unroll
                    for (int e = 0; e < 4; ++e) gg[4 * h2 + e] = g[e] * ga[e]; }
#pragma unroll
                for (int r2 = 0; r2 < 2; ++r2) {
                    const f32x4 xa = *(const f32x4*)(xr + (size_t)r2 * DM + c), xb = *(const f32x4*)(xr + (size_t)r2 * DM + c + 4);
                    float r[8];
#pragma unroll
                    for (int e = 0; e < 8; ++e) { r[e] = (e < 4 ? xa[e & 3] : xb[e & 3]) + gg[e] * (v[r2][i][e] * rstd[r2]); v[r2][i][e] = r[e]; ss2[r2] += r[e] * r[e]; }
                    u32x4 w; w.x = cvt_pk_bf16(r[0], r[1]); w.y = cvt_pk_bf16(r[2], r[3]); w.z = cvt_pk_bf16(r[4], r[5]); w.w = cvt_pk_bf16(r[6], r[7]);
                    *(u32x4*)(X1B + (size_t)(m + r2) * DM + c) = w; } }
            float rs2[2]; rs2[0] = rsqrtf(wave_sum(ss2[0]) * (1.f / DM) + EPS); rs2[1] = rsqrtf(wave_sum(ss2[1]) * (1.f / DM) + EPS);
            bf16_t* orow = XN + (size_t)m * DM;
#pragma unroll
            for (int i = 0; i < 4; ++i) { const int c = 8 * lane + 512 * i;
                float gsv[8], shv[8];
#pragma unroll
                for (int h2 = 0; h2 < 2; ++h2) {
                    const f32x4 g = *(const f32x4*)(g_ffn_pre + c + 4 * h2), sh = *(const f32x4*)(md + 6144 + c + 4 * h2), sc = *(const f32x4*)(md + 8192 + c + 4 * h2);
#pragma unroll
                    for (int e = 0; e < 4; ++e) { gsv[4 * h2 + e] = g[e] * (sc[e] + 1.f); shv[4 * h2 + e] = sh[e]; } }
#pragma unroll
                for (int r2 = 0; r2 < 2; ++r2) {
                    float r[8];
#pragma unroll
                    for (int e = 0; e < 8; ++e) r[e] = v[r2][i][e] * rs2[r2] * gsv[e] + shv[e];
                    u32x4 w; w.x = cvt_pk_bf16(r[0], r[1]); w.y = cvt_pk_bf16(r[2], r[3]); w.z = cvt_pk_bf16(r[4], r[5]); w.w = cvt_pk_bf16(r[6], r[7]);
                    *(u32x4*)(orow + (size_t)r2 * DM + c) = w; } }
        }
    }
    SEAM(7);
    if (IN(8)) {
        pg8::Gemm g{XN, WUP, MTOK, NUP, DM}; pg8::StaticOrder S; S.init(MTOK, NUP, G, bx);
        pg8::EpiConv E{ACT, HBUF, conv_w, conv_b, (LAS float*)(ldsl + 131072)};
        pg8::gemm_phase<pg8::EpiConv, pg8::StaticOrder, true>(ldsl, g, S, E, wave_s);
    }
    SEAM(8);
    if (IN(9)) {
        PHASE_IDS
        for (int it = gw; it < 32 * 2 * 22; it += NGW) {
            const int seg = it % 22, side = (it / 22) & 1, lt = it / 44; const int q = lt & 3;
            if ((side == 0 && q == 0) || (side == 1 && q == 3)) continue;
            const int ch = seg * 256 + lane * 4;
            f32x4 r[2];
#pragma unroll
            for (int bj = 0; bj < 2; ++bj) {
                const float* hp = HBUF + (size_t)bj * DFF + ch;
                const f32x4 up = *(const f32x4*)(hp + (size_t)((side ? lt * 4 + 2 : (lt - 1) * 4 + 3) * 2) * DFF);
                const f32x4 cu = *(const f32x4*)(hp + (size_t)((side ? lt * 4 + 3 : lt * 4 + 0) * 2) * DFF);
                const f32x4 dn = *(const f32x4*)(hp + (size_t)((side ? (lt + 1) * 4 + 0 : lt * 4 + 1) * 2) * DFF);
                const f32x4 w0 = *(const f32x4*)(conv_w + bj * DFF + ch), w1 = *(const f32x4*)(conv_w + NUP + bj * DFF + ch), w2 = *(const f32x4*)(conv_w + 2 * NUP + bj * DFF + ch);
                r[bj] = w0 * up + w1 * cu + w2 * dn + *(const f32x4*)(conv_b + bj * DFF + ch);
            }
            float a[4];
#pragma unroll
            for (int e = 0; e < 4; ++e) a[e] = r[1][e] * __builtin_amdgcn_rcpf(1.f + __expf(-r[1][e])) * r[0][e];
            u32x2 ow; ow.x = cvt_pk_bf16(a[0], a[1]); ow.y = cvt_pk_bf16(a[2], a[3]);
            *(u32x2*)(ACT + (size_t)(NCTX + lt * 256 + (side ? 255 : 0)) * DFF + ch) = ow;
        }
    }
    SEAM(9);
    if (IN(10)) {
        PHASE_IDS
        pg8::Gemm g{ACT, WDN, MTOK, DM, DFF}; pg8::StaticOrder S; S.init(MTOK, DM, G, bx);
        pg8::EpiBf16 E{P2, DM};
        pg8::gemm_phase<pg8::EpiBf16, pg8::StaticOrder, true>(ldsl, g, S, E, wave_s);
    }
    SEAM(10);
    if (IN(11)) {
        PHASE_IDS
        for (int m = 2 * gw; m < MTOK; m += 2 * NGW) {
            const float* md = MOD + (size_t)((m < NCTX) ? 0 : 1 + ((m - NCTX) >> 10)) * NMOD;
            const bf16_t* pr = P2 + (size_t)m * DM; const bf16_t* x1r = X1B + (size_t)m * DM;
            float v[2][4][8]; float ss[2] = {0.f, 0.f};
            u32x4 pw[2][4], xw[2][4];
#pragma unroll
            for (int r2 = 0; r2 < 2; ++r2)
#pragma unroll
                for (int i = 0; i < 4; ++i) { pw[r2][i] = *(const u32x4*)(pr + (size_t)r2 * DM + 8 * lane + 512 * i); xw[r2][i] = *(const u32x4*)(x1r + (size_t)r2 * DM + 8 * lane + 512 * i); }
#pragma unroll
            for (int r2 = 0; r2 < 2; ++r2)
#pragma unroll
                for (int i = 0; i < 4; ++i) { const u32x4 w = pw[r2][i];
                    v[r2][i][0] = bf_lo(w.x); v[r2][i][1] = bf_hi(w.x); v[r2][i][2] = bf_lo(w.y); v[r2][i][3] = bf_hi(w.y); v[r2][i][4] = bf_lo(w.z); v[r2][i][5] = bf_hi(w.z); v[r2][i][6] = bf_lo(w.w); v[r2][i][7] = bf_hi(w.w);
#pragma unroll
                    for (int e = 0; e < 8; ++e) ss[r2] += v[r2][i][e] * v[r2][i][e]; }
            float rstd[2]; rstd[0] = rsqrtf(wave_sum(ss[0]) * (1.f / DM) + EPS); rstd[1] = rsqrtf(wave_sum(ss[1]) * (1.f / DM) + EPS);
#pragma unroll
            for (int i = 0; i < 4; ++i) { const int c = 8 * lane + 512 * i;
                float gg[8];
#pragma unroll
                for (int h2 = 0; h2 < 2; ++h2) {
                    const f32x4 g = *(const f32x4*)(g_ffn_post + c + 4 * h2), ga = *(const f32x4*)(md + 10240 + c + 4 * h2);
#pragma unroll
                    for (int e = 0; e < 4; ++e) gg[4 * h2 + e] = g[e] * ga[e]; }
#pragma unroll
                for (int r2 = 0; r2 < 2; ++r2) { const u32x4 xq = xw[r2][i];
                    const float xv[8] = {bf_lo(xq.x), bf_hi(xq.x), bf_lo(xq.y), bf_hi(xq.y), bf_lo(xq.z), bf_hi(xq.z), bf_lo(xq.w), bf_hi(xq.w)};
                    f32x4 r0, r1;
#pragma unroll
                    for (int e = 0; e < 4; ++e) { r0[e] = xv[e] + gg[e] * (v[r2][i][e] * rstd[r2]); r1[e] = xv[4 + e] + gg[4 + e] * (v[r2][i][4 + e] * rstd[r2]); }
                    *(f32x4*)(Y_ + (size_t)(m + r2) * DM + c) = r0; *(f32x4*)(Y_ + (size_t)(m + r2) * DM + c + 4) = r1; } }
        }
    }
#undef IN
#undef SEAM
#undef ws
#undef x_prompt
#undef x_sample
#undef cvec
#undef cache_a_k
#undef cache_a_v
#undef cache_b_k
#undef cache_b_v
#undef c_ctx
#undef w_mod
#undef b_mod
#undef g_attn_pre
#undef g_attn_post
#undef g_ffn_pre
#undef g_ffn_post
#undef w_in
#undef rpb
#undef g_qnorm
#undef g_knorm
#undef w_out
#undef w_up
#undef conv_w
#undef conv_b
#undef w_down
#undef Y_
#undef st_ak
#undef st_av
#undef st_bk
#undef st_bv
#undef MOD
#undef MODP
#undef WIN
#undef WOUT
#undef WUP
#undef WDN
#undef XN
#undef CAK
#undef CAV
#undef CBK
#undef CBV
#undef QA
#undef KA
#undef VA
#undef QB
#undef KB
#undef VB
#undef OB
#undef P1
#undef P2
#undef ACT
#undef HBUF
#undef X1B
}

extern "C" void kernel_launch(void* const* d_in, const int* in_sizes, int n_in, void* d_out, int out_size, void* d_ws, size_t ws_size, hipStream_t stream) {
    static int grid = 0;
    if (grid == 0) {
        if (n_in != 23 || ws_size < WS_END) { fprintf(stderr, "kernel_launch: unexpected n_in %d or ws_size %zu (need %zu)\n", n_in, ws_size, (size_t)WS_END); grid = -1; return; }
        int dev = 0, cus = 0, per_cu = 0;
        hipGetDevice(&dev);
        hipDeviceGetAttribute(&cus, hipDeviceAttributeMultiprocessorCount, dev);
        if (hipFuncSetAttribute((const void*)mk_fwd, hipFuncAttributeMaxDynamicSharedMemorySize, LDS_BYTES) != hipSuccess) { fprintf(stderr, "kernel_launch: hipFuncSetAttribute failed\n"); grid = -1; return; }
        if (hipOccupancyMaxActiveBlocksPerMultiprocessor(&per_cu, (const void*)mk_fwd, 512, LDS_BYTES) != hipSuccess || per_cu < 1) { fprintf(stderr, "kernel_launch: occupancy query failed (%d)\n", per_cu); per_cu = 1; }
        (void)hipGetLastError();
        grid = cus * (per_cu > 1 ? 1 : per_cu);
        if (grid > 256) grid = 256;
    }
    if (grid < 0) return;
    if (hipMemsetAsync((char*)d_ws + WS_CTL, 0, CTL_BYTES, stream) != hipSuccess) { fprintf(stderr, "kernel_launch: memset failed\n"); return; }
    Args a{};
    for (int i = 0; i < 23; ++i) a.in[i] = (const float*)d_in[i];
    a.out = (float*)d_out; a.ws = (unsigned char*)d_ws; a.ph_lo = 0; a.ph_hi = 12;
    void* kargs[] = {&a};
    hipError_t e = hipLaunchCooperativeKernel((const void*)mk_fwd, dim3(grid), dim3(512), kargs, LDS_BYTES, stream);
    if (e != hipSuccess) fprintf(stderr, "kernel_launch: cooperative launch failed: %s (grid %d)\n", hipGetErrorString(e), grid);
}
```

```cpp
#include <hip/hip_runtime.h>
#include <hip/hip_cooperative_groups.h>
#include <cstdio>
#include <cstdint>
namespace cg = cooperative_groups;

#define LAS __attribute__((address_space(3)))
typedef unsigned short bf16_t;
typedef short bf16x8 __attribute__((ext_vector_type(8)));
typedef short s16x4 __attribute__((ext_vector_type(4)));
typedef float f32x4 __attribute__((ext_vector_type(4)));
typedef float f32x16 __attribute__((ext_vector_type(16)));
typedef unsigned u32x4 __attribute__((ext_vector_type(4)));
typedef unsigned u32x2 __attribute__((ext_vector_type(2)));

constexpr int DM = 2048, MTOK = 16384, NCTX = 8192, DFF = 5632, NUP = 11264, NIN = 4608, NMOD = 12288;
constexpr float EPS = 1e-6f;
constexpr int CHROWS = 4096;

constexpr size_t MiB = 1u << 20;
constexpr size_t WS_MOD = 0, WS_WDN = 1 * MiB, WS_XN = 23 * MiB, WS_WIN = 87 * MiB, WS_WOUT = 105 * MiB, WS_WUP = 113 * MiB;
constexpr size_t WS_CAK = 157 * MiB, WS_CAV = 161 * MiB, WS_CBK = 165 * MiB, WS_CBV = 166 * MiB;
constexpr size_t WS_QA = 167 * MiB, WS_KA = 199 * MiB, WS_VA = 231 * MiB, WS_QB = 263 * MiB, WS_KB = 295 * MiB, WS_VB = 303 * MiB;
constexpr size_t WS_O = 311 * MiB, WS_MODP = 311 * MiB;
constexpr size_t WS_P1 = 167 * MiB;
constexpr size_t WS_ACT = 157 * MiB, WS_U = 333 * MiB, WS_X1 = 341 * MiB;
constexpr size_t WS_P2 = 23 * MiB;
constexpr size_t WS_END = 421 * MiB;

constexpr int LDS_BYTES = 147456, MISC_OFF = 147200;
constexpr size_t WS_CTL = 512 * 1024, CTL_BYTES = 16384;

__device__ __forceinline__ unsigned cvt_pk_bf16(float lo, float hi) { unsigned r; asm volatile("v_cvt_pk_bf16_f32 %0, %1, %2" : "=v"(r) : "v"(lo), "v"(hi)); return r; }
__device__ __forceinline__ float bf_lo(unsigned w) { return __uint_as_float(w << 16); }
__device__ __forceinline__ float bf_hi(unsigned w) { return __uint_as_float(w & 0xffff0000u); }
__device__ __forceinline__ int tid_of(int wave_s) { unsigned z; asm volatile("v_mov_b32 %0, 0" : "=v"(z) :: "memory");
    return wave_s * 64 + (int)__builtin_amdgcn_mbcnt_hi(~0u, __builtin_amdgcn_mbcnt_lo(~0u, z)); }
__device__ __forceinline__ float wave_sum(float v) {
#pragma unroll
    for (int o = 1; o < 64; o <<= 1) v += __shfl_xor(v, o);
    return v;
}


#define XB_TMO      128
#define XB_XCNT(j)  (256  + 64 * (j))
#define XB_XSUB(j)  (1280 + 64 * (j))
#define XB_XGEN(j)  (2304 + 64 * (j))
#define XB_TOP      3328
#define XB_TOPGEN   3392
#define XCD_BAR_WORDS 3456
#define XB_SPIN_CAP (1u << 18)
__device__ __forceinline__ unsigned xb_ld(unsigned* p)              { return __hip_atomic_load(p, __ATOMIC_RELAXED, __HIP_MEMORY_SCOPE_AGENT); }
__device__ __forceinline__ unsigned xb_add(unsigned* p, unsigned v) { return __hip_atomic_fetch_add(p, v, __ATOMIC_RELAXED, __HIP_MEMORY_SCOPE_AGENT); }
__device__ __forceinline__ unsigned xb_xcc_id() { return (unsigned)__builtin_amdgcn_s_getreg((3 << 11) | 20) & 0xFu; }
#define XB_SPIN(cond, bar) do { unsigned _sp = 0; while (cond) { __builtin_amdgcn_s_sleep(1); \
    if ((++_sp & 255u) == 0u) { if (xb_ld(&(bar)[XB_TMO])) break; if (_sp > XB_SPIN_CAP) { atomicAdd(&(bar)[XB_TMO], 1u); break; } } } } while (0)
struct XcdBarrier { unsigned* bar; unsigned x; volatile LAS unsigned* st; };
__device__ __forceinline__ XcdBarrier xcd_barrier_post(unsigned* bar, volatile LAS unsigned* st, int wave_s) {
    XcdBarrier b; b.bar = bar; b.x = xb_xcc_id(); b.st = st;
    if (tid_of(wave_s) == 0) (void)xb_add(&bar[XB_XCNT(b.x)], 1u);
    return b;
}
__device__ __forceinline__ void xcd_barrier_complete(unsigned* bar, unsigned x, unsigned& nloc, unsigned& nx) {
    const unsigned G = gridDim.x * gridDim.y * gridDim.z;
    unsigned sum, cnt, mine, sp = 0u;
    for (;;) {
        sum = 0u; cnt = 0u; mine = 0u;
#pragma unroll
        for (unsigned j = 0; j < 16; ++j) { const unsigned c = xb_ld(&bar[XB_XCNT(j)]); sum += c; cnt += (c > 0u) ? 1u : 0u; mine = (j == x) ? c : mine; }
        if (sum == G) break;
        __builtin_amdgcn_s_sleep(1);
        if ((++sp & 255u) == 0u) { if (xb_ld(&bar[XB_TMO])) break; if (sp > XB_SPIN_CAP) { atomicAdd(&bar[XB_TMO], 1u); break; } }
    }
    nloc = mine > 0u ? mine : 1u; nx = cnt > 0u ? cnt : 1u;
}
__device__ __forceinline__ void xcd_barrier(const XcdBarrier& b, int wave_s) {
    asm volatile("s_waitcnt vmcnt(0)" ::: "memory");
    __syncthreads();
    if (tid_of(wave_s) == 0) {
        unsigned* bar = b.bar;
        __builtin_amdgcn_s_waitcnt(0);
        unsigned nloc = b.st[0], nx = b.st[1];
        if (nloc == 0u) { xcd_barrier_complete(bar, b.x, nloc, nx); b.st[0] = nloc; b.st[1] = nx; }
        const unsigned old = xb_add(&bar[XB_XSUB(b.x)], 1u);
        const unsigned gen = old / nloc;
        if (old + 1u == (gen + 1u) * nloc) {
            __builtin_amdgcn_fence(__ATOMIC_RELEASE, "agent");
            asm volatile("s_waitcnt vmcnt(0)" ::: "memory");
            const unsigned og = xb_add(&bar[XB_TOP], 1u);
            const unsigned tg = og / nx;
            if (og + 1u == (tg + 1u) * nx) xb_add(&bar[XB_TOPGEN], 1u);
            else XB_SPIN(xb_ld(&bar[XB_TOPGEN]) == tg, bar);
            __builtin_amdgcn_fence(__ATOMIC_ACQUIRE, "agent");
            xb_add(&bar[XB_XGEN(b.x)], 1u);
            asm volatile("s_waitcnt vmcnt(0)" ::: "memory");
        } else {
            XB_SPIN(xb_ld(&bar[XB_XGEN(b.x)]) == gen, bar);
            __builtin_amdgcn_fence(__ATOMIC_ACQUIRE, "agent");
            asm volatile("s_waitcnt vmcnt(0)" ::: "memory");
        }
    }
    __syncthreads();
}

namespace pg8 {
constexpr int BM = 256, BK = 64, HALF = 128, HTB = HALF * BK * 2, STAGE_BYTES = 8 * HTB, NXCD = 8, WGM = 8;
__host__ __device__ __forceinline__ int lds_byte(int r, int c) { const int st = (r >> 4) * 2 + (c >> 5), rr = r & 15, cc = c & 31, ob = rr * 64 + cc * 2; return st * 1024 + (ob ^ (((ob >> 9) & 1) << 5)); }
__host__ __device__ __forceinline__ void stage_rc(int b, int& R, int& C) { const int st = b / 1024, sb = b % 1024, swz = sb ^ (((sb >> 9) & 1) << 5); R = (st >> 1) * 16 + swz / 64; C = (st & 1) * 32 + (swz % 64) / 2; }
__host__ __device__ __forceinline__ int perm32(int rho) { const int n = rho >> 4, i = rho & 15; return 8 * (i >> 2) + 4 * n + (i & 3); }

struct Unit { int pm, pn; };
struct Gemm { const bf16_t* A; const bf16_t* Bt; int M, N, K; };

struct StaticOrder {
    int nM, nN, nwg, G, c;
    __host__ __device__ void init(int M, int N, int G_, int c_) { nM = M / BM; nN = N / BM; nwg = nM * nN; G = G_; c = c_; }
    __host__ __device__ bool next(int i, Unit& u) const {
        const long L = (long)i * G + c; if (L >= nwg) return false;
        int wgid = (int)L; { const int q = nwg / NXCD, r = nwg % NXCD, xcd = wgid % NXCD, off = wgid / NXCD; wgid = (xcd < r ? xcd * (q + 1) : r * (q + 1) + (xcd - r) * q) + off; }
        const int nig = WGM * nN, gid = wgid / nig, fm = gid * WGM, gsz = (nM - fm) < WGM ? (nM - fm) : WGM;
        u.pm = fm + ((wgid % nig) % gsz); u.pn = (wgid % nig) / gsz; return true;
    }
    __device__ __forceinline__ void a_ready(const Unit&) const {}
    __device__ __forceinline__ void done(const Unit&) const {}
};

__device__ __forceinline__ u32x4 quad_xpose(u32x4 w, int src4) {
    u32x4 r;
    r.x = (unsigned)__builtin_amdgcn_ds_bpermute(src4, (int)w.x); r.y = (unsigned)__builtin_amdgcn_ds_bpermute(src4, (int)w.y);
    r.z = (unsigned)__builtin_amdgcn_ds_bpermute(src4, (int)w.z); r.w = (unsigned)__builtin_amdgcn_ds_bpermute(src4, (int)w.w);
    return r;
}
struct EpiF32 {
    static constexpr bool PERM = false, AFTER_DRAIN = false;
    float* C; int ldc;
    __device__ __forceinline__ void operator()(const f32x4 (&acc)[2][2][4][2], const Unit& u, int wr, int wc, int fr, int fq) const {
        const int row0 = u.pm * BM + wr * 64 + fr, col0 = u.pn * BM + wc * 32 + 4 * fq;
#pragma unroll
        for (int ai = 0; ai < 2; ++ai)
#pragma unroll
            for (int m = 0; m < 4; ++m) { float* rowp = C + (size_t)(row0 + ai * HALF + m * 16) * ldc + col0;
#pragma unroll
                for (int bj = 0; bj < 2; ++bj)
#pragma unroll
                    for (int n = 0; n < 2; ++n) *(f32x4*)(rowp + bj * HALF + n * 16) = acc[ai][bj][m][n]; }
    }
};
struct EpiBf16 {
    static constexpr bool PERM = true, AFTER_DRAIN = false;
    bf16_t* O; int ldc;
    __device__ __forceinline__ void operator()(const f32x4 (&acc)[2][2][4][2], const Unit& u, int wr, int wc, int fr, int fq) const {
        const int ln = fr + 16 * fq, r4 = ln >> 2, c4 = ln & 3, src4 = 4 * (16 * c4 + r4);
        const int row0 = u.pm * BM + wr * 64 + r4, col0 = u.pn * BM + wc * 32 + 8 * c4;
#pragma unroll
        for (int ai = 0; ai < 2; ++ai)
#pragma unroll
            for (int m = 0; m < 4; ++m) { bf16_t* rowp = O + (size_t)(row0 + ai * HALF + m * 16) * ldc + col0;
#pragma unroll
                for (int bj = 0; bj < 2; ++bj) { const f32x4 v0 = acc[ai][bj][m][0], v1 = acc[ai][bj][m][1];
                    u32x4 w; w.x = cvt_pk_bf16(v0[0], v0[1]); w.y = cvt_pk_bf16(v0[2], v0[3]); w.z = cvt_pk_bf16(v1[0], v1[1]); w.w = cvt_pk_bf16(v1[2], v1[3]);
                    *(u32x4*)(rowp + bj * HALF) = quad_xpose(w, src4); } }
    }
};
struct EpiQKV {
    static constexpr bool PERM = true, AFTER_DRAIN = false;
    bf16_t *QA, *KA, *VA, *QB, *KB, *VB; float *sak, *sav, *sbv;
    __device__ __forceinline__ void operator()(const f32x4 (&acc)[2][2][4][2], const Unit& u, int wr, int wc, int fr, int fq) const {
        const int pn = u.pn, pm = u.pm;
        bf16_t* buf; int H, h0; float* st = nullptr;
        if (pn < 4) { buf = QA; H = 8; h0 = 2 * pn; }
        else if (pn < 8) { buf = KA; H = 8; h0 = 2 * (pn - 4); st = sak; }
        else if (pn < 12) { buf = VA; H = 8; h0 = 2 * (pn - 8); st = sav; }
        else if (pn < 16) { buf = QB; H = 8; h0 = 2 * (pn - 12); }
        else if (pn == 16) { buf = KB; H = 2; h0 = 0; }
        else { buf = VB; H = 2; h0 = 0; st = sbv; }
        const bool ctx = pm < 32;
        int b, t0, L; size_t reg;
        if (ctx) { b = pm; t0 = 0; L = 256; reg = 0; } else { b = (pm - 32) >> 2; t0 = ((pm - 32) & 3) * 256; L = 1024; reg = (size_t)NCTX * H * 128; }
#pragma unroll
        for (int bj = 0; bj < 2; ++bj) {
            const int h = h0 + bj;
            bf16_t* base = buf + reg + ((size_t)(b * H + h) * L + t0) * 128 + wc * 32 + 8 * fq;
            float* sbase = st + ((size_t)(b * H + h) * 256) * 128 + wc * 32 + 8 * fq;
#pragma unroll
            for (int ai = 0; ai < 2; ++ai)
#pragma unroll
                for (int m = 0; m < 4; ++m) {
                    const int t = ai * HALF + wr * 64 + m * 16 + fr;
                    const f32x4 v0 = acc[ai][bj][m][0], v1 = acc[ai][bj][m][1];
                    u32x4 w; w.x = cvt_pk_bf16(v0[0], v0[1]); w.y = cvt_pk_bf16(v0[2], v0[3]); w.z = cvt_pk_bf16(v1[0], v1[1]); w.w = cvt_pk_bf16(v1[2], v1[3]);
                    *(u32x4*)(base + (size_t)t * 128) = w;
                    if (ctx && st) { *(f32x4*)(sbase + (size_t)t * 128) = v0; *(f32x4*)(sbase + (size_t)t * 128 + 4) = v1; }
                    asm volatile("" ::: "memory");
                }
        }
    }
};


template <int CTRL> __device__ __forceinline__ float dppf(float old, float src) {
    return __builtin_bit_cast(float, __builtin_amdgcn_update_dpp(__builtin_bit_cast(int, old), __builtin_bit_cast(int, src), CTRL, 0xF, 0xF, false));
}
struct EpiConv {
    static constexpr bool PERM = true, AFTER_DRAIN = false;
    bf16_t* ACT; float* HB; const float* cw; const float* cb; LAS float* H;
    __device__ __forceinline__ void operator()(const f32x4 (&acc)[2][2][4][2], const Unit& u, int wr, int wc, int fr, int fq) const {
        const int pm = u.pm, pn = u.pn;
        const int cl = 32 * wc + 8 * fq, j0 = 128 * pn + cl;
#pragma unroll
        for (int ai = 0; ai < 2; ++ai) { const int blk = ai * 2 + wr;
            if (fr == 0) {
#pragma unroll
                for (int bj = 0; bj < 2; ++bj)
#pragma unroll
                    for (int n = 0; n < 2; ++n) *(LAS f32x4*)(H + ((blk * 2 + 0) * 2 + bj) * 128 + cl + 4 * n) = acc[ai][bj][0][n]; }
            if (fr == 15) {
#pragma unroll
                for (int bj = 0; bj < 2; ++bj)
#pragma unroll
                    for (int n = 0; n < 2; ++n) *(LAS f32x4*)(H + ((blk * 2 + 1) * 2 + bj) * 128 + cl + 4 * n) = acc[ai][bj][3][n]; } }
        if (pm >= 32) { const int lt = pm - 32;
            if (wr == 0 && fr < 2) {
#pragma unroll
                for (int bj = 0; bj < 2; ++bj)
#pragma unroll
                    for (int n = 0; n < 2; ++n) *(f32x4*)(HB + ((size_t)((lt * 4 + fr) * 2 + bj)) * DFF + j0 + 4 * n) = acc[0][bj][0][n]; }
            if (wr == 1 && fr >= 14) {
#pragma unroll
                for (int bj = 0; bj < 2; ++bj)
#pragma unroll
                    for (int n = 0; n < 2; ++n) *(f32x4*)(HB + ((size_t)((lt * 4 + fr - 12) * 2 + bj)) * DFF + j0 + 4 * n) = acc[1][bj][3][n]; } }
        asm volatile("s_waitcnt lgkmcnt(0)" ::: "memory"); __builtin_amdgcn_s_barrier(); asm volatile("" ::: "memory");
        u32x2 keep[2][4];
        const int ln = fr + 16 * fq, r4 = ln >> 2, c4 = ln & 3, src4 = 4 * (16 * c4 + r4);
#pragma unroll
        for (int n = 0; n < 2; ++n) {
            f32x4 w[3][2], bs[2];
#pragma unroll
            for (int bj = 0; bj < 2; ++bj) { bs[bj] = *(const f32x4*)(cb + bj * DFF + j0 + 4 * n);
#pragma unroll
                for (int k = 0; k < 3; ++k) w[k][bj] = *(const f32x4*)(cw + (size_t)k * NUP + bj * DFF + j0 + 4 * n); }
#pragma unroll
            for (int ai = 0; ai < 2; ++ai) { const int blk = ai * 2 + wr;
                f32x4 hu[2], hd[2];
#pragma unroll
                for (int bj = 0; bj < 2; ++bj) {
                    hu[bj] = (blk > 0) ? *(const LAS f32x4*)(H + (((blk - 1) * 2 + 1) * 2 + bj) * 128 + cl + 4 * n) : (f32x4){0.f, 0.f, 0.f, 0.f};
                    hd[bj] = (blk < 3) ? *(const LAS f32x4*)(H + (((blk + 1) * 2 + 0) * 2 + bj) * 128 + cl + 4 * n) : (f32x4){0.f, 0.f, 0.f, 0.f}; }
#pragma unroll
                for (int m = 0; m < 4; ++m) {
                    float a[4];
#pragma unroll
                    for (int e = 0; e < 4; ++e) {
                        float r[2];
#pragma unroll
                        for (int bj = 0; bj < 2; ++bj) {
                            const float cur = acc[ai][bj][m][n][e];
                            const float upT = (m == 0) ? hu[bj][e] : dppf<0x121>(0.f, acc[ai][bj][m == 0 ? 0 : m - 1][n][e]);
                            const float up = dppf<0x111>(upT, cur);
                            const float dnT = (m == 3) ? hd[bj][e] : dppf<0x12F>(0.f, acc[ai][bj][m == 3 ? 3 : m + 1][n][e]);
                            const float dn = dppf<0x101>(dnT, cur);
                            r[bj] = w[0][bj][e] * up + w[1][bj][e] * cur + w[2][bj][e] * dn + bs[bj][e];
                        }
                        a[e] = r[1] * __builtin_amdgcn_rcpf(1.f + __expf(-r[1])) * r[0];
                    }
                    u32x2 ow; ow.x = cvt_pk_bf16(a[0], a[1]); ow.y = cvt_pk_bf16(a[2], a[3]);
                    if (n == 0) keep[ai][m] = ow;
                    else { u32x4 w16; w16.x = keep[ai][m].x; w16.y = keep[ai][m].y; w16.z = ow.x; w16.w = ow.y;
                        *(u32x4*)(ACT + (size_t)(pm * BM + ai * HALF + wr * 64 + m * 16 + r4) * DFF + 128 * pn + 32 * wc + 8 * c4) = quad_xpose(w16, src4); }
                }
            }
        }
    }
};

template <class Epi, class Sched, bool ALIGN_EPI = true>
__device__ __forceinline__ void gemm_phase(LAS unsigned char* lds, const Gemm g, const Sched& S, const Epi& E, int wave_s) {
    const int tid = tid_of(wave_s);
    const int wid = wave_s, lane = tid & 63, wr = wid >> 2, wc = wid & 3, fr = lane & 15, fq = lane >> 4;
    const int K = g.K, nt = K / BK;
    unsigned voffA[2], voffB[2];
#pragma unroll
    for (int i = 0; i < 2; ++i) { int R, C; stage_rc(tid * 16 + i * 8192, R, C); const int Rb = Epi::PERM ? ((R & ~31) + perm32(R & 31)) : R;
        voffA[i] = (unsigned)(R * K + C) * 2u; voffB[i] = (unsigned)(Rb * K + C) * 2u; }
    const size_t kstep = (size_t)(BK * 2);
    const size_t hstep = (size_t)HALF * K * 2;
    const size_t tstep = 2 * hstep;
    const unsigned ldsw = (unsigned)wid * 1024u;
    const int aoff = lds_byte(wr * 64 + fr, fq * 8), boff = lds_byte(wc * 32 + fr, fq * 8);
#define PG8_SA(b, h) (((b) * 2 + (h)) * HTB)
#define PG8_SB(b, h) ((4 + (b) * 2 + (h)) * HTB)
#define PG8_STAGE(bufoff, gbase, voff) do { _Pragma("unroll") for (int _i = 0; _i < 2; ++_i) \
        __builtin_amdgcn_global_load_lds((const unsigned*)((const char*)(gbase) + (voff)[_i]), (LAS unsigned*)(lds + (bufoff) + ldsw + _i * 8192), 16, 0, 0); } while (0)
#define PG8_LDA(dst, b, h) do { _Pragma("unroll") for (int m = 0; m < 4; ++m) _Pragma("unroll") for (int k = 0; k < 2; ++k) dst[m][k] = *(const LAS bf16x8*)(lds + PG8_SA(b, h) + aoff + m * 2048 + k * 1024); } while (0)
#define PG8_LDB(dst, b, h) do { _Pragma("unroll") for (int n = 0; n < 2; ++n) _Pragma("unroll") for (int k = 0; k < 2; ++k) dst[n][k] = *(const LAS bf16x8*)(lds + PG8_SB(b, h) + boff + n * 2048 + k * 1024); } while (0)
#define PG8_MMA(ai, bj, At, Bt) do { __builtin_amdgcn_s_setprio(1); _Pragma("unroll") for (int m = 0; m < 4; ++m) _Pragma("unroll") for (int n = 0; n < 2; ++n) _Pragma("unroll") for (int k = 0; k < 2; ++k) \
        acc[ai][bj][m][n] = __builtin_amdgcn_mfma_f32_16x16x32_bf16(Bt[n][k], At[m][k], acc[ai][bj][m][n], 0, 0, 0); __builtin_amdgcn_s_setprio(0); } while (0)
#define PG8_WAIT_V(n) asm volatile("s_waitcnt vmcnt(" #n ")" ::: "memory")
#define PG8_WAIT_L(n) asm volatile("s_waitcnt lgkmcnt(" #n ")" ::: "memory")
#define PG8_BAR __builtin_amdgcn_s_barrier()
#define PG8_SCHED __builtin_amdgcn_sched_barrier(0)
    Unit cur, nxt; int ui = 0;
    if (!S.next(0, cur)) return;
    f32x4 acc[2][2][4][2];
#pragma unroll
    for (int a = 0; a < 2; ++a)
#pragma unroll
        for (int b = 0; b < 2; ++b)
#pragma unroll
            for (int m = 0; m < 4; ++m)
#pragma unroll
                for (int n = 0; n < 2; ++n) acc[a][b][m][n] = (f32x4){0.f, 0.f, 0.f, 0.f};
    bf16x8 At[4][2], B0[2][2], B1[2][2];
    const char* cA = (const char*)g.A + (size_t)cur.pm * tstep; const char* cB = (const char*)g.Bt + (size_t)cur.pn * tstep;
    S.a_ready(cur);
    PG8_STAGE(PG8_SB(0, 0), cB, voffB); PG8_STAGE(PG8_SB(0, 1), cB + hstep, voffB); PG8_STAGE(PG8_SA(0, 0), cA, voffA); PG8_STAGE(PG8_SA(0, 1), cA + hstep, voffA);
    if (wr == 1) PG8_BAR;
    PG8_WAIT_V(2); PG8_BAR;
    PG8_STAGE(PG8_SB(1, 0), cB + kstep, voffB); PG8_STAGE(PG8_SA(1, 0), cA + kstep, voffA); PG8_STAGE(PG8_SB(1, 1), cB + hstep + kstep, voffB);
    PG8_WAIT_V(6); PG8_BAR;
    for (;;) {
        const bool has_next = S.next(ui + 1, nxt);
        const char* nA = has_next ? (const char*)g.A + (size_t)nxt.pm * tstep : cA; const char* nB = has_next ? (const char*)g.Bt + (size_t)nxt.pn * tstep : cB;
        for (int t = 0; t < nt; t += 2) {
            const bool last = (t == nt - 2);
            const char* a1 = cA + (size_t)(t + 1) * kstep;
            const char* a2 = last ? nA : cA + (size_t)(t + 2) * kstep; const char* b2 = last ? nB : cB + (size_t)(t + 2) * kstep;
            const char* a3 = a2 + kstep; const char* b3 = b2 + kstep;
            if (last && has_next) S.a_ready(nxt);
            PG8_LDB(B0, 0, 0); PG8_LDB(B1, 0, 1); PG8_SCHED; PG8_LDA(At, 0, 0); PG8_STAGE(PG8_SA(1, 1), a1 + hstep, voffA);
            PG8_WAIT_V(8); PG8_WAIT_L(0); PG8_BAR; PG8_MMA(0, 0, At, B0); PG8_MMA(0, 1, At, B1); PG8_BAR; PG8_SCHED;
            PG8_LDA(At, 0, 1); PG8_STAGE(PG8_SB(0, 0), b2, voffB); PG8_STAGE(PG8_SB(0, 1), b2 + hstep, voffB); PG8_STAGE(PG8_SA(0, 0), a2, voffA);
            PG8_WAIT_V(8); PG8_WAIT_L(0); PG8_BAR; PG8_MMA(1, 0, At, B0); PG8_MMA(1, 1, At, B1); PG8_BAR; PG8_SCHED;
            PG8_LDB(B0, 1, 0); PG8_LDB(B1, 1, 1); PG8_SCHED; PG8_LDA(At, 1, 0); PG8_STAGE(PG8_SA(0, 1), a2 + hstep, voffA);
            PG8_WAIT_V(8); PG8_WAIT_L(0); PG8_BAR; PG8_MMA(0, 0, At, B0); PG8_MMA(0, 1, At, B1); PG8_BAR; PG8_SCHED;
            PG8_LDA(At, 1, 1); PG8_STAGE(PG8_SB(1, 0), b3, voffB); PG8_STAGE(PG8_SB(1, 1), b3 + hstep, voffB); PG8_STAGE(PG8_SA(1, 0), a3, voffA);
            PG8_WAIT_V(8); PG8_WAIT_L(0); PG8_BAR; PG8_MMA(1, 0, At, B0); PG8_MMA(1, 1, At, B1); PG8_BAR; PG8_SCHED;
        }
        if constexpr (ALIGN_EPI) { if (wr == 0) PG8_BAR; }
        E(acc, cur, wr, wc, fr, fq); S.done(cur);
        if (!has_next) break;
#pragma unroll
        for (int a = 0; a < 2; ++a)
#pragma unroll
            for (int b = 0; b < 2; ++b)
#pragma unroll
                for (int m = 0; m < 4; ++m)
#pragma unroll
                    for (int n = 0; n < 2; ++n) acc[a][b][m][n] = (f32x4){0.f, 0.f, 0.f, 0.f};
        cur = nxt; cA = nA; cB = nB; ++ui;
        if constexpr (ALIGN_EPI) { if (wr == 1) PG8_BAR; }
    }
    PG8_WAIT_V(0);
    if constexpr (!ALIGN_EPI) { if (wr == 0) PG8_BAR; }
    PG8_BAR;
#undef PG8_SA
#undef PG8_SB
#undef PG8_STAGE
#undef PG8_LDA
#undef PG8_LDB
#undef PG8_MMA
#undef PG8_WAIT_V
#undef PG8_WAIT_L
#undef PG8_BAR
#undef PG8_SCHED
}
}

namespace att {
constexpr int D = 128, NW = 8, QBLK = 32, KVBLK = 64;
constexpr float SCALE = 0.088388347648318440f;
constexpr float THR = 8.f;
constexpr int SHM_V = KVBLK * D * 2, SHM_K = KVBLK * D * 2, SHM_ATTN = 2 * SHM_V + 2 * SHM_K + NW * 64 * 4;
constexpr int BIAS_OFF = SHM_ATTN, BIAS_FLOATS = 704;
constexpr int OST_OFF = 73728, OST_WAVE = 32 * 272;
#define KSWZ(row, colB) ((row) * 256 + ((colB) ^ (((row) & 7) << 4)))
#define SBAR() __builtin_amdgcn_sched_barrier(0)
__device__ __forceinline__ int crow(int r, int hi) { return (r & 3) + 8 * (r >> 2) + 4 * hi; }
__device__ __forceinline__ unsigned cvtpk(float lo, float hi) { unsigned r; asm volatile("v_cvt_pk_bf16_f32 %0, %1, %2" : "=v"(r) : "v"(lo), "v"(hi)); return r; }
__device__ __forceinline__ bf16x8 ld8(const bf16_t* p) { return *reinterpret_cast<const bf16x8*>(p); }

__device__ __forceinline__ void partialSM(f32x16& p0, f32x16& p1, float& m_reg, float& mn, float& alpha) {
  constexpr float C = SCALE * 1.4426950408889634f;
  float pmax = p0[0];
#pragma unroll
  for (int r = 1; r < 16; ++r) pmax = fmaxf(pmax, p0[r]);
#pragma unroll
  for (int r = 0; r < 16; ++r) pmax = fmaxf(pmax, p1[r]);
  { auto rr = __builtin_amdgcn_permlane32_swap(__float_as_uint(pmax), __float_as_uint(pmax), false, false);
    pmax = fmaxf(__uint_as_float(rr[0]), __uint_as_float(rr[1])); }
  if (__builtin_expect(__all(pmax - m_reg <= THR / SCALE), 1)) { mn = m_reg; alpha = 1.f; }
  else { mn = fmaxf(m_reg, pmax); alpha = __builtin_amdgcn_exp2f((m_reg - mn) * C); m_reg = mn; }
  float mnC = -mn * C;
#pragma unroll
  for (int r = 0; r < 16; ++r) p0[r] = fmaf(p0[r], C, mnC);
#pragma unroll
  for (int r = 0; r < 16; ++r) p1[r] = fmaf(p1[r], C, mnC);
#pragma unroll
  for (int r = 0; r < 16; ++r) p0[r] = __builtin_amdgcn_exp2f(p0[r]);
}
__device__ __forceinline__ void finishSM(f32x16& p0, f32x16& p1, float alpha, float& l_reg, bf16x8& pa0, bf16x8& pa1, bf16x8& pa2, bf16x8& pa3) {
#pragma unroll
  for (int r = 0; r < 16; ++r) p1[r] = __builtin_amdgcn_exp2f(p1[r]);
  float ps = 0;
#pragma unroll
  for (int r = 0; r < 16; ++r) ps += p0[r];
#pragma unroll
  for (int r = 0; r < 16; ++r) ps += p1[r];
  { auto rr = __builtin_amdgcn_permlane32_swap(__float_as_uint(ps), __float_as_uint(ps), false, false);
    ps = __uint_as_float(rr[0]) + __uint_as_float(rr[1]); }
  l_reg = l_reg * alpha + ps;
#define PK4(P, BASE, OUT) do { unsigned a0 = cvtpk(P[BASE + 0], P[BASE + 1]), a1 = cvtpk(P[BASE + 2], P[BASE + 3]);   \
    unsigned b0 = cvtpk(P[BASE + 4], P[BASE + 5]), b1 = cvtpk(P[BASE + 6], P[BASE + 7]);                              \
    auto r0 = __builtin_amdgcn_permlane32_swap(a0, b0, false, false); auto r1 = __builtin_amdgcn_permlane32_swap(a1, b1, false, false); \
    u32x4 w = {r0[0], r1[0], r0[1], r1[1]}; OUT = *reinterpret_cast<bf16x8*>(&w); } while (0)
  PK4(p0, 0, pa0); PK4(p0, 8, pa1); PK4(p1, 0, pa2); PK4(p1, 8, pa3);
#undef PK4
}
__device__ __forceinline__ void qkt(f32x16& p0, f32x16& p1, const char* Ks, const bf16x8* qr, int r32, int hi) {
  p0 = f32x16{}; p1 = f32x16{};
#pragma unroll
  for (int d0 = 0; d0 < 8; ++d0) { int cb = (d0 * 16 + hi * 8) * 2;
    bf16x8 b0 = *reinterpret_cast<const bf16x8*>(Ks + KSWZ(r32, cb));
    bf16x8 b1 = *reinterpret_cast<const bf16x8*>(Ks + KSWZ(32 + r32, cb));
    p0 = __builtin_amdgcn_mfma_f32_32x32x16_bf16(b0, qr[d0], p0, 0, 0, 0);
    p1 = __builtin_amdgcn_mfma_f32_32x32x16_bf16(b1, qr[d0], p1, 0, 0, 0); }
}
__device__ __forceinline__ int v_st(int k, int c) { const int kk = (k & ~0xC) | ((k & 4) << 1) | ((k & 8) >> 1); return ((kk >> 3) * 4 + (c >> 5)) * 512 + ((kk & 7) * 32 + (c & 31)) * 2; }
__device__ __forceinline__ int v_rd_base(int lane) { return ((lane & 3) << 3) | (((lane >> 2) & 3) << 6) | (((lane >> 4) & 1) << 5) | (((lane >> 5) & 1) << 8); }
constexpr int v_rd_off(int d0, int ks, int half) { return d0 * 512 + ks * 4096 + half * 2048; }
template <int OFF> __device__ __forceinline__ s16x4 tr_read(int vb) {
  s16x4 r; asm volatile("ds_read_b64_tr_b16 %0, %1 offset:%2" : "=&v"(r) : "v"(vb), "i"(OFF) : "memory"); return r;
}
template <int D0> __device__ __forceinline__ void pv_one(f32x16& od, int vb, bf16x8 pa0, bf16x8 pa1, bf16x8 pa2, bf16x8 pa3) {
  const s16x4 l0 = tr_read<v_rd_off(D0, 0, 0)>(vb), h0 = tr_read<v_rd_off(D0, 0, 1)>(vb), l1 = tr_read<v_rd_off(D0, 1, 0)>(vb), h1 = tr_read<v_rd_off(D0, 1, 1)>(vb);
  const s16x4 l2 = tr_read<v_rd_off(D0, 2, 0)>(vb), h2 = tr_read<v_rd_off(D0, 2, 1)>(vb), l3 = tr_read<v_rd_off(D0, 3, 0)>(vb), h3 = tr_read<v_rd_off(D0, 3, 1)>(vb);
  asm volatile("s_waitcnt lgkmcnt(0)" ::: "memory"); SBAR();
#define PK(L, H) (bf16x8){L[0], L[1], L[2], L[3], H[0], H[1], H[2], H[3]}
  od = __builtin_amdgcn_mfma_f32_32x32x16_bf16(pa0, PK(l0, h0), od, 0, 0, 0);
  od = __builtin_amdgcn_mfma_f32_32x32x16_bf16(pa1, PK(l1, h1), od, 0, 0, 0);
  od = __builtin_amdgcn_mfma_f32_32x32x16_bf16(pa2, PK(l2, h2), od, 0, 0, 0);
  od = __builtin_amdgcn_mfma_f32_32x32x16_bf16(pa3, PK(l3, h3), od, 0, 0, 0);
#undef PK
}
__device__ __forceinline__ void pv_d0(f32x16* o, int vb, bf16x8 pa0, bf16x8 pa1, bf16x8 pa2, bf16x8 pa3) {
  pv_one<0>(o[0], vb, pa0, pa1, pa2, pa3); pv_one<1>(o[1], vb, pa0, pa1, pa2, pa3); pv_one<2>(o[2], vb, pa0, pa1, pa2, pa3); pv_one<3>(o[3], vb, pa0, pa1, pa2, pa3);
}

template <bool NB, int QN = 0>
__device__ __forceinline__ void attn_body(const bf16_t* __restrict__ Qb, const bf16_t* __restrict__ K0, const bf16_t* __restrict__ V0, int nt0,
                                          const bf16_t* __restrict__ K1, const bf16_t* __restrict__ V1, int NT,
                                          bf16_t* __restrict__ Ob, char* lds, int nb_r0, int nb_krlo, int wave_s,
                                          const float* __restrict__ gq = nullptr, int tpos0 = 0) {
  const int tid = tid_of(wave_s);
  const int wid = wave_s, lane = tid & 63, r32 = lane & 31, hi = lane >> 5;
  char* V_lds = lds; char* K_lds = lds + 2 * SHM_V;
  float* ws = (float*)(lds + 2 * SHM_V + 2 * SHM_K) + wid * 64; float* li_l = ws; float* al_l = ws + 32;
  float m_reg = -1e30f, l_reg = 0; f32x16 o[4] = {}; bf16x8 qr[8];
  const bf16_t* Qw = Qb + (size_t)(wid * QBLK + r32) * D + hi * 8;
#pragma unroll
  for (int d0 = 0; d0 < 8; ++d0) qr[d0] = ld8(Qw + d0 * 16);
  if constexpr (QN != 0) {
    float qf[8][8]; float ss = 0.f;
#pragma unroll
    for (int d0 = 0; d0 < 8; ++d0) { const u32x4 w = __builtin_bit_cast(u32x4, qr[d0]);
      qf[d0][0] = bf_lo(w.x); qf[d0][1] = bf_hi(w.x); qf[d0][2] = bf_lo(w.y); qf[d0][3] = bf_hi(w.y); qf[d0][4] = bf_lo(w.z); qf[d0][5] = bf_hi(w.z); qf[d0][6] = bf_lo(w.w); qf[d0][7] = bf_hi(w.w);
#pragma unroll
      for (int e = 0; e < 8; ++e) ss += qf[d0][e] * qf[d0][e]; }
    ss += __shfl_xor(ss, 32);
    const float rstd = rsqrtf(ss * (1.f / 128.f) + EPS);
#pragma unroll
    for (int d0 = 0; d0 < 8; ++d0) { const f32x4 g0 = *(const f32x4*)(gq + d0 * 16 + hi * 8), g1 = *(const f32x4*)(gq + d0 * 16 + hi * 8 + 4);
#pragma unroll
      for (int e = 0; e < 4; ++e) { qf[d0][e] *= rstd * g0[e]; qf[d0][4 + e] *= rstd * g1[e]; } }
    if constexpr (QN == 2) {
      const int tq = tpos0 + wid * QBLK + r32;
#pragma unroll
      for (int dh = 0; dh < 2; ++dh)
#pragma unroll
        for (int e = 0; e < 8; ++e) {
          const float fr_ = __builtin_amdgcn_exp2f(-(float)(dh * 16 + hi * 8 + e) * (13.287712379549449f / 32.f)) * 0.15915494309189535f;
#pragma unroll
          for (int H = 0; H < 2; ++H) {
            float rev = (float)(H ? (tq & 63) : (tq >> 6)) * fr_; rev -= floorf(rev);
            const float sn = __builtin_amdgcn_sinf(rev), cn = __builtin_amdgcn_cosf(rev);
            const float x1 = qf[4 * H + dh][e], x2 = qf[4 * H + dh + 2][e];
            qf[4 * H + dh][e] = x1 * cn - x2 * sn; qf[4 * H + dh + 2][e] = x2 * cn + x1 * sn; } }
    }
#pragma unroll
    for (int d0 = 0; d0 < 8; ++d0) { u32x4 w; w.x = cvtpk(qf[d0][0], qf[d0][1]); w.y = cvtpk(qf[d0][2], qf[d0][3]); w.z = cvtpk(qf[d0][4], qf[d0][5]); w.w = cvtpk(qf[d0][6], qf[d0][7]);
      qr[d0] = __builtin_bit_cast(bf16x8, w); }
  }
  const int sr = tid >> 4, sc = (tid & 15) * 8, vst0 = v_st(sr, sc), vst1 = v_st(32 + sr, sc);
  const int vb0 = (int)(uintptr_t)V_lds + v_rd_base(lane);
  const int nq_r = nb_r0 + (wid >> 1), nq_c = 32 * (wid & 1) + r32;
  const int nrs = min(max(nq_r - 4, 0), 8), ncs = min(max(nq_c - 8, 0), 48);
  const float* btab = (const float*)(lds + BIAS_OFF) + 64 + 15 - nq_c + 4 * hi;
  struct { bf16x8 vs0, vs1, ks0, ks1; } sr_[2];
#define KPTR(j) ((j) < nt0 ? K0 + (size_t)(j) * (KVBLK * D) : K1 + (size_t)((j) - nt0) * (KVBLK * D))
#define VPTR(j) ((j) < nt0 ? V0 + (size_t)(j) * (KVBLK * D) : V1 + (size_t)((j) - nt0) * (KVBLK * D))
#define SLOAD(i, j) do { const bf16_t* kp_ = KPTR(j); const bf16_t* vp_ = VPTR(j); \
    sr_[i].vs0 = ld8(vp_ + sr * D + sc); sr_[i].vs1 = ld8(vp_ + (32 + sr) * D + sc); \
    sr_[i].ks0 = ld8(kp_ + sr * D + sc); sr_[i].ks1 = ld8(kp_ + (32 + sr) * D + sc); } while (0)
#define SWRITE(b, i) do { *(bf16x8*)(V_lds + (b) * SHM_V + vst0) = sr_[i].vs0;          \
    *(bf16x8*)(V_lds + (b) * SHM_V + vst1) = sr_[i].vs1; int kc = sc * 2;               \
    *(bf16x8*)(K_lds + (b) * SHM_K + KSWZ(sr, kc)) = sr_[i].ks0;                       \
    *(bf16x8*)(K_lds + (b) * SHM_K + KSWZ(32 + sr, kc)) = sr_[i].ks1; } while (0)
#define SWAIT() asm volatile("s_waitcnt vmcnt(4)" ::: "memory")
#define RESC(a) do { if (__any((a) < 1.f)) { if (hi == 0) al_l[r32] = (a); asm volatile("s_waitcnt lgkmcnt(0)" ::: "memory"); \
    _Pragma("unroll") for (int d = 0; d < 4; ++d) _Pragma("unroll") for (int r = 0; r < 16; ++r) o[d][r] *= al_l[crow(r, hi)]; } } while (0)
#define NBMASK(P0, P1, j) do { if (NB && (j) >= 4) { const int kr_ = nb_krlo + (j) - 4; \
    if ((unsigned)(kr_ - nrs) >= 8u) { _Pragma("unroll") for (int r = 0; r < 16; ++r) { P0[r] = -1e30f; P1[r] = -1e30f; } } \
    else { const float* tb_ = btab + (kr_ - nq_r + 7) * 31; const int kb_ = 4 * hi - ncs; \
      _Pragma("unroll") for (int r = 0; r < 16; ++r) { const int c0_ = (r & 3) + 8 * (r >> 2); \
        P0[r] = ((unsigned)(kb_ + c0_) < 16u) ? P0[r] + tb_[c0_] : -1e30f; \
        P1[r] = ((unsigned)(kb_ + c0_ + 32) < 16u) ? P1[r] + tb_[c0_ + 32] : -1e30f; } } } } while (0)
  f32x16 pA0, pA1, pB0, pB1; float mnA, mnB, alA, alB; bf16x8 pa0, pa1, pa2, pa3;
  constexpr int SE = 0, SO = 1;
  SLOAD(SE, 0); asm volatile("s_waitcnt vmcnt(0)" ::: "memory"); SWRITE(0, SE); __syncthreads();
  qkt(pA0, pA1, K_lds, qr, r32, hi); partialSM(pA0, pA1, m_reg, mnA, alA);
  SLOAD(SO, 1); if (2 < NT) SLOAD(SE, 2);
  SWAIT(); SWRITE(1, SO); __syncthreads();
  for (int j = 1; j + 1 < NT; j += 2) {
    SBAR(); qkt(pB0, pB1, K_lds + SHM_K, qr, r32, hi);
    finishSM(pA0, pA1, alA, l_reg, pa0, pa1, pa2, pa3); SBAR();
    SLOAD(SO, j + 2); SBAR();
    pv_d0(o, vb0, pa0, pa1, pa2, pa3); NBMASK(pB0, pB1, j); partialSM(pB0, pB1, m_reg, mnB, alB);
    __syncthreads(); SWAIT(); SWRITE(0, SE);
    RESC(alB); __syncthreads();
    SBAR(); qkt(pA0, pA1, K_lds, qr, r32, hi);
    finishSM(pB0, pB1, alB, l_reg, pa0, pa1, pa2, pa3); SBAR();
    if (j + 3 < NT) SLOAD(SE, j + 3); SBAR();
    pv_d0(o, vb0 + SHM_V, pa0, pa1, pa2, pa3); NBMASK(pA0, pA1, j + 1); partialSM(pA0, pA1, m_reg, mnA, alA);
    __syncthreads(); SWAIT(); SWRITE(1, SO);
    RESC(alA); __syncthreads();
  }
  SBAR(); qkt(pB0, pB1, K_lds + SHM_K, qr, r32, hi);
  finishSM(pA0, pA1, alA, l_reg, pa0, pa1, pa2, pa3); SBAR();
  pv_d0(o, vb0, pa0, pa1, pa2, pa3); NBMASK(pB0, pB1, NT - 1); partialSM(pB0, pB1, m_reg, mnB, alB);
  __syncthreads(); RESC(alB);
  finishSM(pB0, pB1, alB, l_reg, pa0, pa1, pa2, pa3); SBAR();
  pv_d0(o, vb0 + SHM_V, pa0, pa1, pa2, pa3);
  if (hi == 0) li_l[r32] = l_reg; asm volatile("s_waitcnt lgkmcnt(0)" ::: "memory");
  float rli[16];
#pragma unroll
  for (int r = 0; r < 16; ++r) rli[r] = __builtin_amdgcn_rcpf(li_l[crow(r, hi)]);
  char* ost = lds + OST_OFF + wid * OST_WAVE;
#pragma unroll
  for (int r = 0; r < 16; ++r) { const int orow = crow(r, hi);
#pragma unroll
    for (int d0 = 0; d0 < 4; ++d0) { const float v = o[d0][r] * rli[r]; *(bf16_t*)(ost + orow * 272 + (d0 * 32 + r32) * 2) = (bf16_t)(cvtpk(v, v) & 0xffffu); } }
  asm volatile("s_waitcnt lgkmcnt(0)" ::: "memory");
  bf16_t* Ow = Ob + (size_t)(wid * QBLK) * DM;
#pragma unroll
  for (int i = 0; i < 8; ++i) { const int row = (lane >> 4) + 4 * i, ch = lane & 15;
    const u32x4 w = *(const u32x4*)(ost + row * 272 + ch * 16);
    *(u32x4*)(Ow + (size_t)row * DM + ch * 8) = w; }
#undef KPTR
#undef VPTR
#undef SLOAD
#undef SWRITE
#undef SWAIT
#undef RESC
#undef NBMASK
}
}

__device__ __forceinline__ unsigned f2bf(float f) { unsigned u = __builtin_bit_cast(unsigned, f); return (u + 0x7fffu + ((u >> 16) & 1u)) >> 16; }
__device__ __forceinline__ unsigned pk2(float lo, float hi) { return f2bf(lo) | (f2bf(hi) << 16); }
#define LDS_WAIT() asm volatile("s_waitcnt lgkmcnt(0)" ::: "memory")
template <bool UPMAP> __device__ __forceinline__ void transpose_item(const float* __restrict__ W, int K, int N, bf16_t* __restrict__ WT, LAS float* scr, int item, int lane) {
    const int nblk = N / 32, kb = item / nblk, nb = item % nblk, k0 = 64 * kb, n0 = 32 * nb;
    const int d0 = UPMAP ? (n0 < DFF ? (n0 >> 7) * 256 + (n0 & 127) : ((n0 - DFF) >> 7) * 256 + 128 + ((n0 - DFF) & 127)) : n0;
    {
        const int r8 = lane >> 3, c4 = lane & 7;
        f32x4 v[8];
#pragma unroll
        for (int g = 0; g < 8; ++g) v[g] = *(const f32x4*)(W + (size_t)(k0 + 8 * g + r8) * N + n0 + 4 * c4);
#pragma unroll
        for (int g = 0; g < 8; ++g) { LAS float* d = scr + (8 * g + r8) * 33 + 4 * c4; d[0] = v[g][0]; d[1] = v[g][1]; d[2] = v[g][2]; d[3] = v[g][3]; }
    }
    LDS_WAIT(); asm volatile("" ::: "memory");
    const int c = lane & 7;
#pragma unroll
    for (int j = 0; j < 4; ++j) { const int n = (lane >> 3) + 8 * j; const LAS float* s = scr + (8 * c) * 33 + n;
        u32x4 o; o.x = pk2(s[0 * 33], s[1 * 33]); o.y = pk2(s[2 * 33], s[3 * 33]); o.z = pk2(s[4 * 33], s[5 * 33]); o.w = pk2(s[6 * 33], s[7 * 33]);
        *(u32x4*)(WT + (size_t)(d0 + n) * K + k0 + 8 * c) = o; }
    LDS_WAIT(); asm volatile("" ::: "memory");
}

struct Args { const float* in[23]; float* out; unsigned char* ws; int ph_lo, ph_hi; };

__global__ void __launch_bounds__(512, 2) mk_fwd(Args args) {
    extern __shared__ __attribute__((aligned(16))) unsigned char lds[];
    cg::grid_group grid = cg::this_grid();
    const int G = gridDim.x, bx = blockIdx.x, NGW = G * 8;
    const int wave_s = __builtin_amdgcn_readfirstlane((int)threadIdx.x >> 6);
#define PHASE_IDS const int tid = tid_of(wave_s); const int lane = tid & 63, wave = wave_s; \
    const int gw = bx * 8 + wave, gwi = wave * G + bx; (void)lane; (void)gw; (void)gwi; (void)tid;
#define ws (args.ws)
#define x_prompt (args.in[0])
#define x_sample (args.in[1])
#define cvec (args.in[2])
#define cache_a_k (args.in[3])
#define cache_a_v (args.in[4])
#define cache_b_k (args.in[5])
#define cache_b_v (args.in[6])
#define c_ctx (args.in[7])
#define w_mod (args.in[8])
#define b_mod (args.in[9])
#define g_attn_pre (args.in[10])
#define g_attn_post (args.in[11])
#define g_ffn_pre (args.in[12])
#define g_ffn_post (args.in[13])
#define w_in (args.in[14])
#define rpb (args.in[15])
#define g_qnorm (args.in[16])
#define g_knorm (args.in[17])
#define w_out (args.in[18])
#define w_up (args.in[19])
#define conv_w (args.in[20])
#define conv_b (args.in[21])
#define w_down (args.in[22])
#define Y_ (args.out)
#define st_ak (args.out + (size_t)MTOK * DM)
#define st_av (args.out + (size_t)MTOK * DM + (size_t)32 * 8 * 256 * 128)
#define st_bk (args.out + (size_t)MTOK * DM + (size_t)2 * 32 * 8 * 256 * 128)
#define st_bv (args.out + (size_t)MTOK * DM + (size_t)2 * 32 * 8 * 256 * 128 + (size_t)32 * 2 * 256 * 128)
#define MOD ((float*)(ws + WS_MOD))
#define MODP ((float*)(ws + WS_MODP))
#define WIN ((bf16_t*)(ws + WS_WIN))
#define WOUT ((bf16_t*)(ws + WS_WOUT))
#define WUP ((bf16_t*)(ws + WS_WUP))
#define WDN ((bf16_t*)(ws + WS_WDN))
#define XN ((bf16_t*)(ws + WS_XN))
#define CAK ((bf16_t*)(ws + WS_CAK))
#define CAV ((bf16_t*)(ws + WS_CAV))
#define CBK ((bf16_t*)(ws + WS_CBK))
#define CBV ((bf16_t*)(ws + WS_CBV))
#define QA ((bf16_t*)(ws + WS_QA))
#define KA ((bf16_t*)(ws + WS_KA))
#define VA ((bf16_t*)(ws + WS_VA))
#define QB ((bf16_t*)(ws + WS_QB))
#define KB ((bf16_t*)(ws + WS_KB))
#define VB ((bf16_t*)(ws + WS_VB))
#define OB ((bf16_t*)(ws + WS_O))
#define P1 ((bf16_t*)(ws + WS_P1))
#define P2 ((bf16_t*)(ws + WS_P2))
#define ACT ((bf16_t*)(ws + WS_ACT))
#define HBUF ((float*)(ws + WS_U))
#define X1B ((bf16_t*)(ws + WS_X1))
    LAS unsigned char* ldsl = (LAS unsigned char*)lds;

    const int lo = args.ph_lo, hi = args.ph_hi;
#ifndef PH_MASK
#define PH_MASK 0xFFF
#endif
#define IN(k) (((PH_MASK >> (k)) & 1) && lo <= (k) && (k) < hi)
    { const int t0 = tid_of(wave_s); if (t0 < 16) ((volatile LAS unsigned*)(ldsl + MISC_OFF))[t0] = 0u; }
    __syncthreads();
    const XcdBarrier xbar = xcd_barrier_post((unsigned*)(ws + WS_CTL), (volatile LAS unsigned*)(ldsl + MISC_OFF), wave_s);
#define SEAM(k) do { if (IN(k) && IN((k) + 1)) { if ((k) == 0) grid.sync(); else xcd_barrier(xbar, wave_s); } } while (0)

    if (IN(0)) {
        PHASE_IDS
        LAS float* cs = (LAS float*)ldsl;
        for (int idx = tid; idx < 9 * 2048; idx += 512) { const int j = idx >> 11, k = idx & 2047; const float c = (j == 0) ? c_ctx[k] : cvec[(j - 1) * 2048 + k];
            cs[k * 9 + j] = c / (1.f + __expf(-c)); }
        __syncthreads();
        for (int ch = bx; ch < 256; ch += G) {
            const int vc = (ch & 7) * 32 + (ch >> 3), rsub = lane / 12, c4 = lane - 12 * rsub;
            f32x4 acc[9];
#pragma unroll
            for (int j = 0; j < 9; ++j) acc[j] = (f32x4){0.f, 0.f, 0.f, 0.f};
            if (rsub < 5) {
                const float* wp = w_mod + (size_t)(wave * 256 + rsub) * NMOD + vc * 48 + 4 * c4;
                const LAS float* sp = cs + (wave * 256 + rsub) * 9;
#pragma unroll 8
                for (int it = 0; it < 51; ++it) {
                    const f32x4 w = *(const f32x4*)(wp + (size_t)(5 * it) * NMOD);
                    const LAS float* s2 = sp + 45 * it;
#pragma unroll
                    for (int j = 0; j < 9; ++j) acc[j] += w * s2[j];
                }
                if (rsub == 0) {
                    const f32x4 w = *(const f32x4*)(wp + (size_t)255 * NMOD);
                    const LAS float* s2 = sp + 9 * 255;
#pragma unroll
                    for (int j = 0; j < 9; ++j) acc[j] += w * s2[j];
                }
            }
            __syncthreads();
            LAS float* red = (LAS float*)ldsl;
#pragma unroll
            for (int j = 0; j < 9; ++j) *(LAS f32x4*)(red + tid * 36 + 4 * j) = acc[j];
            __syncthreads();
            if (tid < 432) { const int j = tid / 48, col = tid - 48 * j, cc = col >> 2, e = col & 3;
                float sum = b_mod[vc * 48 + col];
#pragma unroll
                for (int w = 0; w < 8; ++w)
#pragma unroll
                    for (int r5 = 0; r5 < 5; ++r5) sum += red[(w * 64 + r5 * 12 + cc) * 36 + 4 * j + e];
                MOD[(size_t)j * NMOD + vc * 48 + col] = sum; }
            __syncthreads();
            if (ch + G < 256) {
                for (int idx = tid; idx < 9 * 2048; idx += 512) { const int j = idx >> 11, k = idx & 2047; const float c = (j == 0) ? c_ctx[k] : cvec[(j - 1) * 2048 + k];
                    cs[k * 9 + j] = c / (1.f + __expf(-c)); }
                __syncthreads();
            }
        }
        LAS float* scr = (LAS float*)(ldsl + wave * 8448);
        constexpr int I_IN = 32 * 144, I_OUT = 32 * 64;
        for (int it = gwi; it < I_IN + I_OUT; it += NGW) {
            if (it < I_IN) transpose_item<false>(w_in, DM, NIN, WIN, scr, it, lane);
            else transpose_item<false>(w_out, DM, DM, WOUT, scr, it - I_IN, lane);
        }
        {
            constexpr int NA8 = 8 * 8 * 256 * 128 / 8, NB8 = 8 * 2 * 256 * 128 / 8;
            for (int i = bx * 512 + tid; i < 2 * NA8 + 2 * NB8; i += G * 512) {
                const float* src; bf16_t* dst; int j = i;
                if (j < NA8) { src = cache_a_k; dst = CAK; } else if ((j -= NA8) < NA8) { src = cache_a_v; dst = CAV; }
                else if ((j -= NA8) < NB8) { src = cache_b_k; dst = CBK; } else { j -= NB8; src = cache_b_v; dst = CBV; }
                const f32x4 a = *(const f32x4*)(src + (size_t)j * 8), b = *(const f32x4*)(src + (size_t)j * 8 + 4);
                u32x4 w; w.x = cvt_pk_bf16(a[0], a[1]); w.y = cvt_pk_bf16(a[2], a[3]); w.z = cvt_pk_bf16(b[0], b[1]); w.w = cvt_pk_bf16(b[2], b[3]);
                *(u32x4*)(dst + (size_t)j * 8) = w;
            }
        }
    }
    SEAM(0);
    if (IN(2)) {
        PHASE_IDS
        for (int m = 2 * gw; m < MTOK; m += 2 * NGW) {
            const float* xr = (m < NCTX) ? x_prompt + (size_t)m * DM : x_sample + (size_t)(m - NCTX) * DM;
            const float* md = MOD + (size_t)((m < NCTX) ? 0 : 1 + ((m - NCTX) >> 10)) * NMOD;
            f32x4 v[2][4][2]; float ss[2] = {0.f, 0.f};
#pragma unroll
            for (int r2 = 0; r2 < 2; ++r2)
#pragma unroll
                for (int i = 0; i < 4; ++i) { v[r2][i][0] = *(const f32x4*)(xr + (size_t)r2 * DM + 8 * lane + 512 * i); v[r2][i][1] = *(const f32x4*)(xr + (size_t)r2 * DM + 8 * lane + 512 * i + 4); }
#pragma unroll
            for (int r2 = 0; r2 < 2; ++r2)
#pragma unroll
                for (int i = 0; i < 4; ++i)
#pragma unroll
                    for (int h2 = 0; h2 < 2; ++h2) { const f32x4 t = v[r2][i][h2]; ss[r2] += (t[0] * t[0] + t[1] * t[1]) + (t[2] * t[2] + t[3] * t[3]); }
            const float rstd0 = rsqrtf(wave_sum(ss[0]) * (1.f / DM) + EPS), rstd1 = rsqrtf(wave_sum(ss[1]) * (1.f / DM) + EPS);
            bf16_t* orow = XN + (size_t)m * DM;
#pragma unroll
            for (int i = 0; i < 4; ++i) { const int c = 8 * lane + 512 * i;
                f32x4 r0[2], r1[2];
#pragma unroll
                for (int h2 = 0; h2 < 2; ++h2) {
                    const f32x4 g = *(const f32x4*)(g_attn_pre + c + 4 * h2), sh = *(const f32x4*)(md + c + 4 * h2), sc = *(const f32x4*)(md + 2048 + c + 4 * h2);
                    const f32x4 gs = g * (sc + 1.f);
                    r0[h2] = v[0][i][h2] * rstd0 * gs + sh; r1[h2] = v[1][i][h2] * rstd1 * gs + sh; }
                u32x4 w0, w1;
                w0.x = cvt_pk_bf16(r0[0][0], r0[0][1]); w0.y = cvt_pk_bf16(r0[0][2], r0[0][3]); w0.z = cvt_pk_bf16(r0[1][0], r0[1][1]); w0.w = cvt_pk_bf16(r0[1][2], r0[1][3]);
                w1.x = cvt_pk_bf16(r1[0][0], r1[0][1]); w1.y = cvt_pk_bf16(r1[0][2], r1[0][3]); w1.z = cvt_pk_bf16(r1[1][0], r1[1][1]); w1.w = cvt_pk_bf16(r1[1][2], r1[1][3]);
                *(u32x4*)(orow + c) = w0; *(u32x4*)(orow + DM + c) = w1; }
        }
    }
    SEAM(2);
    if (IN(3)) {
        pg8::Gemm g{XN, WIN, MTOK, NIN, DM}; pg8::StaticOrder S; S.init(MTOK, NIN, G, bx);
        pg8::EpiQKV E{QA, KA, VA, QB, KB, VB, st_ak, st_av, st_bv};
        const int hb = G >> 1;
        if (bx >= hb) {
            PHASE_IDS
            LAS float* scr = (LAS float*)(ldsl + wave * 8448);
            constexpr int I_UP = 32 * 352, I_DN = 88 * 64;
            for (int it = wave * (G - hb) + (bx - hb); it < I_UP + I_DN; it += 8 * (G - hb)) {
                if (it < I_UP) transpose_item<true>(w_up, DM, NUP, WUP, scr, it, lane);
                else transpose_item<false>(w_down, DFF, DM, WDN, scr, it - I_UP, lane);
            }
            __syncthreads();
        }
        pg8::gemm_phase<pg8::EpiQKV, pg8::StaticOrder, true>(ldsl, g, S, E, wave_s);
    }
    SEAM(3);
    if (IN(4)) {
        PHASE_IDS
        const int vs = lane >> 3, part = lane & 7, hsel = part >> 2;
        const int ib = 16 * (part & 1);
        const float sgn = (part & 2) ? 1.f : -1.f;
        constexpr int NIQ = MTOK * 8 / 8, NIK = MTOK * 2 / 8;
        for (int itv = NIQ + gw; itv < NIQ + NIK; itv += NGW) {
            const bool isq = itv < NIQ; const int H = isq ? 8 : 2;
            const int vv = (isq ? itv : itv - NIQ) * 8 + vs;
            bf16_t* p = (isq ? QB : KB) + (size_t)vv * 128 + 16 * part;
            const float* gp = (isq ? g_qnorm : g_knorm) + 16 * part;
            const u32x4 w0 = *(const u32x4*)p, w1 = *(const u32x4*)(p + 8);
            float e[16];
#pragma unroll
            for (int q = 0; q < 4; ++q) { e[2 * q] = bf_lo(w0[q]); e[2 * q + 1] = bf_hi(w0[q]); e[8 + 2 * q] = bf_lo(w1[q]); e[8 + 2 * q + 1] = bf_hi(w1[q]); }
            float ss = 0.f;
#pragma unroll
            for (int j = 0; j < 16; ++j) ss += e[j] * e[j];
            ss += __shfl_xor(ss, 1); ss += __shfl_xor(ss, 2); ss += __shfl_xor(ss, 4);
            const float rstd = rsqrtf(ss * (1.f / 128.f) + EPS);
#pragma unroll
            for (int q = 0; q < 4; ++q) { const f32x4 g = *(const f32x4*)(gp + 4 * q);
#pragma unroll
                for (int t = 0; t < 4; ++t) e[4 * q + t] *= rstd * g[t]; }
            const int nctxv = NCTX * H;
            if (vv >= nctxv) {
                const int t = (vv - nctxv) & 1023; const float pos = (float)(hsel ? (t & 63) : (t >> 6));
#pragma unroll
                for (int j = 0; j < 16; ++j) {
                    const float other = __shfl_xor(e[j], 2);
                    float rev = pos * (exp2f(-(float)(ib + j) * (13.287712379549449f / 32.f)) * 0.15915494309189535f); rev -= floorf(rev);
                    const float sn = __builtin_amdgcn_sinf(rev), cn = __builtin_amdgcn_cosf(rev);
                    e[j] = e[j] * cn + sgn * other * sn;
                }
            } else if (!isq) {
                float* sp = st_bk + (size_t)vv * 128 + 16 * part;
#pragma unroll
                for (int q = 0; q < 4; ++q) *(f32x4*)(sp + 4 * q) = (f32x4){e[4 * q], e[4 * q + 1], e[4 * q + 2], e[4 * q + 3]};
            }
            u32x4 o0, o1;
#pragma unroll
            for (int q = 0; q < 4; ++q) { o0[q] = cvt_pk_bf16(e[2 * q], e[2 * q + 1]); o1[q] = cvt_pk_bf16(e[8 + 2 * q], e[8 + 2 * q + 1]); }
            *(u32x4*)p = o0; *(u32x4*)(p + 8) = o1;
        }
    }
    SEAM(4);
    if (IN(5)) {
        char* al = (char*)lds;
#ifndef AT_MASK
#define AT_MASK 15
#endif
        if (AT_MASK & 1) for (int u0 = bx; u0 < 256; u0 += G) { const int u = (G == 256) ? ((u0 & 7) * 32 + (u0 >> 3)) : u0;
                const int b = u >> 3, h = u & 7; const size_t off = ((size_t)(b * 8 + h) * 256) * 128;
                att::attn_body<false>(QA + off, KA + off, VA + off, 4, KA + off, VA + off, 4, OB + (size_t)(b * 256) * DM + h * 128, al, 0, 0, wave_s);
                __syncthreads();
        }
        if (AT_MASK & 2) for (int u0 = bx; u0 < 256; u0 += G) { const int u = (G == 256) ? ((u0 & 7) * 32 + (u0 >> 3)) : u0;
                const int b = u >> 3, qh = u & 7, kvh = qh >> 2; const size_t qoff = ((size_t)(b * 8 + qh) * 256) * 128, koff = ((size_t)(b * 2 + kvh) * 256) * 128;
                att::attn_body<false, 1>(QB + qoff, KB + koff, VB + koff, 4, KB + koff, VB + koff, 4, OB + (size_t)(b * 256) * DM + 1024 + qh * 128, al, 0, 0, wave_s, g_qnorm, 0);
                __syncthreads();
        }
        if (AT_MASK & 4) for (int u0 = bx; u0 < 256; u0 += G) { const int u = (G == 256) ? ((u0 & 7) * 32 + (u0 >> 3)) : u0;
                const int b = u >> 5, qh = (u >> 2) & 7, qb = u & 3, kvh = qh >> 2;
                const size_t qoff = (size_t)NCTX * 8 * 128 + ((size_t)(b * 8 + qh) * 1024 + qb * 256) * 128;
                const size_t coff = ((size_t)(b * 2 + kvh) * 256) * 128, koff = (size_t)NCTX * 2 * 128 + ((size_t)(b * 2 + kvh) * 1024) * 128;
                att::attn_body<false, 2>(QB + qoff, CBK + coff, CBV + coff, 4, KB + koff, VB + koff, 20, OB + (size_t)(NCTX + b * 1024 + qb * 256) * DM + 1024 + qh * 128, al, 0, 0, wave_s, g_qnorm, qb * 256);
                __syncthreads();
        }
        if (AT_MASK & 8) for (int u0 = bx; u0 < 256; u0 += G) { const int u = (G == 256) ? ((u0 & 7) * 32 + (u0 >> 3)) : u0;
                const int b = u >> 5, h = (u >> 2) & 7, qb = u & 3;
                PHASE_IDS
                float* bt = (float*)(al + att::BIAS_OFF);
                for (int i = tid; i < att::BIAS_FLOATS; i += 512) { const int k = i - 64; bt[i] = (k >= 0 && k < 465) ? rpb[h * 465 + k] * (1.f / att::SCALE) : 0.f; }
                const int krlo = (qb == 0 || qb == 1) ? 0 : (qb == 2 ? 4 : 8), nrows = (qb == 0 || qb == 3) ? 8 : 12;
                const size_t qoff = (size_t)NCTX * 8 * 128 + ((size_t)(b * 8 + h) * 1024 + qb * 256) * 128;
                const size_t coff = ((size_t)(b * 8 + h) * 256) * 128, koff = (size_t)NCTX * 8 * 128 + ((size_t)(b * 8 + h) * 1024 + krlo * 64) * 128;
                att::attn_body<true>(QA + qoff, CAK + coff, CAV + coff, 4, KA + koff, VA + koff, 4 + nrows, OB + (size_t)(NCTX + b * 1024 + qb * 256) * DM + h * 128, al, qb * 4, krlo, wave_s);
                __syncthreads();
        }
    }
    SEAM(5);
    if (IN(6)) {
        pg8::Gemm g{OB, WOUT, MTOK, DM, DM}; pg8::StaticOrder S; S.init(MTOK, DM, G, bx);
        pg8::EpiBf16 E{P1, DM};
        pg8::gemm_phase<pg8::EpiBf16, pg8::StaticOrder, true>(ldsl, g, S, E, wave_s);
    }
    SEAM(6);
    if (IN(7)) {
        PHASE_IDS
        for (int m = 2 * gw; m < MTOK; m += 2 * NGW) {
            const float* xr = (m < NCTX) ? x_prompt + (size_t)m * DM : x_sample + (size_t)(m - NCTX) * DM;
            const float* md = MOD + (size_t)((m < NCTX) ? 0 : 1 + ((m - NCTX) >> 10)) * NMOD;
            const bf16_t* pr = P1 + (size_t)m * DM;
            float v[2][4][8]; float ss[2] = {0.f, 0.f};
            u32x4 pw[2][4]; f32x4 xq[2][4][2];
#pragma unroll
            for (int r2 = 0; r2 < 2; ++r2)
#pragma unroll
                for (int i = 0; i < 4; ++i) { pw[r2][i] = *(const u32x4*)(pr + (size_t)r2 * DM + 8 * lane + 512 * i);
                    xq[r2][i][0] = *(const f32x4*)(xr + (size_t)r2 * DM + 8 * lane + 512 * i); xq[r2][i][1] = *(const f32x4*)(xr + (size_t)r2 * DM + 8 * lane + 512 * i + 4); }
#pragma unroll
            for (int r2 = 0; r2 < 2; ++r2)
#pragma unroll
                for (int i = 0; i < 4; ++i)
#pragma unroll
                    for (int q = 0; q < 4; ++q) { const float lo_ = bf_lo(pw[r2][i][q]), hi_ = bf_hi(pw[r2][i][q]); v[r2][i][2 * q] = lo_; v[r2][i][2 * q + 1] = hi_; ss[r2] += lo_ * lo_ + hi_ * hi_; }
            float rstd[2]; rstd[0] = rsqrtf(wave_sum(ss[0]) * (1.f / DM) + EPS); rstd[1] = rsqrtf(wave_sum(ss[1]) * (1.f / DM) + EPS);
            float ss2[2] = {0.f, 0.f};
#pragma unroll
            for (int i = 0; i < 4; ++i) { const int c = 8 * lane + 512 * i;
                float gg[8];
#pragma unroll
                for (int h2 = 0; h2 < 2; ++h2) {
                    const f32x4 g = *(const f32x4*)(g_attn_post + c + 4 * h2), ga = *(const f32x4*)(md + 4096 + c + 4 * h2);
#pragma unroll
                    for (int e = 0; e < 4; ++e) gg[4 * h2 + e] = g[e] * ga[e]; }
#pragma unroll
                for (int r2 = 0; r2 < 2; ++r2) {
                    const f32x4 xa = xq[r2][i][0], xb = xq[r2][i][1];
                    float r[8];
#pragma unroll
                    for (int e = 0; e < 8; ++e) { r[e] = (e < 4 ? xa[e & 3] : xb[e & 3]) + gg[e] * (v[r2][i][e] * rstd[r2]); v[r2][i][e] = r[e]; ss2[r2] += r[e] * r[e]; }
                    u32x4 w; w.x = cvt_pk_bf16(r[0], r[1]); w.y = cvt_pk_bf16(r[2], r[3]); w.z = cvt_pk_bf16(r[4], r[5]); w.w = cvt_pk_bf16(r[6], r[7]);
                    *(u32x4*)(X1B + (size_t)(m + r2) * DM + c) = w; } }
            float rs2[2]; rs2[0] = rsqrtf(wave_sum(ss2[0]) * (1.f / DM) + EPS); rs2[1] = rsqrtf(wave_sum(ss2[1]) * (1.f / DM) + EPS);
            bf16_t* orow = XN + (size_t)m * DM;
#pragma unroll
            for (int i = 0; i < 4; ++i) { const int c = 8 * lane + 512 * i;
                float gsv[8], shv[8];
#pragma unroll
                for (int h2 = 0; h2 < 2; ++h2) {
                    const f32x4 g = *(const f32x4*)(g_ffn_pre + c + 4 * h2), sh = *(const f32x4*)(md + 6144 + c + 4 * h2), sc = *(const f32x4*)(md + 8192 + c + 4 * h2);
#pragma unroll
                    for (int e = 0; e < 4; ++e) { gsv[4 * h2 + e] = g[e] * (sc[e] + 1.f); shv[4 * h2 + e] = sh[e]; } }
#pragma unroll
                for (int r2 = 0; r2 < 2; ++r2) {
                    float r[8];
#pragma unroll
                    for (int e = 0; e < 8; ++e) r[e] = v[r2][i][e] * rs2[r2] * gsv[e] + shv[e];
                    u32x4 w; w.x = cvt_pk_bf16(r[0], r[1]); w.y = cvt_pk_bf16(r[2], r[3]); w.z = cvt_pk_bf16(r[4], r[5]); w.w = cvt_pk_bf16(r[6], r[7]);
                    *(u32x4*)(orow + (size_t)r2 * DM + c) = w; } }
        }
    }
    SEAM(7);
    if (IN(8)) {
        pg8::Gemm g{XN, WUP, MTOK, NUP, DM}; pg8::StaticOrder S; S.init(MTOK, NUP, G, bx);
        pg8::EpiConv E{ACT, HBUF, conv_w, conv_b, (LAS float*)(ldsl + 131072)};
        pg8::gemm_phase<pg8::EpiConv, pg8::StaticOrder, true>(ldsl, g, S, E, wave_s);
    }
    SEAM(8);
    if (IN(9)) {
        PHASE_IDS
        for (int it = gw; it < 32 * 2 * 22; it += NGW) {
            const int seg = it % 22, side = (it / 22) & 1, lt = it / 44; const int q = lt & 3;
            if ((side == 0 && q == 0) || (side == 1 && q == 3)) continue;
            const int ch = seg * 256 + lane * 4;
            f32x4 r[2];
#pragma unroll
            for (int bj = 0; bj < 2; ++bj) {
                const float* hp = HBUF + (size_t)bj * DFF + ch;
                const f32x4 up = *(const f32x4*)(hp + (size_t)((side ? lt * 4 + 2 : (lt - 1) * 4 + 3) * 2) * DFF);
                const f32x4 cu = *(const f32x4*)(hp + (size_t)((side ? lt * 4 + 3 : lt * 4 + 0) * 2) * DFF);
                const f32x4 dn = *(const f32x4*)(hp + (size_t)((side ? (lt + 1) * 4 + 0 : lt * 4 + 1) * 2) * DFF);
                const f32x4 w0 = *(const f32x4*)(conv_w + bj * DFF + ch), w1 = *(const f32x4*)(conv_w + NUP + bj * DFF + ch), w2 = *(const f32x4*)(conv_w + 2 * NUP + bj * DFF + ch);
                r[bj] = w0 * up + w1 * cu + w2 * dn + *(const f32x4*)(conv_b + bj * DFF + ch);
            }
            float a[4];
#pragma unroll
            for (int e = 0; e < 4; ++e) a[e] = r[1][e] * __builtin_amdgcn_rcpf(1.f + __expf(-r[1][e])) * r[0][e];
            u32x2 ow; ow.x = cvt_pk_bf16(a[0], a[1]); ow.y = cvt_pk_bf16(a[2], a[3]);
            *(u32x2*)(ACT + (size_t)(NCTX + lt * 256 + (side ? 255 : 0)) * DFF + ch) = ow;
        }
    }
    SEAM(9);
    if (IN(10)) {
        PHASE_IDS
        pg8::Gemm g{ACT, WDN, MTOK, DM, DFF}; pg8::StaticOrder S; S.init(MTOK, DM, G, bx);
        pg8::EpiBf16 E{P2, DM};
        pg8::gemm_phase<pg8::EpiBf16, pg8::StaticOrder, true>(ldsl, g, S, E, wave_s);
    }
    SEAM(10);
    if (IN(11)) {
        PHASE_IDS
        for (int m = 2 * gw; m < MTOK; m += 2 * NGW) {
            const float* md = MOD + (size_t)((m < NCTX) ? 0 : 1 + ((m - NCTX) >> 10)) * NMOD;
            const bf16_t* pr = P2 + (size_t)m * DM; const bf16_t* x1r = X1B + (size_t)m * DM;
            float v[2][4][8]; float ss[2] = {0.f, 0.f};
            u32x4 pw[2][4], xw[2][4];
#pragma unroll
            for (int r2 = 0; r2 < 2; ++r2)
#pragma unroll
                for (int i = 0; i < 4; ++i) { pw[r2][i] = *(const u32x4*)(pr + (size_t)r2 * DM + 8 * lane + 512 * i); xw[r2][i] = *(const u32x4*)(x1r + (size_t)r2 * DM + 8 * lane + 512 * i); }
#pragma unroll
            for (int r2 = 0; r2 < 2; ++r2)
#pragma unroll
                for (int i = 0; i < 4; ++i) { const u32x4 w = pw[r2][i];
                    v[r2][i][0] = bf_lo(w.x); v[r2][i][1] = bf_hi(w.x); v[r2][i][2] = bf_lo(w.y); v[r2][i][3] = bf_hi(w.y); v[r2][i][4] = bf_lo(w.z); v[r2][i][5] = bf_hi(w.z); v[r2][i][6] = bf_lo(w.w); v[r2][i][7] = bf_hi(w.w);
#pragma unroll
                    for (int e = 0; e < 8; ++e) ss[r2] += v[r2][i][e] * v[r2][i][e]; }
            float rstd[2]; rstd[0] = rsqrtf(wave_sum(ss[0]) * (1.f / DM) + EPS); rstd[1] = rsqrtf(wave_sum(ss[1]) * (1.f / DM) + EPS);
#pragma unroll
            for (int i = 0; i < 4; ++i) { const int c = 8 * lane + 512 * i;
                float gg[8];
#pragma unroll
                for (int h2 = 0; h2 < 2; ++h2) {
                    const f32x4 g = *(const f32x4*)(g_ffn_post + c + 4 * h2), ga = *(const f32x4*)(md + 10240 + c + 4 * h2);
#pragma unroll
                    for (int e = 0; e < 4; ++e) gg[4 * h2 + e] = g[e] * ga[e]; }
#pragma unroll
                for (int r2 = 0; r2 < 2; ++r2) { const u32x4 xq = xw[r2][i];
                    const float xv[8] = {bf_lo(xq.x), bf_hi(xq.x), bf_lo(xq.y), bf_hi(xq.y), bf_lo(xq.z), bf_hi(xq.z), bf_lo(xq.w), bf_hi(xq.w)};
                    f32x4 r0, r1;
#pragma unroll
                    for (int e = 0; e < 4; ++e) { r0[e] = xv[e] + gg[e] * (v[r2][i][e] * rstd[r2]); r1[e] = xv[4 + e] + gg[4 + e] * (v[r2][i][4 + e] * rstd[r2]); }
                    *(f32x4*)(Y_ + (size_t)(m + r2) * DM + c) = r0; *(f32x4*)(Y_ + (size_t)(m + r2) * DM + c + 4) = r1; } }
        }
    }
#undef IN
#undef SEAM
#undef ws
#undef x_prompt
#undef x_sample
#undef cvec
#undef cache_a_k
#undef cache_a_v
#undef cache_b_k
#undef cache_b_v
#undef c_ctx
#undef w_mod
#undef b_mod
#undef g_attn_pre
#undef g_attn_post
#undef g_ffn_pre
#undef g_ffn_post
#undef w_in
#undef rpb
#undef g_qnorm
#undef g_knorm
#undef w_out
#undef w_up
#undef conv_w
#undef conv_b
#undef w_down
#undef Y_
#undef st_ak
#undef st_av
#undef st_bk
#undef st_bv
#undef MOD
#undef MODP
#undef WIN
#undef WOUT
#undef WUP
#undef WDN
#undef XN
#undef CAK
#undef CAV
#undef CBK
#undef CBV
#undef QA
#undef KA
#undef VA
#undef QB
#undef KB
#undef VB
#undef OB
#undef P1
#undef P2
#undef ACT
#undef HBUF
#undef X1B
}

extern "C" void kernel_launch(void* const* d_in, const int* in_sizes, int n_in, void* d_out, int out_size, void* d_ws, size_t ws_size, hipStream_t stream) {
    static int grid = 0;
    if (grid == 0) {
        if (n_in != 23 || ws_size < WS_END) { fprintf(stderr, "kernel_launch: unexpected n_in %d or ws_size %zu (need %zu)\n", n_in, ws_size, (size_t)WS_END); grid = -1; return; }
        int dev = 0, cus = 0, per_cu = 0;
        hipGetDevice(&dev);
        hipDeviceGetAttribute(&cus, hipDeviceAttributeMultiprocessorCount, dev);
        if (hipFuncSetAttribute((const void*)mk_fwd, hipFuncAttributeMaxDynamicSharedMemorySize, LDS_BYTES) != hipSuccess) { fprintf(stderr, "kernel_launch: hipFuncSetAttribute failed\n"); grid = -1; return; }
        if (hipOccupancyMaxActiveBlocksPerMultiprocessor(&per_cu, (const void*)mk_fwd, 512, LDS_BYTES) != hipSuccess || per_cu < 1) { fprintf(stderr, "kernel_launch: occupancy query failed (%d)\n", per_cu); per_cu = 1; }
        (void)hipGetLastError();
        grid = cus * (per_cu > 1 ? 1 : per_cu);
        if (grid > 256) grid = 256;
    }
    if (grid < 0) return;
    if (hipMemsetAsync((char*)d_ws + WS_CTL, 0, CTL_BYTES, stream) != hipSuccess) { fprintf(stderr, "kernel_launch: memset failed\n"); return; }
    Args a{};
    for (int i = 0; i < 23; ++i) a.in[i] = (const float*)d_in[i];
    a.out = (float*)d_out; a.ws = (unsigned char*)d_ws; a.ph_lo = 0; a.ph_hi = 12;
    void* kargs[] = {&a};
    hipError_t e = hipLaunchCooperativeKernel((const void*)mk_fwd, dim3(grid), dim3(512), kargs, LDS_BYTES, stream);
    if (e != hipSuccess) fprintf(stderr, "kernel_launch: cooperative launch failed: %s (grid %d)\n", hipGetErrorString(e), grid);
}
```
